# Optimizing an MI355X kernel written in HIP

```python
import jax, jax.numpy as jnp
from jax import lax
import numpy as np

D_MODEL = 1024
BATCH = 8
SEQ = 2048
DEPTH = 2

HEAD_DIM = 64
NSA_HEADS = 8
NSA_KV_GROUPS = 2
NSA_REP = NSA_HEADS // NSA_KV_GROUPS
CMP_LEN = 32
CMP_STRIDE = 16
CMP_HIDDEN = 128
SEL_BLOCK = 64
SEL_TOPK = 16
WINDOW = 512
MOBA_HEADS = 8
MOBA_BLOCK = 256
MOBA_TOPK = 3
Q_BLOCK = 128
D_FF = 2816
ROPE_THETA = 10000.0
EPS = 1e-6
NEG = -1e30
TINY = 1e-30
FORCE_BONUS = 1e4
NSA_WIDTH = NSA_HEADS * HEAD_DIM
NSA_KV_WIDTH = NSA_KV_GROUPS * HEAD_DIM
MOBA_WIDTH = MOBA_HEADS * HEAD_DIM
SPLIT_SIZES = (NSA_WIDTH, 3 * NSA_HEADS, NSA_KV_WIDTH, NSA_KV_WIDTH, NSA_KV_WIDTH, NSA_KV_WIDTH, NSA_KV_WIDTH, NSA_KV_WIDTH, MOBA_WIDTH, MOBA_WIDTH, MOBA_WIDTH, D_MODEL, D_MODEL)
IN_COLS = NSA_WIDTH + 3 * NSA_HEADS + 6 * NSA_KV_WIDTH + 3 * MOBA_WIDTH + 2 * D_MODEL

kernel_name = "hybrid_nsa_moba_macaron"


def _rms(x, g):
    xf = x.astype(jnp.float32)
    y = xf * lax.rsqrt(jnp.mean(xf * xf, axis=-1, keepdims=True) + EPS)
    return (y * g.astype(jnp.float32)).astype(x.dtype)


def _swiglu(h, wg, wu, wd):
    return (jax.nn.silu(h @ wg) * (h @ wu)) @ wd


def _rope_tables(pos):
    inv = ROPE_THETA ** (-jnp.arange(0, HEAD_DIM, 2, dtype=jnp.float32) / HEAD_DIM)
    ang = pos.astype(jnp.float32)[:, None] * inv[None, :]
    return jnp.cos(ang), jnp.sin(ang)


def _rope(x, cos, sin):
    x1, x2 = jnp.split(x.astype(jnp.float32), 2, axis=-1)
    return jnp.concatenate([x1 * cos - x2 * sin, x2 * cos + x1 * sin], axis=-1).astype(x.dtype)


def _masked_softmax(s, mask, axis):
    s = jnp.where(mask, s.astype(jnp.float32), NEG)
    m = jnp.max(s, axis=axis, keepdims=True)
    p = jnp.exp(s - m) * mask
    return p / jnp.maximum(jnp.sum(p, axis=axis, keepdims=True), TINY)


def _heads(z, n):
    b, s, _ = z.shape
    return z.reshape(b, s, n, HEAD_DIM).transpose(0, 2, 1, 3)


def _split_cols(z):
    idx = []
    acc = 0
    for w in SPLIT_SIZES[:-1]:
        acc += w
        idx.append(acc)
    return jnp.split(z, idx, axis=-1)


def _chunk_queries(a):
    b = a.shape[0]
    s = a.shape[-2]
    nq = s // Q_BLOCK
    mid = a.shape[1:-2]
    a = a.reshape((b,) + mid + (nq, Q_BLOCK, a.shape[-1]))
    nd = a.ndim
    perm = (0, nd - 3) + tuple(range(1, nd - 3)) + (nd - 2, nd - 1)
    return a.transpose(perm).reshape((b * nq,) + mid + (Q_BLOCK, a.shape[-1]))


def _unchunk_queries(a, b):
    nq = a.shape[0] // b
    mid = a.shape[1:-2]
    a = a.reshape((b, nq) + mid + a.shape[-2:])
    nd = a.ndim
    perm = (0,) + tuple(range(2, nd - 2)) + (1, nd - 2, nd - 1)
    return a.transpose(perm).reshape((b,) + mid + (nq * Q_BLOCK, a.shape[-1]))


def _compress(k, pos_emb, w1, w2):
    b, g, s, d = k.shape
    ch = k.reshape(b, g, s // CMP_STRIDE, CMP_STRIDE, d)
    blocks = jnp.concatenate([ch[:, :, :-1], ch[:, :, 1:]], axis=3) + pos_emb
    flat = blocks.reshape(b, g, blocks.shape[2], CMP_LEN * d)
    return jax.nn.gelu(flat @ w1) @ w2


def _nsa(q, g, kc, vc, ks, vs, kw, vw, ck_pos, ck_w1, ck_w2, cv_pos, cv_w1, cv_w2):
    B, S, _ = q.shape
    G, R, D = NSA_KV_GROUPS, NSA_REP, HEAD_DIM
    scale = HEAD_DIM ** -0.5
    t = jnp.arange(S)
    cos, sin = _rope_tables(t)
    qh = _rope(_heads(q, NSA_HEADS), cos, sin).reshape(B, G, R, S, D)

    kcb = _compress(_heads(kc, G), ck_pos, ck_w1, ck_w2)
    vcb = _compress(_heads(vc, G), cv_pos, cv_w1, cv_w2)
    nc = kcb.shape[2]
    end_pos = jnp.arange(nc) * CMP_STRIDE + (CMP_LEN - 1)
    cc, sc = _rope_tables(end_pos)
    kcb = _rope(kcb, cc, sc)
    s_cmp = jnp.einsum('bgrtd,bgcd->bgrtc', qh, kcb) * scale
    p_cmp = _masked_softmax(s_cmp, end_pos[None, :] <= t[:, None], -1)
    o_cmp = jnp.einsum('bgrtc,bgcd->bgrtd', p_cmp.astype(vcb.dtype), vcb)

    ns = S // SEL_BLOCK
    ci = jnp.arange(nc)[:, None] * CMP_STRIDE
    sj = jnp.arange(ns)[None, :] * SEL_BLOCK
    overlap = ((ci < sj + SEL_BLOCK) & (ci + CMP_LEN > sj)).astype(jnp.float32)
    imp = jnp.einsum('bgrtc,cj->bgtj', p_cmp, overlap)
    tblk = (t // SEL_BLOCK)[:, None]
    jj = jnp.arange(ns)[None, :]
    forced = (jj == 0) | (jj == tblk) | (jj == tblk - 1)
    imp = jnp.where(jj <= tblk, imp + jnp.where(forced, FORCE_BONUS, 0.0), NEG)
    k_sel = min(SEL_TOPK, ns)
    _, sel_idx = lax.top_k(imp, k_sel)

    ksb = _rope(_heads(ks, G), cos, sin).reshape(B, G, ns, SEL_BLOCK, D)
    vsb = _heads(vs, G).reshape(B, G, ns, SEL_BLOCK, D)
    nq = S // Q_BLOCK
    q_ch = _chunk_queries(qh)
    idx_ch = _chunk_queries(sel_idx)
    b_ids = jnp.repeat(jnp.arange(B), nq)
    n_ids = jnp.tile(jnp.arange(nq), B)

    def sel_body(args):
        qc, ic, bi, ni = args
        kg = jax.vmap(lambda kk, ii: kk[ii])(ksb[bi], ic)
        vg = jax.vmap(lambda vv, ii: vv[ii])(vsb[bi], ic)
        s = jnp.einsum('grqd,gqnkd->grqnk', qc, kg) * scale
        tq = ni * Q_BLOCK + jnp.arange(Q_BLOCK)
        kpos = ic[..., None] * SEL_BLOCK + jnp.arange(SEL_BLOCK)
        mask = (kpos <= tq[None, :, None, None])[:, None]
        p = _masked_softmax(s, mask, (-2, -1))
        return jnp.einsum('grqnk,gqnkd->grqd', p.astype(vg.dtype), vg)

    o_sel = _unchunk_queries(lax.map(sel_body, (q_ch, idx_ch, b_ids, n_ids)), B)

    kwh = _rope(_heads(kw, G), cos, sin)
    vwh = _heads(vw, G)
    pad = ((0, 0), (0, 0), (WINDOW, 0), (0, 0))
    band = jnp.arange(nq)[:, None] * Q_BLOCK + jnp.arange(WINDOW + Q_BLOCK)[None, :]
    kband = jnp.take(jnp.pad(kwh, pad), band, axis=2)
    vband = jnp.take(jnp.pad(vwh, pad), band, axis=2)
    qb = qh.reshape(B, G, R, nq, Q_BLOCK, D)
    s_win = jnp.einsum('bgrnqd,bgnkd->bgrnqk', qb, kband) * scale
    kpos = (band - WINDOW)[:, None, :]
    tq = (jnp.arange(nq)[:, None] * Q_BLOCK + jnp.arange(Q_BLOCK)[None, :])[:, :, None]
    m_win = (kpos >= 0) & (kpos <= tq) & (tq - kpos < WINDOW)
    p_win = _masked_softmax(s_win, m_win, -1)
    o_win = jnp.einsum('bgrnqk,bgnkd->bgrnqd', p_win.astype(vband.dtype), vband).reshape(B, G, R, S, D)

    gate = jax.nn.sigmoid(g).reshape(B, S, G, R, 3).transpose(0, 2, 3, 1, 4)
    o = gate[..., 0:1] * o_cmp + gate[..., 1:2] * o_sel + gate[..., 2:3] * o_win
    return o.transpose(0, 3, 1, 2, 4).reshape(B, S, NSA_WIDTH)


def _moba(q, k, v):
    B, S, _ = q.shape
    H, D = MOBA_HEADS, HEAD_DIM
    scale = HEAD_DIM ** -0.5
    t = jnp.arange(S)
    cos, sin = _rope_tables(t)
    qh = _rope(_heads(q, H), cos, sin)
    kh = _rope(_heads(k, H), cos, sin)
    vh = _heads(v, H)
    nb = -(-S // MOBA_BLOCK)
    sp = nb * MOBA_BLOCK
    kp = jnp.pad(kh, ((0, 0), (0, 0), (0, sp - S), (0, 0)))
    vp = jnp.pad(vh, ((0, 0), (0, 0), (0, sp - S), (0, 0)))
    kblk = kp.reshape(B, H, nb, MOBA_BLOCK, D)
    vblk = vp.reshape(B, H, nb, MOBA_BLOCK, D)
    n_top = min(MOBA_TOPK, nb - 1)
    nq = S // Q_BLOCK
    if n_top > 0:
        kmean = jnp.mean(kblk.astype(jnp.float32), axis=3).astype(kh.dtype)
        gsc = jnp.einsum('bhtd,bhjd->bhtj', qh, kmean)
        past = jnp.arange(nb)[None, :] < (t // MOBA_BLOCK)[:, None]
        gsc = jnp.where(past, gsc.astype(jnp.float32), NEG)
        _, gidx = lax.top_k(gsc, n_top)
        idx_ch = _chunk_queries(gidx)
    else:
        idx_ch = jnp.zeros((B * nq, H, Q_BLOCK, 1), jnp.int32)
    q_ch = _chunk_queries(qh)
    b_ids = jnp.repeat(jnp.arange(B), nq)
    n_ids = jnp.tile(jnp.arange(nq), B)

    def body(args):
        qc, ic, bi, ni = args
        tq = ni * Q_BLOCK + jnp.arange(Q_BLOCK)
        c = (ni * Q_BLOCK) // MOBA_BLOCK
        kown = lax.dynamic_slice_in_dim(kp[bi], c * MOBA_BLOCK, MOBA_BLOCK, axis=1)
        vown = lax.dynamic_slice_in_dim(vp[bi], c * MOBA_BLOCK, MOBA_BLOCK, axis=1)
        s_own = jnp.einsum('hqd,hkd->hqk', qc, kown) * scale
        own_pos = c * MOBA_BLOCK + jnp.arange(MOBA_BLOCK)
        m_own = jnp.broadcast_to((own_pos[None, :] <= tq[:, None])[None], s_own.shape)
        if n_top > 0:
            kg = jax.vmap(lambda kk, ii: kk[ii])(kblk[bi], ic)
            vg = jax.vmap(lambda vv, ii: vv[ii])(vblk[bi], ic)
            s_sel = jnp.einsum('hqd,hqnkd->hqnk', qc, kg) * scale
            m_sel = jnp.broadcast_to((ic < c)[..., None], s_sel.shape)
            s_all = jnp.concatenate([s_sel.reshape(H, Q_BLOCK, -1), s_own], axis=-1)
            m_all = jnp.concatenate([m_sel.reshape(H, Q_BLOCK, -1), m_own], axis=-1)
            p = _masked_softmax(s_all, m_all, -1)
            p_sel = p[..., :n_top * MOBA_BLOCK].reshape(H, Q_BLOCK, n_top, MOBA_BLOCK)
            p_own = p[..., n_top * MOBA_BLOCK:]
            return (jnp.einsum('hqnk,hqnkd->hqd', p_sel.astype(vg.dtype), vg)
                    + jnp.einsum('hqk,hkd->hqd', p_own.astype(vown.dtype), vown))
        p_own = _masked_softmax(s_own, m_own, -1)
        return jnp.einsum('hqk,hkd->hqd', p_own.astype(vown.dtype), vown)

    o = _unchunk_queries(lax.map(body, (q_ch, idx_ch, b_ids, n_ids)), B)
    return o.transpose(0, 2, 1, 3).reshape(B, S, MOBA_WIDTH)


def setup_inputs(seed: int = 0) -> dict:
    key = jax.random.key(seed)
    ks = jax.random.split(key, 24)

    def w(k, shape, fan_in):
        return jax.random.normal(k, shape, jnp.float32) * (fan_in ** -0.5)

    def gain(k, shape):
        return 1.0 + 0.01 * jax.random.normal(k, shape, jnp.float32)

    L, Dm, F = DEPTH, D_MODEL, D_FF
    return {
        "x": jax.random.normal(ks[0], (BATCH, SEQ, Dm), jnp.float32),
        "ffn1_norm": gain(ks[1], (L, Dm)),
        "ffn1_wg": w(ks[2], (L, Dm, F), Dm),
        "ffn1_wu": w(ks[3], (L, Dm, F), Dm),
        "ffn1_wd": w(ks[4], (L, F, Dm), F),
        "mix_norm": gain(ks[5], (L, Dm)),
        "w_in": w(ks[6], (L, Dm, IN_COLS), Dm),
        "cmpk_pos": 0.1 * jax.random.normal(ks[7], (L, CMP_LEN, HEAD_DIM), jnp.float32),
        "cmpk_w1": w(ks[8], (L, CMP_LEN * HEAD_DIM, CMP_HIDDEN), CMP_LEN * HEAD_DIM),
        "cmpk_w2": w(ks[9], (L, CMP_HIDDEN, HEAD_DIM), CMP_HIDDEN),
        "cmpv_pos": 0.1 * jax.random.normal(ks[10], (L, CMP_LEN, HEAD_DIM), jnp.float32),
        "cmpv_w1": w(ks[11], (L, CMP_LEN * HEAD_DIM, CMP_HIDDEN), CMP_LEN * HEAD_DIM),
        "cmpv_w2": w(ks[12], (L, CMP_HIDDEN, HEAD_DIM), CMP_HIDDEN),
        "w_branch_nsa": w(ks[13], (L, NSA_WIDTH, Dm), NSA_WIDTH),
        "w_branch_moba": w(ks[14], (L, MOBA_WIDTH, Dm), MOBA_WIDTH),
        "w_out": w(ks[15], (L, Dm, Dm), Dm),
        "ffn2_norm": gain(ks[16], (L, Dm)),
        "ffn2_wg": w(ks[17], (L, Dm, F), Dm),
        "ffn2_wu": w(ks[18], (L, Dm, F), Dm),
        "ffn2_wd": w(ks[19], (L, F, Dm), F),
        "final_norm": gain(ks[20], (Dm,)),
    }


def reference(x, ffn1_norm, ffn1_wg, ffn1_wu, ffn1_wd, mix_norm, w_in, cmpk_pos, cmpk_w1, cmpk_w2, cmpv_pos, cmpv_w1, cmpv_w2, w_branch_nsa, w_branch_moba, w_out, ffn2_norm, ffn2_wg, ffn2_wu, ffn2_wd, final_norm):
    for l in range(DEPTH):
        x = x + 0.5 * _swiglu(_rms(x, ffn1_norm[l]), ffn1_wg[l], ffn1_wu[l], ffn1_wd[l])
        h = _rms(x, mix_norm[l])
        (q_a, g_a, kc, vc, ks_, vs_, kw, vw, q_b, k_b, v_b, gate_a, gate_b) = _split_cols(h @ w_in[l])
        y_a = _nsa(q_a, g_a, kc, vc, ks_, vs_, kw, vw, cmpk_pos[l], cmpk_w1[l], cmpk_w2[l], cmpv_pos[l], cmpv_w1[l], cmpv_w2[l]) @ w_branch_nsa[l]
        y_b = _moba(q_b, k_b, v_b) @ w_branch_moba[l]
        merged = jax.nn.sigmoid(gate_a) * y_a + jax.nn.sigmoid(gate_b) * y_b
        x = x + merged @ w_out[l]
        x = x + 0.5 * _swiglu(_rms(x, ffn2_norm[l]), ffn2_wg[l], ffn2_wu[l], ffn2_wd[l])
    return _rms(x, final_norm)
```

```cpp
#include <hip/hip_runtime.h>
#include <cstdio>
#include <cstdint>
namespace pg8 {
#define PG8_LAS __attribute__((address_space(3)))
typedef unsigned short bf16_t;
typedef short bf16x8 __attribute__((ext_vector_type(8)));
typedef float f32x4 __attribute__((ext_vector_type(4)));
typedef unsigned u32x4 __attribute__((ext_vector_type(4)));
constexpr int BM = 256, BK = 64, HALF = 128, HTB = HALF * BK * 2  , STAGE_BYTES = 8 * HTB, NXCD = 8, WGM = 8;

__host__ __device__ __forceinline__ int lds_byte(int r, int c) { const int st = (r >> 4) * 2 + (c >> 5), rr = r & 15, cc = c & 31, ob = rr * 64 + cc * 2; return st * 1024 + (ob ^ (((ob >> 9) & 1) << 5)); }
__host__ __device__ __forceinline__ void stage_rc(int b, int& R, int& C) { const int st = b / 1024, sb = b % 1024, swz = sb ^ (((sb >> 9) & 1) << 5); R = (st >> 1) * 16 + swz / 64; C = (st & 1) * 32 + (swz % 64) / 2; }
__host__ __device__ __forceinline__ int perm32(int rho) { const int n = rho >> 4, i = rho & 15; return 8 * (i >> 2) + 4 * n + (i & 3); }

struct Unit { int pm, pn; };
struct Gemm { const bf16_t* A; const bf16_t* Bt; int M, N, K; size_t abgap; };

struct StaticOrder {
    int nM, nN, nwg, G, c;
    __host__ __device__ void init(int M, int N, int G_, int c_) { nM = M / BM; nN = N / BM; nwg = nM * nN; G = G_; c = c_; }
    __host__ __device__ bool next(int i, Unit& u) const {
        const long L = (long)i * G + c; if (L >= nwg) return false;
        int wgid = (int)L; { const int q = nwg / NXCD, r = nwg % NXCD, xcd = wgid % NXCD, off = wgid / NXCD; wgid = (xcd < r ? xcd * (q + 1) : r * (q + 1) + (xcd - r) * q) + off; }
        const int nig = WGM * nN, gid = wgid / nig, fm = gid * WGM, gsz = (nM - fm) < WGM ? (nM - fm) : WGM;
        u.pm = fm + ((wgid % nig) % gsz); u.pn = (wgid % nig) / gsz; return true;
    }
    __device__ __forceinline__ void a_ready(const Unit&) const {}
    __device__ __forceinline__ void done(const Unit&) const {}
};

typedef unsigned u32x2 __attribute__((ext_vector_type(2)));
typedef float pk_f32x2 __attribute__((ext_vector_type(2)));
typedef __bf16 pk_bf16x2 __attribute__((ext_vector_type(2)));
__device__ __forceinline__ unsigned cvt_pk_bf16(float lo, float hi) { const pk_f32x2 v = {lo, hi}; const pk_bf16x2 b = __builtin_convertvector(v, pk_bf16x2); return __builtin_bit_cast(unsigned, b); }
__device__ __forceinline__ float rstd_of(const float* rowss, int row) { const f32x4 a = *(const __attribute__((address_space(1))) f32x4*)(rowss + (size_t)row * 4); return __builtin_amdgcn_rsqf(((a[0] + a[1]) + (a[2] + a[3])) * (1.0f / 1024.0f) + 1e-6f); }
__device__ __forceinline__ void rstd8(const float* rowss, int row0, float (&rs)[2][4]) {
    f32x4 a[2][4];
#pragma unroll
    for (int ai = 0; ai < 2; ++ai)
#pragma unroll
        for (int m = 0; m < 4; ++m) a[ai][m] = *(const __attribute__((address_space(1))) f32x4*)(rowss + (size_t)(row0 + ai * HALF + m * 16) * 4);
    __builtin_amdgcn_sched_barrier(0);
#pragma unroll
    for (int ai = 0; ai < 2; ++ai)
#pragma unroll
        for (int m = 0; m < 4; ++m) rs[ai][m] = __builtin_amdgcn_rsqf(((a[ai][m][0] + a[ai][m][1]) + (a[ai][m][2] + a[ai][m][3])) * (1.0f / 1024.0f) + 1e-6f);
}
__device__ __forceinline__ float sigm(float v) { return __builtin_amdgcn_rcpf(1.0f + __builtin_amdgcn_exp2f(-1.4426950408889634f * v)); }
__device__ __forceinline__ float bfl(unsigned w) { return __uint_as_float(w << 16); }
__device__ __forceinline__ float bfh(unsigned w) { return __uint_as_float(w & 0xffff0000u); }

struct EpiSwiglu {
    static constexpr bool PERM = false, AFTER_DRAIN = false, HAS_MID = false;
    bf16_t* H; const float* rowss;
    __device__ __forceinline__ void operator()(const f32x4 (&acc)[2][2][4][2], const Unit& u, int wr, int wc, int fr, int fq) const {
        const int row0 = u.pm * BM + wr * 64 + fr, col0 = u.pn * 128 + wc * 32 + 8 * fq;
        float rsa[2][4]; rstd8(rowss, row0, rsa);
#pragma unroll
        for (int ai = 0; ai < 2; ++ai)
#pragma unroll
            for (int m = 0; m < 4; ++m) { const int row = row0 + ai * HALF + m * 16; const float rs = rsa[ai][m];
                float hv[8];
#pragma unroll
                for (int n = 0; n < 2; ++n)
#pragma unroll
                    for (int i = 0; i < 4; ++i) { const float g = acc[ai][0][m][n][i] * rs, uu = acc[ai][1][m][n][i] * rs; hv[4 * n + i] = g * uu * sigm(g); }
                u32x4 w; w.x = cvt_pk_bf16(hv[0], hv[1]); w.y = cvt_pk_bf16(hv[2], hv[3]); w.z = cvt_pk_bf16(hv[4], hv[5]); w.w = cvt_pk_bf16(hv[6], hv[7]);
                *(u32x4*)(H + (size_t)(row >> 11) * (size_t)10526720 + (size_t)(row & 2047) * 2816 + col0) = w; asm volatile("" ::: "memory"); }
    }
};
struct EpiResid {
    static constexpr bool PERM = false, AFTER_DRAIN = false, HAS_MID = false;
    bf16_t* XB; float* rowss; float alpha; PG8_LAS float* ssl;
    __device__ __forceinline__ void operator()(const f32x4 (&acc)[2][2][4][2], const Unit& u, int wr, int wc, int fr, int fq) const {
        const int row0 = u.pm * BM + wr * 64 + fr, col0 = u.pn * BM + wc * 32 + 4 * fq;
        u32x2 xo[2][4][2][2];
#pragma unroll
        for (int ai = 0; ai < 2; ++ai)
#pragma unroll
            for (int m = 0; m < 4; ++m)
#pragma unroll
                for (int bj = 0; bj < 2; ++bj)
#pragma unroll
                    for (int n = 0; n < 2; ++n) xo[ai][m][bj][n] = *(const __attribute__((address_space(1))) u32x2*)(XB + (size_t)(row0 + ai * HALF + m * 16) * 1024 + col0 + bj * HALF + n * 16);
        __builtin_amdgcn_sched_barrier(0);
#pragma unroll
        for (int ai = 0; ai < 2; ++ai)
#pragma unroll
            for (int m = 0; m < 4; ++m) { const int row = row0 + ai * HALF + m * 16; const size_t off = (size_t)row * 1024 + col0; float ss = 0.f;
#pragma unroll
                for (int bj = 0; bj < 2; ++bj)
#pragma unroll
                    for (int n = 0; n < 2; ++n) { const size_t o = off + bj * HALF + n * 16; const f32x4 a = acc[ai][bj][m][n]; const u32x2 xv = xo[ai][m][bj][n];
                        const float x0 = bfl(xv.x) + a[0] * alpha, x1 = bfh(xv.x) + a[1] * alpha, x2 = bfl(xv.y) + a[2] * alpha, x3 = bfh(xv.y) + a[3] * alpha;
                        u32x2 w; w.x = cvt_pk_bf16(x0, x1); w.y = cvt_pk_bf16(x2, x3); *(__attribute__((address_space(1))) u32x2*)(XB + o) = w;
                        ss += (x0 * x0 + x1 * x1) + (x2 * x2 + x3 * x3); }
                ss += __shfl_xor(ss, 16); ss += __shfl_xor(ss, 32);
                if (fq == 0) ssl[(ai * HALF + wr * 64 + m * 16 + fr) * 4 + wc] = ss; }
        asm volatile("s_waitcnt lgkmcnt(0)" ::: "memory"); __builtin_amdgcn_s_barrier(); asm volatile("" ::: "memory");
        { const int tid = (wr * 4 + wc) * 64 + fq * 16 + fr;
          if (tid < 256) { const f32x4 p = *(const PG8_LAS f32x4*)(ssl + tid * 4); rowss[(size_t)(u.pm * BM + tid) * 4 + u.pn] = (p[0] + p[1]) + (p[2] + p[3]); } }
        asm volatile("s_waitcnt lgkmcnt(0)" ::: "memory"); __builtin_amdgcn_s_barrier(); asm volatile("" ::: "memory");
    }
};
struct EpiMergeF {
    static constexpr bool PERM = false, AFTER_DRAIN = false, HAS_MID = true; static constexpr int MID_T = 8;
    const bf16_t* GA; const bf16_t* GB; bf16_t* Mg;
    __device__ __forceinline__ void mid(f32x4 (&acc)[2][2][4][2], const Unit& u, int wr, int wc, int fr, int fq) const {
        int row0 = u.pm * BM + wr * 64 + fr, col0 = u.pn * BM + wc * 32 + 8 * fq;
        asm volatile("" : "+v"(row0), "+v"(col0));
#pragma unroll
        for (int ai = 0; ai < 2; ++ai) {
            u32x4 ga[4][2], gb[4][2];
#pragma unroll
            for (int m = 0; m < 4; ++m)
#pragma unroll
                for (int bj = 0; bj < 2; ++bj) { const int rw = row0 + ai * HALF + m * 16; const size_t o = (size_t)(rw >> 11) * (size_t)10526720 + (size_t)(rw & 2047) * 1024 + col0 + bj * HALF;
                    ga[m][bj] = *(const __attribute__((address_space(1))) u32x4*)(GA + o); gb[m][bj] = *(const __attribute__((address_space(1))) u32x4*)(GB + o); }
            __builtin_amdgcn_sched_barrier(0);
#pragma unroll
            for (int m = 0; m < 4; ++m)
#pragma unroll
                for (int bj = 0; bj < 2; ++bj) { const u32x4 a = ga[m][bj], b = gb[m][bj]; float r[8];
                    r[0] = bfl(a.x) * __builtin_amdgcn_rcpf(fmaxf(bfl(b.x), 1e-30f)); r[1] = bfh(a.x) * __builtin_amdgcn_rcpf(fmaxf(bfh(b.x), 1e-30f));
                    r[2] = bfl(a.y) * __builtin_amdgcn_rcpf(fmaxf(bfl(b.y), 1e-30f)); r[3] = bfh(a.y) * __builtin_amdgcn_rcpf(fmaxf(bfh(b.y), 1e-30f));
                    r[4] = bfl(a.z) * __builtin_amdgcn_rcpf(fmaxf(bfl(b.z), 1e-30f)); r[5] = bfh(a.z) * __builtin_amdgcn_rcpf(fmaxf(bfh(b.z), 1e-30f));
                    r[6] = bfl(a.w) * __builtin_amdgcn_rcpf(fmaxf(bfl(b.w), 1e-30f)); r[7] = bfh(a.w) * __builtin_amdgcn_rcpf(fmaxf(bfh(b.w), 1e-30f));
                    acc[ai][bj][m][0][0] *= r[0]; acc[ai][bj][m][0][1] *= r[1]; acc[ai][bj][m][0][2] *= r[2]; acc[ai][bj][m][0][3] *= r[3];
                    acc[ai][bj][m][1][0] *= r[4]; acc[ai][bj][m][1][1] *= r[5]; acc[ai][bj][m][1][2] *= r[6]; acc[ai][bj][m][1][3] *= r[7]; }
            asm volatile("" ::: "memory"); }
    }
    __device__ __forceinline__ void operator()(const f32x4 (&acc)[2][2][4][2], const Unit& u, int wr, int wc, int fr, int fq) const {
        const int row0 = u.pm * BM + wr * 64 + fr, col0 = u.pn * BM + wc * 32 + 8 * fq;
        u32x4 gb[2][4][2];
#pragma unroll
        for (int ai = 0; ai < 2; ++ai)
#pragma unroll
            for (int m = 0; m < 4; ++m)
#pragma unroll
                for (int bj = 0; bj < 2; ++bj) { const int rw = row0 + ai * HALF + m * 16; gb[ai][m][bj] = *(const __attribute__((address_space(1))) u32x4*)(GB + (size_t)(rw >> 11) * (size_t)10526720 + (size_t)(rw & 2047) * 1024 + col0 + bj * HALF); }
        __builtin_amdgcn_sched_barrier(0);
#pragma unroll
        for (int ai = 0; ai < 2; ++ai)
#pragma unroll
            for (int m = 0; m < 4; ++m) { const int row = row0 + ai * HALF + m * 16;
#pragma unroll
                for (int bj = 0; bj < 2; ++bj) { const size_t o = (size_t)(row >> 11) * (size_t)10526720 + (size_t)(row & 2047) * 1024 + col0 + bj * HALF; const u32x4 gw = gb[ai][m][bj];
                    float r[8]; const f32x4 a0 = acc[ai][bj][m][0], a1 = acc[ai][bj][m][1];
                    r[0] = fmaxf(bfl(gw.x), 1e-30f) * a0[0]; r[1] = fmaxf(bfh(gw.x), 1e-30f) * a0[1]; r[2] = fmaxf(bfl(gw.y), 1e-30f) * a0[2]; r[3] = fmaxf(bfh(gw.y), 1e-30f) * a0[3];
                    r[4] = fmaxf(bfl(gw.z), 1e-30f) * a1[0]; r[5] = fmaxf(bfh(gw.z), 1e-30f) * a1[1]; r[6] = fmaxf(bfl(gw.w), 1e-30f) * a1[2]; r[7] = fmaxf(bfh(gw.w), 1e-30f) * a1[3];
                    u32x4 w; w.x = cvt_pk_bf16(r[0], r[1]); w.y = cvt_pk_bf16(r[2], r[3]); w.z = cvt_pk_bf16(r[4], r[5]); w.w = cvt_pk_bf16(r[6], r[7]);
                    *(__attribute__((address_space(1))) u32x4*)(Mg + o) = w; } }
    }
};
constexpr float C2Q = 0.125f * 1.4426950408889634f;
enum { WT_ROPE = 0, WT_PLAIN = 1, WT_VT = 2, WT_SIG = 3, WT_GS = 4, WT_NONE = 5 };
struct WinBufs { bf16_t *QA, *QB, *KBb, *VBt, *KC, *VC, *KS, *VSt, *KW, *VWt, *GA, *GB; float* GS; };
struct EpiWin {
    static constexpr bool PERM = false, AFTER_DRAIN = false, HAS_MID = false;
    const float* rowss; const float* ropec; const float* ropes; WinBufs B;
    __device__ __forceinline__ void operator()(const f32x4 (&acc)[2][2][4][2], const Unit& u, int wr, int wc, int fr, int fq) const {
        const int row0 = u.pm * BM + wr * 64 + fr;
        float rs[2][4]; rstd8(rowss, row0, rs);
        const int hh = wc >> 1, w = wc & 1;
#pragma unroll
        for (int bj = 0; bj < 2; ++bj) {
            const int half = 2 * u.pn + bj;
            int type, nh = 8, hb = 0, cb = 0; bf16_t* dst = nullptr; float sc = 1.f;
            if (half < 4) { type = WT_ROPE; dst = B.QA; hb = 2 * half; sc = C2Q; }
            else if (half == 4) { type = WT_PLAIN; dst = B.KC; nh = 2; }
            else if (half == 5) { type = WT_PLAIN; dst = B.VC; nh = 2; }
            else if (half == 6) { type = WT_ROPE; dst = B.KS; nh = 2; }
            else if (half == 7) { type = WT_VT; dst = B.VSt; nh = 2; }
            else if (half == 8) { type = WT_ROPE; dst = B.KW; nh = 2; }
            else if (half == 9) { type = WT_VT; dst = B.VWt; nh = 2; }
            else if (half < 14) { type = WT_ROPE; dst = B.QB; hb = 2 * (half - 10); sc = C2Q; }
            else if (half < 18) { type = WT_ROPE; dst = B.KBb; hb = 2 * (half - 14); }
            else if (half < 22) { type = WT_VT; dst = B.VBt; hb = 2 * (half - 18); }
            else if (half < 30) { type = WT_SIG; dst = B.GA; cb = 128 * (half - 22); }
            else if (half < 38) { type = WT_SIG; dst = B.GB; cb = 128 * (half - 30); }
            else if (half == 38) { type = WT_GS; }
            else { type = WT_NONE; }
            const int head = hb + hh;
            if (type == WT_ROPE) {
#pragma unroll
                for (int ai = 0; ai < 2; ++ai) {
                    f32x4 cs4[4], sn4[4];
#pragma unroll
                    for (int m = 0; m < 4; ++m) { const int sp = (row0 + ai * HALF + m * 16) & 2047;
                        cs4[m] = *(const __attribute__((address_space(1))) f32x4*)(ropec + sp * 32 + 16 * w + 4 * fq); sn4[m] = *(const __attribute__((address_space(1))) f32x4*)(ropes + sp * 32 + 16 * w + 4 * fq); }
                    __builtin_amdgcn_sched_barrier(0);
#pragma unroll
                    for (int m = 0; m < 4; ++m) { const int row = row0 + ai * HALF + m * 16, b = row >> 11, s = row & 2047; const float r = rs[ai][m] * sc;
                        const f32x4 c4 = cs4[m], s4 = sn4[m];
                        const f32x4 x1 = acc[ai][bj][m][0] * r, x2 = acc[ai][bj][m][1] * r;
                        const f32x4 o1 = x1 * c4 - x2 * s4, o2 = x2 * c4 + x1 * s4;
                        bf16_t* p = dst + (size_t)b * (size_t)10526720 + ((size_t)head * 2048 + s) * 64 + 16 * w + 4 * fq;
                        u32x2 w1, w2; w1.x = cvt_pk_bf16(o1[0], o1[1]); w1.y = cvt_pk_bf16(o1[2], o1[3]); w2.x = cvt_pk_bf16(o2[0], o2[1]); w2.y = cvt_pk_bf16(o2[2], o2[3]);
                        *(u32x2*)p = w1; *(u32x2*)(p + 32) = w2; }
                    asm volatile("" ::: "memory"); }
            } else if (type == WT_PLAIN) {
#pragma unroll
                for (int ai = 0; ai < 2; ++ai)
#pragma unroll
                    for (int m = 0; m < 4; ++m) { const int row = row0 + ai * HALF + m * 16, b = row >> 11, s = row & 2047; const float r = rs[ai][m];
                        const f32x4 v0 = acc[ai][bj][m][0] * r, v1 = acc[ai][bj][m][1] * r;
                        bf16_t* p = dst + (size_t)b * (size_t)10526720 + ((size_t)head * 2048 + s) * 64 + 32 * w + 4 * fq;
                        u32x2 w1, w2; w1.x = cvt_pk_bf16(v0[0], v0[1]); w1.y = cvt_pk_bf16(v0[2], v0[3]); w2.x = cvt_pk_bf16(v1[0], v1[1]); w2.y = cvt_pk_bf16(v1[2], v1[3]);
                        *(u32x2*)p = w1; *(u32x2*)(p + 16) = w2; asm volatile("" ::: "memory"); }
            } else if (type == WT_VT) {
#pragma unroll
                for (int ai = 0; ai < 2; ++ai)
#pragma unroll
                    for (int m = 0; m < 4; ++m) { const int row = row0 + ai * HALF + m * 16, b = row >> 11, s = row & 2047; const float r = rs[ai][m];
                        bf16_t* p = dst + (size_t)b * (size_t)10526720 + ((size_t)head * 64 + 32 * w + 4 * fq) * 2048 + s;
#pragma unroll
                        for (int n = 0; n < 2; ++n) { const f32x4 v = acc[ai][bj][m][n] * r; const unsigned a = cvt_pk_bf16(v[0], v[1]), c = cvt_pk_bf16(v[2], v[3]);
                            bf16_t* q = p + (size_t)(16 * n) * 2048;
                            q[0] = (bf16_t)(a & 0xffffu); q[2048] = (bf16_t)(a >> 16); q[4096] = (bf16_t)(c & 0xffffu); q[6144] = (bf16_t)(c >> 16); } asm volatile("" ::: "memory"); }
            } else if (type == WT_SIG) {
#pragma unroll
                for (int ai = 0; ai < 2; ++ai)
#pragma unroll
                    for (int m = 0; m < 4; ++m) { const int row = row0 + ai * HALF + m * 16, b = row >> 11, s = row & 2047; const float r = rs[ai][m];
                        const f32x4 v0 = acc[ai][bj][m][0] * r, v1 = acc[ai][bj][m][1] * r;
                        u32x4 o; o.x = cvt_pk_bf16(sigm(v0[0]), sigm(v0[1])); o.y = cvt_pk_bf16(sigm(v0[2]), sigm(v0[3])); o.z = cvt_pk_bf16(sigm(v1[0]), sigm(v1[1])); o.w = cvt_pk_bf16(sigm(v1[2]), sigm(v1[3]));
                        *(u32x4*)(dst + (size_t)b * (size_t)10526720 + (size_t)s * 1024 + cb + 32 * wc + 8 * fq) = o; asm volatile("" ::: "memory"); }
            } else if (type == WT_GS) {
                if (wc == 0) {
#pragma unroll
                    for (int ai = 0; ai < 2; ++ai)
#pragma unroll
                        for (int m = 0; m < 4; ++m) { const int row = row0 + ai * HALF + m * 16; const float r = rs[ai][m];
#pragma unroll
                            for (int n = 0; n < 2; ++n) { const f32x4 v = acc[ai][bj][m][n] * r; f32x4 o; o[0] = sigm(v[0]); o[1] = sigm(v[1]); o[2] = sigm(v[2]); o[3] = sigm(v[3]);
                                *(f32x4*)(B.GS + (size_t)(row >> 11) * (size_t)5263360 + (size_t)(row & 2047) * 32 + 16 * n + 4 * fq) = o; } }
                }
            }
        }
    }
};
template <class Epi, class Sched, bool ALIGN_EPI = false, bool SP2 = false>
__device__ __forceinline__ void gemm_phase(PG8_LAS unsigned char* lds, const Gemm g, const Sched& S, const Epi& E, const int tid) {
    const int wid = __builtin_amdgcn_readfirstlane(tid >> 6), lane = tid & 63, wr = wid >> 2, wc = wid & 3, fr = lane & 15, fq = lane >> 4;
    const int K = g.K, nt = K / BK;
    unsigned voffA[2], voffB[2];
#pragma unroll
    for (int i = 0; i < 2; ++i) { int R, C; stage_rc(tid * 16 + i * 8192, R, C); const int Rb = Epi::PERM ? ((R & ~31) + perm32(R & 31)) : R;
        voffA[i] = (unsigned)(R * K + C) * 2u; voffB[i] = (unsigned)(Rb * K + C) * 2u; }
    const size_t kstep = (size_t)(BK * 2);
    const size_t hstep = (size_t)HALF * K * 2;
    const size_t tstep = 2 * hstep;
    const unsigned ldsw = (unsigned)wid * 1024u;
    const int aoff = lds_byte(wr * 64 + fr, fq * 8), boff = lds_byte(wc * 32 + fr, fq * 8);
#define PG8_SA(b, h) (((b) * 2 + (h)) * HTB)
#define PG8_SB(b, h) ((4 + (b) * 2 + (h)) * HTB)
#define PG8_STAGE(bufoff, gbase, voff) do { _Pragma("unroll") for (int _i = 0; _i < 2; ++_i) \
        __builtin_amdgcn_global_load_lds((const unsigned*)((const char*)(gbase) + (voff)[_i]), (PG8_LAS unsigned*)(lds + (bufoff) + ldsw + _i * 8192), 16, 0, 0); } while (0)
#define PG8_LDA(dst, b, h) do { _Pragma("unroll") for (int m = 0; m < 4; ++m) _Pragma("unroll") for (int k = 0; k < 2; ++k) dst[m][k] = *(const PG8_LAS bf16x8*)(lds + PG8_SA(b, h) + aoff + m * 2048 + k * 1024); } while (0)
#define PG8_LDB(dst, b, h) do { _Pragma("unroll") for (int n = 0; n < 2; ++n) _Pragma("unroll") for (int k = 0; k < 2; ++k) dst[n][k] = *(const PG8_LAS bf16x8*)(lds + PG8_SB(b, h) + boff + n * 2048 + k * 1024); } while (0)
#define PG8_MMA(ai, bj, At, Bt) do { __builtin_amdgcn_s_setprio(1); _Pragma("unroll") for (int m = 0; m < 4; ++m) _Pragma("unroll") for (int n = 0; n < 2; ++n) _Pragma("unroll") for (int k = 0; k < 2; ++k) \
        acc[ai][bj][m][n] = __builtin_amdgcn_mfma_f32_16x16x32_bf16(Bt[n][k], At[m][k], acc[ai][bj][m][n], 0, 0, 0); __builtin_amdgcn_s_setprio(0); } while (0)
#define PG8_WAIT_V(n) asm volatile("s_waitcnt vmcnt(" #n ")" ::: "memory")
#define PG8_WAIT_L(n) asm volatile("s_waitcnt lgkmcnt(" #n ")" ::: "memory")
#define PG8_BAR __builtin_amdgcn_s_barrier()
#define PG8_SCHED __builtin_amdgcn_sched_barrier(0)
    Unit cur, nxt; int ui = 0;
    if (!S.next(0, cur)) return;
    f32x4 acc[2][2][4][2];
#pragma unroll
    for (int a = 0; a < 2; ++a)
#pragma unroll
        for (int b = 0; b < 2; ++b)
#pragma unroll
            for (int m = 0; m < 4; ++m)
#pragma unroll
                for (int n = 0; n < 2; ++n) acc[a][b][m][n] = (f32x4){0.f, 0.f, 0.f, 0.f};
    bf16x8 At[4][2], B0[2][2], B1[2][2];
    const char* cA = (const char*)g.A + (size_t)cur.pm * tstep + (size_t)(cur.pm >> 3) * g.abgap; const char* cB = (const char*)g.Bt + (size_t)cur.pn * tstep;
    S.a_ready(cur);
    if constexpr (SP2) {
        PG8_STAGE(PG8_SB(0, 0), cB, voffB); PG8_STAGE(PG8_SB(0, 1), cB + hstep, voffB); PG8_STAGE(PG8_SA(0, 0), cA, voffA); PG8_STAGE(PG8_SA(0, 1), cA + hstep, voffA);
        if (wr == 1) PG8_BAR;
        PG8_WAIT_V(2); PG8_BAR;
        PG8_STAGE(PG8_SB(1, 0), cB + kstep, voffB); PG8_STAGE(PG8_SA(1, 0), cA + kstep, voffA); PG8_STAGE(PG8_SB(1, 1), cB + hstep + kstep, voffB);
        PG8_WAIT_V(6); PG8_BAR;
    } else {
        PG8_STAGE(PG8_SB(0, 0), cB, voffB); PG8_STAGE(PG8_SA(0, 0), cA, voffA); PG8_STAGE(PG8_SB(0, 1), cB + hstep, voffB); PG8_STAGE(PG8_SA(0, 1), cA + hstep, voffA);
        if (wr == 1) PG8_BAR;
        PG8_WAIT_V(4); PG8_BAR;
        PG8_STAGE(PG8_SB(1, 0), cB + kstep, voffB); PG8_STAGE(PG8_SA(1, 0), cA + kstep, voffA); PG8_STAGE(PG8_SB(1, 1), cB + hstep + kstep, voffB);
        PG8_WAIT_V(6); PG8_BAR;
    }
    for (;;) {
        const bool has_next = S.next(ui + 1, nxt);
        const char* nA = has_next ? (const char*)g.A + (size_t)nxt.pm * tstep + (size_t)(nxt.pm >> 3) * g.abgap : cA; const char* nB = has_next ? (const char*)g.Bt + (size_t)nxt.pn * tstep : cB;
        for (int t = 0; t < nt; t += 2) {
            const bool last = (t == nt - 2);
            const char* a1 = cA + (size_t)(t + 1) * kstep;
            const char* a2 = last ? nA : cA + (size_t)(t + 2) * kstep; const char* b2 = last ? nB : cB + (size_t)(t + 2) * kstep;
            const char* a3 = a2 + kstep; const char* b3 = b2 + kstep;
            if (last && has_next) S.a_ready(nxt);
            if constexpr (Epi::HAS_MID) { if (t == Epi::MID_T) { __builtin_amdgcn_sched_barrier(0); E.mid(acc, cur, wr, wc, fr, fq); __builtin_amdgcn_sched_barrier(0); } }
            if constexpr (SP2) {
            PG8_LDB(B0, 0, 0); PG8_LDB(B1, 0, 1); PG8_SCHED; PG8_LDA(At, 0, 0); PG8_STAGE(PG8_SA(1, 1), a1 + hstep, voffA);
            PG8_WAIT_V(8); PG8_WAIT_L(0); PG8_BAR; PG8_MMA(0, 0, At, B0); PG8_MMA(0, 1, At, B1); PG8_BAR; PG8_SCHED;
            PG8_LDA(At, 0, 1); PG8_STAGE(PG8_SB(0, 0), b2, voffB); PG8_STAGE(PG8_SB(0, 1), b2 + hstep, voffB); PG8_STAGE(PG8_SA(0, 0), a2, voffA);
            PG8_WAIT_V(8); PG8_WAIT_L(0); PG8_BAR; PG8_MMA(1, 0, At, B0); PG8_MMA(1, 1, At, B1); PG8_BAR; PG8_SCHED;
            PG8_LDB(B0, 1, 0); PG8_LDB(B1, 1, 1); PG8_SCHED; PG8_LDA(At, 1, 0); PG8_STAGE(PG8_SA(0, 1), a2 + hstep, voffA);
            PG8_WAIT_V(8); PG8_WAIT_L(0); PG8_BAR; PG8_MMA(0, 0, At, B0); PG8_MMA(0, 1, At, B1); PG8_BAR; PG8_SCHED;
            PG8_LDA(At, 1, 1); PG8_STAGE(PG8_SB(1, 0), b3, voffB); PG8_STAGE(PG8_SB(1, 1), b3 + hstep, voffB); PG8_STAGE(PG8_SA(1, 0), a3, voffA);
            PG8_WAIT_V(8); PG8_WAIT_L(0); PG8_BAR; PG8_MMA(1, 0, At, B0); PG8_MMA(1, 1, At, B1); PG8_BAR; PG8_SCHED;
            } else {
            PG8_LDB(B0, 0, 0); PG8_SCHED; PG8_LDA(At, 0, 0); PG8_STAGE(PG8_SA(1, 1), a1 + hstep, voffA);
            PG8_WAIT_L(8); PG8_BAR; PG8_WAIT_L(0); PG8_MMA(0, 0, At, B0); PG8_BAR; PG8_SCHED;
            PG8_LDB(B1, 0, 1); PG8_STAGE(PG8_SB(0, 0), b2, voffB);
            PG8_BAR; PG8_WAIT_L(0); PG8_MMA(0, 1, At, B1); PG8_BAR;
            PG8_LDA(At, 0, 1); PG8_STAGE(PG8_SA(0, 0), a2, voffA);
            PG8_BAR; PG8_WAIT_L(0); PG8_MMA(1, 0, At, B0); PG8_BAR; PG8_SCHED;
            PG8_STAGE(PG8_SB(0, 1), b2 + hstep, voffB);
            PG8_WAIT_V(6); PG8_BAR; PG8_MMA(1, 1, At, B1); PG8_BAR;
            PG8_LDB(B0, 1, 0); PG8_SCHED; PG8_LDA(At, 1, 0); PG8_STAGE(PG8_SA(0, 1), a2 + hstep, voffA);
            PG8_WAIT_L(8); PG8_BAR; PG8_WAIT_L(0); PG8_MMA(0, 0, At, B0); PG8_BAR; PG8_SCHED;
            PG8_LDB(B1, 1, 1); PG8_STAGE(PG8_SB(1, 0), b3, voffB);
            PG8_BAR; PG8_WAIT_L(0); PG8_MMA(0, 1, At, B1); PG8_BAR;
            PG8_LDA(At, 1, 1); PG8_STAGE(PG8_SA(1, 0), a3, voffA);
            PG8_BAR; PG8_WAIT_L(0); PG8_MMA(1, 0, At, B0); PG8_BAR; PG8_SCHED;
            PG8_STAGE(PG8_SB(1, 1), b3 + hstep, voffB);
            PG8_WAIT_V(6); PG8_BAR; PG8_MMA(1, 1, At, B1); PG8_BAR;
            }
        }
        if constexpr (ALIGN_EPI) { if (wr == 0) PG8_BAR; }
        if constexpr (!Epi::AFTER_DRAIN) { E(acc, cur, wr, wc, fr, fq); S.done(cur); }
        if (!has_next) break;
#pragma unroll
        for (int a = 0; a < 2; ++a)
#pragma unroll
            for (int b = 0; b < 2; ++b)
#pragma unroll
                for (int m = 0; m < 4; ++m)
#pragma unroll
                    for (int n = 0; n < 2; ++n) acc[a][b][m][n] = (f32x4){0.f, 0.f, 0.f, 0.f};
        cur = nxt; cA = nA; cB = nB; ++ui;
        if constexpr (ALIGN_EPI) { if (wr == 1) PG8_BAR; }
    }
    PG8_WAIT_V(0);
    if constexpr (!ALIGN_EPI) { if (wr == 0) PG8_BAR; }
    PG8_BAR;
    if constexpr (Epi::AFTER_DRAIN) { E.fused(acc, cur, wr, wc, fr, fq, lds, wid, lane); S.done(cur); }
#undef PG8_SA
#undef PG8_SB
#undef PG8_STAGE
#undef PG8_LDA
#undef PG8_LDB
#undef PG8_MMA
#undef PG8_WAIT_V
#undef PG8_WAIT_L
#undef PG8_BAR
#undef PG8_SCHED
}
}
constexpr int NB = 8, SEQ = 2048, DM = 1024, MT = NB * SEQ, DFF = 2816, INC = 4888, NWIN = 5120, NUP = 2 * DFF;
constexpr int NWAVES = 8;
typedef unsigned short bf16;
typedef float f32x4 __attribute__((ext_vector_type(4)));
typedef unsigned v4u __attribute__((ext_vector_type(4)));
typedef unsigned v2u __attribute__((ext_vector_type(2)));
#define LAS __attribute__((address_space(3)))
#define GAS __attribute__((address_space(1)))
typedef GAS unsigned gu32;
#define RLX_AGENT __ATOMIC_RELAXED, __HIP_MEMORY_SCOPE_AGENT
#define LDS_WAIT() asm volatile("s_waitcnt lgkmcnt(0)" ::: "memory")
#define VM_WAIT() asm volatile("s_waitcnt vmcnt(0)" ::: "memory")
constexpr size_t MiB = 1u << 20;
constexpr size_t WS_CTL = 0, CTL_ZERO_BYTES = 64 * 1024;
constexpr size_t WS_ROPEC = 1 * MiB, WS_ROPES = 1 * MiB + 256 * 1024;
constexpr size_t WS_ROWSS = 1 * MiB + 512 * 1024;
constexpr size_t WS_KCB = 2 * MiB + 512 * 1024, WS_VCBT = WS_KCB + 256 * 1024;
constexpr size_t WS_CBIAS = 3 * MiB + 512 * 1024;
constexpr size_t WS_W2TK = 3 * MiB + 576 * 1024, WS_W2TV = 3 * MiB + 592 * 1024;
constexpr size_t WS_W1TK = 51 * MiB, WS_W1TV = 51 * MiB + 512 * 1024;
constexpr size_t WS_WUP1 = 4 * MiB, WS_WDN1 = 15 * MiB, WS_WIN = 20 * MiB + 512 * 1024, WS_WPA = 30 * MiB + 512 * 1024  ,
                 WS_WOUT = 32 * MiB + 512 * 1024, WS_WUP2 = 34 * MiB + 512 * 1024, WS_WDN2 = 45 * MiB + 512 * 1024;
constexpr size_t WS_XB = 52 * MiB;
constexpr size_t WS_ARENA = 84 * MiB, ARENA_B = 20 * MiB + 80 * 1024  , ARENA_E = ARENA_B / 2;
constexpr size_t A_QA = 0, A_QB = 2 * MiB, A_KB = 4 * MiB, A_VBT = 6 * MiB, A_KC = 8 * MiB, A_VC = 8 * MiB + 512 * 1024, A_KS = 9 * MiB, A_VST = 9 * MiB + 512 * 1024,
                 A_KW = 10 * MiB, A_VWT = 10 * MiB + 512 * 1024, A_GA = 11 * MiB, A_GB = 15 * MiB, A_GS = 19 * MiB;
constexpr size_t A_H = 0;
constexpr size_t A_MRG = 2 * MiB;
constexpr size_t OUT_BATCH_E = 4 * MiB;
constexpr size_t WS_END = WS_ARENA + 8 * ARENA_B;
constexpr int RING_BYTES = 131072, LDSCTL_OFF = RING_BYTES, MISC_OFF = LDSCTL_OFF + 320, LDS_BYTES = 147456;

enum { PH_CONV = 0, PH_UP1, PH_DN1, PH_WIN, PH_CMP, PH_ATT, PH_MRG, PH_OUT, PH_UP2, PH_DN2, PH_PER_LAYER };
constexpr int PH_NORM = 2 * PH_PER_LAYER, PH_TOTAL = PH_NORM + 1;

struct Args { const float* in[21]; float* out; unsigned char* ws; int ph_lo, ph_hi; };
static_assert(sizeof(Args) == 21 * 8 + 8 + 8 + 8, "no padding in Args");
enum { I_X = 0, I_F1N, I_F1G, I_F1U, I_F1D, I_MIXN, I_WIN, I_CKP, I_CKW1, I_CKW2, I_CVP, I_CVW1, I_CVW2, I_WBA, I_WBB, I_WOUT, I_F2N, I_F2G, I_F2U, I_F2D, I_FINN };

struct Frame {
    LAS unsigned char* lds; gu32* ctl; unsigned char* ws;
    int tid, lane, wave, G, bx, wave_s;
};
__device__ __forceinline__ int fresh_tid(int wave_s) { unsigned z = 0u; asm volatile("" : "+s"(z)); int t = wave_s * 64 + (int)__builtin_amdgcn_mbcnt_hi(~0u, __builtin_amdgcn_mbcnt_lo(~0u, z)); asm volatile("" : "+v"(t)); return t; }
__device__ __forceinline__ void frame_refresh(Frame& F) { asm volatile("" : "+v"(F.tid)); F.lane = F.tid & 63; F.wave = __builtin_amdgcn_readfirstlane(F.tid >> 6); }
__device__ __forceinline__ float wave_sum(float v) {
#pragma unroll
    for (int o = 1; o < 64; o <<= 1) v += __shfl_xor(v, o);
    return v;
}
__device__ __forceinline__ unsigned f2bf(float f) { unsigned u = __builtin_bit_cast(unsigned, f); return (u + 0x7fffu + ((u >> 16) & 1u)) >> 16; }
__device__ __forceinline__ unsigned pk2(float lo, float hi) { return f2bf(lo) | (f2bf(hi) << 16); }
__device__ __forceinline__ float bf2f(bf16 h) { return __uint_as_float((unsigned)h << 16); }
__host__ __device__ __forceinline__ int perm32i(int rho) { const int n = rho >> 4, i = rho & 15; return 8 * (i >> 2) + 4 * n + (i & 3); }

enum { CV_UP = 0, CV_NAT = 1, CV_WIN = 2, CV_P32 = 3 };
__device__ __forceinline__ int win_src_col(int rho) {
    const int half = rho >> 7, p = rho & 127;
    const int hh = p >> 6, q = p & 63, dim = 16 * (q >> 5) + (q & 15) + 32 * ((q >> 4) & 1);
    const int rp = 64 * hh + dim, pp = (p & ~31) + perm32i(p & 31);
    if (half < 4) return 128 * half + rp;
    if (half == 4) return 536 + p;
    if (half == 5) return 664 + p;
    if (half == 6) return 792 + rp;
    if (half == 7) return 920 + p;
    if (half == 8) return 1048 + rp;
    if (half == 9) return 1176 + p;
    if (half < 14) return 1304 + 128 * (half - 10) + rp;
    if (half < 18) return 1816 + 128 * (half - 14) + rp;
    if (half < 22) return 2328 + 128 * (half - 18) + p;
    if (half < 30) return 2840 + 128 * (half - 22) + pp;
    if (half < 38) return 3864 + 128 * (half - 30) + pp;
    if (half == 38) return p < 24 ? 512 + p : -1;
    return -1;
}
struct ConvJob { const float* W0; const float* W1; const float* gain; bf16* dst; int K, Nsrc, Ndst, kind, items, dpitch, koff; };
__device__ __forceinline__ int win_block_col(int r0, int& nvalid) {
    const int half = r0 >> 7, p0 = r0 & 127; nvalid = 64;
    if (half < 4) return 128 * half + p0;
    if (half == 4) return 536 + p0;
    if (half == 5) return 664 + p0;
    if (half == 6) return 792 + p0;
    if (half == 7) return 920 + p0;
    if (half == 8) return 1048 + p0;
    if (half == 9) return 1176 + p0;
    if (half < 14) return 1304 + 128 * (half - 10) + p0;
    if (half < 18) return 1816 + 128 * (half - 14) + p0;
    if (half < 22) return 2328 + 128 * (half - 18) + p0;
    if (half < 30) return 2840 + 128 * (half - 22) + p0;
    if (half < 38) return 3864 + 128 * (half - 30) + p0;
    if (half == 38 && p0 == 0) { nvalid = 24; return 512; }
    nvalid = 0; return 0;
}
struct ConvRegs { f32x4 v[16]; f32x4 g0, g1; };
__device__ __forceinline__ int conv_swz(int k) { return ((k & 7) ^ (k >> 3)) & 7; }
__device__ __forceinline__ void conv_item(const ConvJob& J, int item, int& kb, int& rb) {
    const int nrb = J.Ndst / 64;
    if ((nrb & 3) == 0 && ((J.K / 64) & 1) == 0) { const int blk = item >> 3, q = nrb >> 2; rb = 4 * (blk % q) + (item & 3); kb = 2 * (blk / q) + ((item >> 2) & 1); }
    else { kb = item / nrb; rb = item % nrb; }
}
__device__ __forceinline__ void conv_load(const ConvJob& J, int item, int lane, ConvRegs& R) {
    int kb, rb; conv_item(J, item, kb, rb); const int k0 = 64 * kb, r0 = 64 * rb;
    const float* W = J.W0; int c0, nvalid = 64;
    if (J.kind == CV_UP) { const int pn = r0 >> 8, bj = (r0 >> 7) & 1; c0 = 128 * pn + (r0 & 127); if (bj) W = J.W1; }
    else if (J.kind == CV_WIN) c0 = win_block_col(r0, nvalid);
    else c0 = r0;
    const int kr = lane >> 4, c4 = lane & 15;
#pragma unroll
    for (int i = 0; i < 16; ++i) R.v[i] = (f32x4){0.f, 0.f, 0.f, 0.f};
    R.g0 = (f32x4){1.f, 1.f, 1.f, 1.f}; R.g1 = R.g0;
    if (J.gain) { const GAS f32x4* gp = (const GAS f32x4*)(J.gain + k0 + 8 * (lane & 7)); R.g0 = gp[0]; R.g1 = gp[1]; }
    if (4 * c4 < nvalid) {
#pragma unroll
        for (int i = 0; i < 16; ++i) R.v[i] = __builtin_nontemporal_load((const GAS f32x4*)(W + (size_t)(k0 + 4 * i + kr) * J.Nsrc + c0 + 4 * c4));
    }
}
__device__ __forceinline__ void conv_emit(const ConvJob& J, int item, LAS float* scr, int lane, const ConvRegs& R) {
    int kb, rb; conv_item(J, item, kb, rb); const int k0 = 64 * kb, r0 = 64 * rb;
    int c0 = r0, nvalid = 64;
    if (J.kind == CV_UP) c0 = 128 * (r0 >> 8) + (r0 & 127);
    else if (J.kind == CV_WIN) c0 = win_block_col(r0, nvalid);
    const int kr = lane >> 4, c4 = lane & 15;
#pragma unroll
    for (int i = 0; i < 16; ++i) { const int k = 4 * i + kr;
        *(LAS f32x4*)(scr + k * 64 + 4 * (c4 ^ conv_swz(k))) = R.v[i]; }
    LDS_WAIT(); asm volatile("" ::: "memory");
}
__device__ __forceinline__ void conv_emit_b(const ConvJob& J, int item, LAS float* scr, int lane, const ConvRegs& R) {
    int kb, rb; conv_item(J, item, kb, rb); const int k0 = 64 * kb, r0 = 64 * rb;
    int c0 = r0, nvalid = 64;
    if (J.kind == CV_UP) c0 = 128 * (r0 >> 8) + (r0 & 127);
    else if (J.kind == CV_WIN) c0 = win_block_col(r0, nvalid);
#pragma unroll
    for (int e = 0; e < 8; ++e) { const int id = lane + 64 * e, n = id >> 3, c = id & 7, rho = r0 + n; int sc;
        if (J.kind == CV_UP) { const int p = rho & 127; sc = ((p & ~31) + perm32i(p & 31)) - (r0 & 127); }
        else if (J.kind == CV_NAT) sc = n;
        else if (J.kind == CV_P32) sc = ((rho & ~31) + perm32i(rho & 31)) - r0;
        else { const int col = win_src_col(rho); sc = col >= 0 ? col - c0 : -1; }
        v4u o = {0u, 0u, 0u, 0u};
        if (sc >= 0) { float f[8];
#pragma unroll
            for (int i = 0; i < 8; ++i) { const int k = 8 * c + i; f[i] = scr[k * 64 + 4 * ((sc >> 2) ^ conv_swz(k)) + (sc & 3)] * (i < 4 ? R.g0[i & 3] : R.g1[i & 3]); }
            o.x = pk2(f[0], f[1]); o.y = pk2(f[2], f[3]); o.z = pk2(f[4], f[5]); o.w = pk2(f[6], f[7]); }
        *(GAS v4u*)(J.dst + (size_t)rho * J.dpitch + J.koff + k0 + 8 * c) = o; }
    LDS_WAIT(); asm volatile("" ::: "memory");
}
__device__ __forceinline__ unsigned topk16_mask(const float (&v)[32]) { unsigned msk = 0;
#pragma unroll
    for (int j = 0; j < 32; ++j) { int rank = 0;
#pragma unroll
        for (int i = 0; i < 32; ++i) rank += (v[i] > v[j] || (v[i] == v[j] && i < j)) ? 1 : 0;
        if (rank < 16) msk |= (1u << j); }
    return msk; }
#define XB_TMO      128
#define XB_XCNT(j)  (256  + 64 * (j))
#define XB_XSUB(j)  (1280 + 64 * (j))
#define XB_XGEN(j)  (2304 + 64 * (j))
#define XB_TOP      3328
#define XB_TOPGEN   3392
#define XCD_BAR_WORDS 3456
#define XB_LSUB(j)  (3584 + 64 * (j))
#define XB_LGEN(j)  (4608 + 64 * (j))
#define XB_XTAB     5632
#define XB_TSUB(t)  (6400 + 32 * (t))
#define XB_TGEN(t)  (6416 + 32 * (t))
#define XB_SPIN_CAP (1u << 18)

__device__ __forceinline__ unsigned xb_ld(unsigned* p)              { return __hip_atomic_load(p, __ATOMIC_RELAXED, __HIP_MEMORY_SCOPE_AGENT); }
__device__ __forceinline__ unsigned xb_add(unsigned* p, unsigned v) { return __hip_atomic_fetch_add(p, v, __ATOMIC_RELAXED, __HIP_MEMORY_SCOPE_AGENT); }
__device__ __forceinline__ unsigned xb_xcc_id() { return (unsigned)__builtin_amdgcn_s_getreg((3 << 11) | 20) & 0xFu; }
#define XB_SPIN(cond, bar) do { unsigned _sp = 0; while (cond) { __builtin_amdgcn_s_sleep(1); \
    if ((++_sp & 255u) == 0u) { if (xb_ld(&(bar)[XB_TMO])) break; if (_sp > XB_SPIN_CAP) { atomicAdd(&(bar)[XB_TMO], 1u); break; } } } } while (0)

struct XcdBarrier {
    unsigned* bar; unsigned x;
    volatile LAS unsigned* st;
};

__device__ __forceinline__ XcdBarrier xcd_barrier_post(unsigned* bar, volatile LAS unsigned* st) {
    XcdBarrier b; b.bar = bar; b.x = xb_xcc_id(); b.st = st;
    if (threadIdx.x == 0) { (void)xb_add(&bar[XB_XCNT(b.x)], 1u); __hip_atomic_store(&bar[XB_XTAB + blockIdx.x], b.x + 1u, __ATOMIC_RELAXED, __HIP_MEMORY_SCOPE_AGENT); }
    return b;
}
__device__ __forceinline__ void xcd_barrier_complete(unsigned* bar, unsigned x, unsigned& nloc, unsigned& nx) {
    const unsigned G = gridDim.x * gridDim.y * gridDim.z;
    unsigned sum, cnt, mine, sp = 0u;
    for (;;) {
        sum = 0u; cnt = 0u; mine = 0u;
#pragma unroll
        for (unsigned j = 0; j < 16; ++j) { const unsigned c = xb_ld(&bar[XB_XCNT(j)]); sum += c; cnt += (c > 0u) ? 1u : 0u; mine = (j == x) ? c : mine; }
        if (sum == G) break;
        __builtin_amdgcn_s_sleep(1);
        if ((++sp & 255u) == 0u) { if (xb_ld(&bar[XB_TMO])) break; if (sp > XB_SPIN_CAP) { atomicAdd(&bar[XB_TMO], 1u); break; } }
    }
    nloc = mine > 0u ? mine : 1u; nx = cnt > 0u ? cnt : 1u;
}

__device__ __forceinline__ void xcd_barrier(const XcdBarrier& b, const bool leader, const bool release_l2 = true) {
    asm volatile("s_waitcnt vmcnt(0)" ::: "memory");
    __syncthreads();
    if (leader) {
        unsigned* bar = b.bar;
        __builtin_amdgcn_s_waitcnt(0);
        unsigned nloc = b.st[0], nx = b.st[1];
        if (nloc == 0u) { xcd_barrier_complete(bar, b.x, nloc, nx); b.st[0] = nloc; b.st[1] = nx; }
        const unsigned old = xb_add(&bar[XB_XSUB(b.x)], 1u);
        const unsigned gen = old / nloc;
        if (old + 1u == (gen + 1u) * nloc) {
            if (release_l2) __builtin_amdgcn_fence(__ATOMIC_RELEASE, "agent");
            asm volatile("s_waitcnt vmcnt(0)" ::: "memory");
            const unsigned og = xb_add(&bar[XB_TOP], 1u);
            const unsigned tg = og / nx;
            if (og + 1u == (tg + 1u) * nx) xb_add(&bar[XB_TOPGEN], 1u);
            else XB_SPIN(xb_ld(&bar[XB_TOPGEN]) == tg, bar);
            __builtin_amdgcn_fence(__ATOMIC_ACQUIRE, "agent");
            xb_add(&bar[XB_XGEN(b.x)], 1u);
            asm volatile("s_waitcnt vmcnt(0)" ::: "memory");
        } else {
            XB_SPIN(xb_ld(&bar[XB_XGEN(b.x)]) == gen, bar);
            __builtin_amdgcn_fence(__ATOMIC_ACQUIRE, "agent");
            asm volatile("s_waitcnt vmcnt(0)" ::: "memory");
        }
    }
    __syncthreads();
}

__device__ __forceinline__ void group_barrier(const XcdBarrier& b, const bool leader, const unsigned grp, const unsigned nloc) {
    asm volatile("s_waitcnt vmcnt(0)" ::: "memory");
    __syncthreads();
    if (leader) {
        unsigned* bar = b.bar;
        __builtin_amdgcn_s_waitcnt(0);
        asm volatile("buffer_inv sc1" ::: "memory");
        const unsigned old = xb_add(&bar[XB_LSUB(grp)], 1u);
        const unsigned gen = old / nloc;
        if (old + 1u == (gen + 1u) * nloc) xb_add(&bar[XB_LGEN(grp)], 1u);
        else XB_SPIN(xb_ld(&bar[XB_LGEN(grp)]) == gen, bar);
        asm volatile("s_waitcnt vmcnt(0)" ::: "memory");
    }
    __syncthreads();
}
__device__ __forceinline__ void team_barrier(const XcdBarrier& b, const bool leader, const unsigned team) {
    asm volatile("s_waitcnt vmcnt(0)" ::: "memory");
    __syncthreads();
    if (leader) {
        unsigned* bar = b.bar;
        __builtin_amdgcn_s_waitcnt(0);
        asm volatile("buffer_inv sc1" ::: "memory");
        const unsigned old = xb_add(&bar[XB_TSUB(team)], 1u);
        const unsigned gen = old >> 2;
        if ((old & 3u) == 3u) xb_add(&bar[XB_TGEN(team)], 1u);
        else XB_SPIN(xb_ld(&bar[XB_TGEN(team)]) == gen, bar);
        asm volatile("s_waitcnt vmcnt(0)" ::: "memory");
    }
    __syncthreads();
}
__device__ __forceinline__ bool colocal_check(const XcdBarrier& b, volatile LAS unsigned* flag, int tid) {
    if (tid < 64) {
        bool ok = (gridDim.x == 256u);
        if (ok) {
#pragma unroll
            for (int r = 0; r < 4; ++r) { const unsigned t = (unsigned)tid + 64u * r; const unsigned v = xb_ld(&b.bar[XB_XTAB + t]), rep = xb_ld(&b.bar[XB_XTAB + (t & 7u)]); ok = ok && (v != 0u) && (v == rep); }
            if (tid < 8) { const unsigned mine = xb_ld(&b.bar[XB_XTAB + tid]);
#pragma unroll
                for (int u = 0; u < 8; ++u) { const unsigned o = xb_ld(&b.bar[XB_XTAB + u]); if (u != tid && o == mine) ok = false; } }
        }
        const bool all = (__ballot(ok) == ~0ull);
        if (tid == 0) flag[0] = all ? 1u : 2u;
    }
    __syncthreads();
    return flag[0] == 1u;
}
__device__ __forceinline__ void phase_conv(Frame& F, const Args& A, int l) {
    frame_refresh(F);
    LAS float* scr = (LAS float*)(F.lds + F.wave * 16384);
    const int gw = F.bx * NWAVES + F.wave, NGW = F.G * NWAVES;
    unsigned char* ws = F.ws;
    const size_t LU = (size_t)DM * DFF, LW = (size_t)DM * INC, LB = (size_t)512 * DM, LO = (size_t)DM * DM;
    auto job = [&](int j) -> ConvJob {
        switch (j) {
        case 0: return ConvJob{A.in[I_F1G] + l * LU, A.in[I_F1U] + l * LU, A.in[I_F1N] + l * DM, (bf16*)(ws + WS_WUP1), DM, DFF, NUP, CV_UP, (DM / 64) * (NUP / 64), DM, 0};
        case 1: return ConvJob{A.in[I_F1D] + l * LU, nullptr, nullptr, (bf16*)(ws + WS_WDN1), DFF, DM, DM, CV_NAT, (DFF / 64) * (DM / 64), DFF, 0};
        case 2: return ConvJob{A.in[I_WIN] + l * LW, nullptr, A.in[I_MIXN] + l * DM, (bf16*)(ws + WS_WIN), DM, INC, NWIN, CV_WIN, (DM / 64) * (NWIN / 64), DM, 0};
        case 3: return ConvJob{A.in[I_WBA] + l * LB, nullptr, nullptr, (bf16*)(ws + WS_WPA), 512, DM, DM, CV_P32, (512 / 64) * (DM / 64), 1024, 0};
        case 4: return ConvJob{A.in[I_WBB] + l * LB, nullptr, nullptr, (bf16*)(ws + WS_WPA), 512, DM, DM, CV_P32, (512 / 64) * (DM / 64), 1024, 512};
        case 5: return ConvJob{A.in[I_WOUT] + l * LO, nullptr, nullptr, (bf16*)(ws + WS_WOUT), DM, DM, DM, CV_NAT, (DM / 64) * (DM / 64), DM, 0};
        case 6: return ConvJob{A.in[I_F2G] + l * LU, A.in[I_F2U] + l * LU, A.in[I_F2N] + l * DM, (bf16*)(ws + WS_WUP2), DM, DFF, NUP, CV_UP, (DM / 64) * (NUP / 64), DM, 0};
        case 7: return ConvJob{A.in[I_F2D] + l * LU, nullptr, nullptr, (bf16*)(ws + WS_WDN2), DFF, DM, DM, CV_NAT, (DFF / 64) * (DM / 64), DFF, 0};
        case 8: return ConvJob{A.in[I_CKW1] + (size_t)l * 2048 * 128, nullptr, nullptr, (bf16*)(ws + WS_W1TK), 2048, 128, 128, CV_NAT, (2048 / 64) * (128 / 64), 2048, 0};
        case 9: return ConvJob{A.in[I_CVW1] + (size_t)l * 2048 * 128, nullptr, nullptr, (bf16*)(ws + WS_W1TV), 2048, 128, 128, CV_NAT, (2048 / 64) * (128 / 64), 2048, 0};
        case 10: return ConvJob{A.in[I_CKW2] + (size_t)l * 128 * 64, nullptr, nullptr, (bf16*)(ws + WS_W2TK), 128, 64, 64, CV_NAT, 2, 128, 0};
        default: return ConvJob{A.in[I_CVW2] + (size_t)l * 128 * 64, nullptr, nullptr, (bf16*)(ws + WS_W2TV), 128, 64, 64, CV_NAT, 2, 128, 0};
        }
    };
    constexpr int NI[12] = {(DM / 64) * (NUP / 64), (DFF / 64) * (DM / 64), (DM / 64) * (NWIN / 64), (512 / 64) * (DM / 64), (512 / 64) * (DM / 64), (DM / 64) * (DM / 64), (DM / 64) * (NUP / 64), (DFF / 64) * (DM / 64), 64, 64, 2, 2};
    int total = 0;
#pragma unroll
    for (int j = 0; j < 12; ++j) total += NI[j];
    auto locate = [&](int it, int& jj, int& r) { r = it; jj = 11;
#pragma unroll
        for (int j = 0; j < 12; ++j) { if (jj == 11 && j < 11 && r < NI[j]) jj = j; else if (jj == 11 && j < 11) r -= NI[j]; } };
    int it = gw; bool have = it < total; ConvRegs cur; int jc = 0, rc = 0;
    if (have) { locate(it, jc, rc); const ConvJob Jc = job(jc); conv_load(Jc, rc, F.lane, cur); }
    while (have) {
        const int nit = it + NGW; const bool hn = nit < total; ConvRegs nxt; int jn = 0, rn = 0;
        { const ConvJob Jc = job(jc); conv_emit(Jc, rc, scr, F.lane, cur); }
        __builtin_amdgcn_sched_barrier(0);
        if (hn) { locate(nit, jn, rn); const ConvJob Jn = job(jn); conv_load(Jn, rn, F.lane, nxt); }
        __builtin_amdgcn_sched_barrier(0);
        { const ConvJob Jc = job(jc); conv_emit_b(Jc, rc, scr, F.lane, cur); }
        it = nit; have = hn; jc = jn; rc = rn;
        if (hn) cur = nxt;
    }
    if (F.wave == 0) for (int o = F.bx; o < 256; o += F.G) {
        const int kv = o >> 7, n = o & 127; const float* w1 = A.in[kv ? I_CVW1 : I_CKW1] + (size_t)l * 2048 * 128; const float* pos = A.in[kv ? I_CVP : I_CKP] + (size_t)l * 2048; float sacc = 0.f;
#pragma unroll 8
        for (int k = F.lane; k < 2048; k += 64) sacc += pos[k] * w1[(size_t)k * 128 + n];
        sacc = wave_sum(sacc); if (F.lane == 0) ((float*)(ws + WS_CBIAS))[o] = sacc;
    }
    if (l == 0) {
        const float* x = A.in[I_X]; bf16* XB = (bf16*)(ws + WS_XB); float* rowss = (float*)(ws + WS_ROWSS);
        for (int m0 = 4 * gw; m0 < MT; m0 += 4 * NGW) {
            f32x4 v[4][4];
#pragma unroll
            for (int rr = 0; rr < 4; ++rr) { const GAS f32x4* xr = (const GAS f32x4*)(x + (size_t)(m0 + rr) * DM) + F.lane;
#pragma unroll
                for (int j = 0; j < 4; ++j) v[rr][j] = __builtin_nontemporal_load(xr + 64 * j); }
#pragma unroll
            for (int rr = 0; rr < 4; ++rr) { const int m = m0 + rr; float s = 0.f;
#pragma unroll
                for (int j = 0; j < 4; ++j) s += (v[rr][j][0] * v[rr][j][0] + v[rr][j][1] * v[rr][j][1]) + (v[rr][j][2] * v[rr][j][2] + v[rr][j][3] * v[rr][j][3]);
                s = wave_sum(s);
                GAS v2u* o8 = (GAS v2u*)(XB + (size_t)m * DM) + F.lane;
#pragma unroll
                for (int j = 0; j < 4; ++j) { v2u w; w.x = pk2(v[rr][j][0], v[rr][j][1]); w.y = pk2(v[rr][j][2], v[rr][j][3]); o8[64 * j] = w; }
                if (F.lane < 4) rowss[(size_t)m * 4 + F.lane] = F.lane == 0 ? s : 0.f; }
        }
        float* rc = (float*)(ws + WS_ROPEC); float* rsn = (float*)(ws + WS_ROPES);
        for (int e = F.bx * 512 + F.tid; e < SEQ * 32; e += F.G * 512) { const int t = e >> 5, d = e & 31;
            const float inv = __builtin_amdgcn_exp2f(-(float)d * 0.41524101186092029f);
            const float ang = (float)t * inv;
            const float rev = ang * 0.15915494309189535f; const float fr = rev - __builtin_rintf(rev);
            rc[e] = __builtin_amdgcn_cosf(fr); rsn[e] = __builtin_amdgcn_sinf(fr); }
    }
}
__device__ __forceinline__ float gelu_tanh(float v) { const float u = 0.7978845608028654f * (v + 0.044715f * v * v * v); const float e = __builtin_amdgcn_exp2f(-2.8853900817779268f * u); return v * __builtin_amdgcn_rcpf(1.0f + e); }
__device__ __forceinline__ void phase_norm(Frame& F, const Args& A) {
    frame_refresh(F);
    const int vcu = (F.G % 8 == 0) ? (F.bx % 8) * (F.G / 8) + F.bx / 8 : F.bx; const float* g = A.in[I_FINN]; const bf16* XB = (const bf16*)(F.ws + WS_XB); const float* rowss = (const float*)(F.ws + WS_ROWSS);
    for (int v = vcu; v < 256; v += F.G) for (int r = 0; r < 8; ++r) { const int m = 2048 * (v >> 5) + 8 * (v & 31) + F.wave + 256 * r; GAS f32x4* xr = (GAS f32x4*)(A.out + (size_t)m * DM) + F.lane; f32x4 v[4];
        const GAS v2u* xb = (const GAS v2u*)(XB + (size_t)m * DM) + F.lane;
#pragma unroll
        for (int j = 0; j < 4; ++j) { const v2u w = xb[64 * j]; v[j][0] = __uint_as_float(w.x << 16); v[j][1] = __uint_as_float(w.x & 0xffff0000u); v[j][2] = __uint_as_float(w.y << 16); v[j][3] = __uint_as_float(w.y & 0xffff0000u); }
        const float rs = pg8::rstd_of(rowss, m);
#pragma unroll
        for (int j = 0; j < 4; ++j) { const f32x4 gg = *((const GAS f32x4*)g + F.lane + 64 * j); f32x4 o = v[j] * rs * gg;
            xr[64 * j] = o; } }
}
namespace fa {
typedef short bf16x8 __attribute__((ext_vector_type(8)));
typedef short s16x4 __attribute__((ext_vector_type(4)));
typedef float f32x16 __attribute__((ext_vector_type(16)));
typedef float f32x2_t __attribute__((ext_vector_type(2))); typedef __bf16 bf16x2_t __attribute__((ext_vector_type(2)));
#define FA_MFMA(a, b, c) __builtin_amdgcn_mfma_f32_32x32x16_bf16((a), (b), (c), 0, 0, 0)
constexpr float FA_THR = 6.0f, FA_NINF = -INFINITY;
__device__ __forceinline__ int crow(int r, int h) { return (r & 3) + 8 * (r >> 2) + 4 * h; }
__device__ __forceinline__ float opaque_inf() { float v = __builtin_inff(); asm volatile("" : "+s"(v)); return v; }
#define mx2(a, b) __builtin_amdgcn_fmed3f((a), (b), pinf_)
__device__ __forceinline__ unsigned cvtpk(float lo, float hi) { f32x2_t v = {lo, hi}; bf16x2_t b = __builtin_convertvector(v, bf16x2_t); return __builtin_bit_cast(unsigned, b); }
__device__ __forceinline__ float swap_max(float x) { auto rr = __builtin_amdgcn_permlane32_swap(__float_as_uint(x), __float_as_uint(x), false, false); return fmaxf(__uint_as_float(rr[0]), __uint_as_float(rr[1])); }
__device__ __forceinline__ float swap_sum(float x) { auto rr = __builtin_amdgcn_permlane32_swap(__float_as_uint(x), __float_as_uint(x), false, false); return __uint_as_float(rr[0]) + __uint_as_float(rr[1]); }
__device__ __forceinline__ float swap_other(float x, int hi) { auto rr = __builtin_amdgcn_permlane32_swap(__float_as_uint(x), __float_as_uint(x), false, false); return hi ? __uint_as_float(rr[0]) : __uint_as_float(rr[1]); }
__device__ __forceinline__ bf16x8 pack8(const f32x16& p, int s) { v4u w; w.x = cvtpk(p[8 * s], p[8 * s + 1]); w.y = cvtpk(p[8 * s + 2], p[8 * s + 3]); w.z = cvtpk(p[8 * s + 4], p[8 * s + 5]); w.w = cvtpk(p[8 * s + 6], p[8 * s + 7]); return __builtin_bit_cast(bf16x8, w); }
__device__ __forceinline__ bf16x8 vfrag(const bf16* p) { const s16x4 a = *(const GAS s16x4*)p, b = *(const GAS s16x4*)(p + 8); return (bf16x8){a[0], a[1], a[2], a[3], b[0], b[1], b[2], b[3]}; }
struct Qf { bf16x8 f[4]; };
__device__ __forceinline__ void load_rows(Qf& q, const bf16* rowp  ) {
#pragma unroll
    for (int s = 0; s < 4; ++s) q.f[s] = *(const GAS bf16x8*)(rowp + 16 * s);
}
__device__ __forceinline__ f32x16 qk_tile(const bf16* kbase, const Qf& q, const f32x16& c0, int r32, int hi) {
    Qf k; load_rows(k, kbase + r32 * 64 + hi * 8);
    f32x16 S = FA_MFMA(k.f[0], q.f[0], c0); S = FA_MFMA(k.f[1], q.f[1], S); S = FA_MFMA(k.f[2], q.f[2], S); S = FA_MFMA(k.f[3], q.f[3], S); return S;
}
__device__ __forceinline__ void pv_tile(f32x16& o0, f32x16& o1, const bf16* vbase, int vs, const f32x16& P, int r32, int hi) {
    const bf16* v0 = vbase + (size_t)r32 * vs + 4 * hi; const bf16* v1 = v0 + (size_t)32 * vs;
    const bf16x8 a00 = vfrag(v0), a01 = vfrag(v0 + 16), a10 = vfrag(v1), a11 = vfrag(v1 + 16);
    const bf16x8 p0 = pack8(P, 0), p1 = pack8(P, 1);
    o0 = FA_MFMA(a00, p0, o0); o0 = FA_MFMA(a01, p1, o0); o1 = FA_MFMA(a10, p0, o1); o1 = FA_MFMA(a11, p1, o1);
}
struct Acc { f32x16 o0, o1, negm; float m, l; bool seen; };
__device__ __forceinline__ void acc_reset(Acc& a) {
#pragma unroll
    for (int r = 0; r < 16; ++r) { a.o0[r] = 0.f; a.o1[r] = 0.f; a.negm[r] = 0.f; }
    a.m = 0.f; a.l = 0.f; a.seen = false;
}
__device__ __forceinline__ void step32(Acc& a, const Qf& q, const bf16* kbase, const bf16* vbase, int vs, int r32, int hi, bool needmask, int lo, int up, bool rowon) {
    f32x16 S = qk_tile(kbase, q, a.negm, r32, hi);
    if (needmask) {
#pragma unroll
        for (int r = 0; r < 16; ++r) { const int c = crow(r, hi); S[r] = (rowon && c >= lo && c <= up) ? S[r] : FA_NINF; }
    }
    float rm = fmaxf(fmaxf(fmaxf(S[0], S[1]), fmaxf(S[2], S[3])), fmaxf(fmaxf(S[4], S[5]), fmaxf(S[6], S[7])));
    rm = fmaxf(rm, fmaxf(fmaxf(fmaxf(S[8], S[9]), fmaxf(S[10], S[11])), fmaxf(fmaxf(S[12], S[13]), fmaxf(S[14], S[15]))));
    rm = swap_max(rm);
    const bool big = rm > (a.seen ? FA_THR : -3.0e38f);
    if (__any(big)) { const float dl = big ? rm : 0.f; a.m += dl; const float f = __builtin_amdgcn_exp2f(-dl); a.l *= f;
#pragma unroll
        for (int r = 0; r < 16; ++r) { a.o0[r] *= f; a.o1[r] *= f; S[r] -= dl; a.negm[r] = -a.m; } }
    a.seen = a.seen || (rm > -3.0e38f);
    float ps = 0.f;
#pragma unroll
    for (int r = 0; r < 16; ++r) { S[r] = __builtin_amdgcn_exp2f(S[r]); ps += S[r]; }
    a.l += ps;
    pv_tile(a.o0, a.o1, vbase, vs, S, r32, hi);
}
__device__ __forceinline__ void acc_finish(const Acc& a, f32x16& t0, f32x16& t1, float gate) {
    const float l = swap_sum(a.l); const float sc = l > 0.f ? gate * __builtin_amdgcn_rcpf(l) : 0.f;
#pragma unroll
    for (int r = 0; r < 16; ++r) { t0[r] += a.o0[r] * sc; t1[r] += a.o1[r] * sc; }
}
constexpr int L_TILE = 49152, TILE_BYTES = 16384;
struct TileRegs { v4u k, v; };
__device__ __forceinline__ void tile_issue(TileRegs& t, const bf16* kp  , const bf16* vp  , int tid) {
    t.k = *(const GAS v4u*)(kp + tid * 8); t.v = *(const GAS v4u*)(vp + (size_t)(tid >> 3) * SEQ + (tid & 7) * 8);
}
__device__ __forceinline__ void tile_commit(LAS unsigned char* buf, const TileRegs& t, int tid) {
    const int row = tid >> 3, pc = tid & 7;
    *(LAS v4u*)(buf + row * 128 + ((pc ^ ((row >> 1) & 7)) << 4)) = t.k;
    const int x = (row >> 1) & 7, g = pc >> 1, od = pc & 1; v2u lo, hi2; lo.x = t.v.x; lo.y = t.v.y; hi2.x = t.v.z; hi2.y = t.v.w;
    LAS unsigned char* vr = buf + 8192 + row * 128;
    *(LAS v2u*)(vr + (((2 * g) ^ x) << 4) + 8 * od) = lo; *(LAS v2u*)(vr + (((2 * g + 1) ^ x) << 4) + 8 * od) = hi2;
}
__device__ __forceinline__ bf16x8 lds_vfrag(const LAS unsigned char* vrow  , int c16, int x) { return *(const LAS bf16x8*)(vrow + ((c16 ^ x) << 4)); }
__device__ __forceinline__ void step32l(Acc& a, const Qf& q, const LAS unsigned char* buf, int kt, int r32, int hi, bool needmask, int lo, int up, bool rowon) {
    const float pinf_ = opaque_inf();
    const int key = 32 * kt + r32; const LAS unsigned char* kr = buf + key * 128; const int kx = (key >> 1) & 7;
    const bf16x8 k0 = *(const LAS bf16x8*)(kr + (((0 + hi) ^ kx) << 4)), k1 = *(const LAS bf16x8*)(kr + (((2 + hi) ^ kx) << 4)), k2 = *(const LAS bf16x8*)(kr + (((4 + hi) ^ kx) << 4)), k3 = *(const LAS bf16x8*)(kr + (((6 + hi) ^ kx) << 4));
    f32x16 S = FA_MFMA(k0, q.f[0], a.negm); S = FA_MFMA(k1, q.f[1], S); S = FA_MFMA(k2, q.f[2], S); S = FA_MFMA(k3, q.f[3], S);
    const LAS unsigned char* v0 = buf + 8192 + r32 * 128; const LAS unsigned char* v1 = v0 + 32 * 128; const int x0 = (r32 >> 1) & 7;
    const bf16x8 a00 = lds_vfrag(v0, 4 * kt + hi, x0), a01 = lds_vfrag(v0, 4 * kt + 2 + hi, x0), a10 = lds_vfrag(v1, 4 * kt + hi, x0), a11 = lds_vfrag(v1, 4 * kt + 2 + hi, x0);
    if (needmask) {
#pragma unroll
        for (int r = 0; r < 16; ++r) { const int c = crow(r, hi); S[r] = (rowon && c >= lo && c <= up) ? S[r] : FA_NINF; }
    }
    float rm = mx2(mx2(mx2(S[0], S[1]), mx2(S[2], S[3])), mx2(mx2(S[4], S[5]), mx2(S[6], S[7])));
    rm = mx2(rm, mx2(mx2(mx2(S[8], S[9]), mx2(S[10], S[11])), mx2(mx2(S[12], S[13]), mx2(S[14], S[15]))));
    rm = swap_max(rm);
    const bool big = rm > (a.seen ? FA_THR : -3.0e38f);
    if (__any(big)) { const float dl = big ? rm : 0.f; a.m += dl; const float f = __builtin_amdgcn_exp2f(-dl); a.l *= f;
#pragma unroll
        for (int r = 0; r < 16; ++r) { a.o0[r] *= f; a.o1[r] *= f; S[r] -= dl; a.negm[r] = -a.m; } }
    a.seen = a.seen || (rm > -3.0e38f);
    float ps = 0.f;
#pragma unroll
    for (int r = 0; r < 16; ++r) { S[r] = __builtin_amdgcn_exp2f(S[r]); ps += S[r]; }
    a.l += ps;
    const bf16x8 p0 = pack8(S, 0), p1 = pack8(S, 1);
    a.o0 = FA_MFMA(a00, p0, a.o0); a.o0 = FA_MFMA(a01, p1, a.o0); a.o1 = FA_MFMA(a10, p0, a.o1); a.o1 = FA_MFMA(a11, p1, a.o1);
}
__device__ __forceinline__ void step64l(Acc& a, const Qf& q, const LAS unsigned char* buf, int r32, int hi, bool rowmask, bool rowon) {
    const float pinf_ = opaque_inf();
    const LAS unsigned char* kr0 = buf + r32 * 128; const LAS unsigned char* kr1 = kr0 + 32 * 128; const int kx = (r32 >> 1) & 7;
    f32x16 S0, S1;
    { const bf16x8 k0 = *(const LAS bf16x8*)(kr0 + (((0 + hi) ^ kx) << 4)), k1 = *(const LAS bf16x8*)(kr0 + (((2 + hi) ^ kx) << 4)), k2 = *(const LAS bf16x8*)(kr0 + (((4 + hi) ^ kx) << 4)), k3 = *(const LAS bf16x8*)(kr0 + (((6 + hi) ^ kx) << 4));
      const bf16x8 j0 = *(const LAS bf16x8*)(kr1 + (((0 + hi) ^ kx) << 4)), j1 = *(const LAS bf16x8*)(kr1 + (((2 + hi) ^ kx) << 4)), j2 = *(const LAS bf16x8*)(kr1 + (((4 + hi) ^ kx) << 4)), j3 = *(const LAS bf16x8*)(kr1 + (((6 + hi) ^ kx) << 4));
      S0 = FA_MFMA(k0, q.f[0], a.negm); S1 = FA_MFMA(j0, q.f[0], a.negm); S0 = FA_MFMA(k1, q.f[1], S0); S1 = FA_MFMA(j1, q.f[1], S1);
      S0 = FA_MFMA(k2, q.f[2], S0); S1 = FA_MFMA(j2, q.f[2], S1); S0 = FA_MFMA(k3, q.f[3], S0); S1 = FA_MFMA(j3, q.f[3], S1); }
    const LAS unsigned char* v0 = buf + 8192 + r32 * 128; const LAS unsigned char* v1 = v0 + 32 * 128; const int x0 = (r32 >> 1) & 7;
    const bf16x8 a00 = lds_vfrag(v0, hi, x0), a01 = lds_vfrag(v0, 2 + hi, x0), a02 = lds_vfrag(v0, 4 + hi, x0), a03 = lds_vfrag(v0, 6 + hi, x0);
    float ra = mx2(mx2(mx2(S0[0], S0[1]), mx2(S0[2], S0[3])), mx2(mx2(S0[4], S0[5]), mx2(S0[6], S0[7])));
    ra = mx2(ra, mx2(mx2(mx2(S0[8], S0[9]), mx2(S0[10], S0[11])), mx2(mx2(S0[12], S0[13]), mx2(S0[14], S0[15]))));
    float rb = mx2(mx2(mx2(S1[0], S1[1]), mx2(S1[2], S1[3])), mx2(mx2(S1[4], S1[5]), mx2(S1[6], S1[7])));
    rb = mx2(rb, mx2(mx2(mx2(S1[8], S1[9]), mx2(S1[10], S1[11])), mx2(mx2(S1[12], S1[13]), mx2(S1[14], S1[15]))));
    float rm = mx2(ra, rb);
    if (rowmask) rm = rowon ? rm : FA_NINF;
    rm = swap_max(rm);
    const bool big = rm > (a.seen ? FA_THR : -3.0e38f);
    if (__any(big)) { const float dl = big ? rm : 0.f; a.m += dl; const float f = __builtin_amdgcn_exp2f(-dl); a.l *= f;
#pragma unroll
        for (int r = 0; r < 16; ++r) { a.o0[r] *= f; a.o1[r] *= f; S0[r] -= dl; S1[r] -= dl; a.negm[r] = -a.m; } }
    a.seen = a.seen || (rm > -3.0e38f);
    float ps = 0.f, pt = 0.f;
#pragma unroll
    for (int r = 0; r < 16; ++r) { S0[r] = __builtin_amdgcn_exp2f(S0[r]); ps += S0[r]; S1[r] = __builtin_amdgcn_exp2f(S1[r]); pt += S1[r]; }
    ps += pt;
    v4u w0 = __builtin_bit_cast(v4u, pack8(S0, 0)), w1 = __builtin_bit_cast(v4u, pack8(S0, 1)), w2 = __builtin_bit_cast(v4u, pack8(S1, 0)), w3 = __builtin_bit_cast(v4u, pack8(S1, 1));
    if (rowmask) { const unsigned km = rowon ? 0xffffffffu : 0u; ps = rowon ? ps : 0.f;
        w0.x &= km; w0.y &= km; w0.z &= km; w0.w &= km; w1.x &= km; w1.y &= km; w1.z &= km; w1.w &= km; w2.x &= km; w2.y &= km; w2.z &= km; w2.w &= km; w3.x &= km; w3.y &= km; w3.z &= km; w3.w &= km; }
    a.l += ps;
    const bf16x8 p0 = __builtin_bit_cast(bf16x8, w0), p1 = __builtin_bit_cast(bf16x8, w1), p2 = __builtin_bit_cast(bf16x8, w2), p3 = __builtin_bit_cast(bf16x8, w3);
    const bf16x8 a10 = lds_vfrag(v1, hi, x0), a11 = lds_vfrag(v1, 2 + hi, x0), a12 = lds_vfrag(v1, 4 + hi, x0), a13 = lds_vfrag(v1, 6 + hi, x0);
    a.o0 = FA_MFMA(a00, p0, a.o0); a.o0 = FA_MFMA(a01, p1, a.o0); a.o0 = FA_MFMA(a02, p2, a.o0); a.o0 = FA_MFMA(a03, p3, a.o0);
    a.o1 = FA_MFMA(a10, p0, a.o1); a.o1 = FA_MFMA(a11, p1, a.o1); a.o1 = FA_MFMA(a12, p2, a.o1); a.o1 = FA_MFMA(a13, p3, a.o1);
}
__device__ __forceinline__ void step64m(Acc& a, const Qf& q, const LAS unsigned char* buf, int r32, int hi, bool needmask, int loA, int upA, int loB, int upB) {
    const float pinf_ = opaque_inf();
    const LAS unsigned char* kr0 = buf + r32 * 128; const LAS unsigned char* kr1 = kr0 + 32 * 128; const int kx = (r32 >> 1) & 7;
    f32x16 S0, S1;
    { const bf16x8 k0 = *(const LAS bf16x8*)(kr0 + (((0 + hi) ^ kx) << 4)), k1 = *(const LAS bf16x8*)(kr0 + (((2 + hi) ^ kx) << 4)), k2 = *(const LAS bf16x8*)(kr0 + (((4 + hi) ^ kx) << 4)), k3 = *(const LAS bf16x8*)(kr0 + (((6 + hi) ^ kx) << 4));
      const bf16x8 j0 = *(const LAS bf16x8*)(kr1 + (((0 + hi) ^ kx) << 4)), j1 = *(const LAS bf16x8*)(kr1 + (((2 + hi) ^ kx) << 4)), j2 = *(const LAS bf16x8*)(kr1 + (((4 + hi) ^ kx) << 4)), j3 = *(const LAS bf16x8*)(kr1 + (((6 + hi) ^ kx) << 4));
      S0 = FA_MFMA(k0, q.f[0], a.negm); S1 = FA_MFMA(j0, q.f[0], a.negm); S0 = FA_MFMA(k1, q.f[1], S0); S1 = FA_MFMA(j1, q.f[1], S1);
      S0 = FA_MFMA(k2, q.f[2], S0); S1 = FA_MFMA(j2, q.f[2], S1); S0 = FA_MFMA(k3, q.f[3], S0); S1 = FA_MFMA(j3, q.f[3], S1); }
    const LAS unsigned char* v0 = buf + 8192 + r32 * 128; const LAS unsigned char* v1 = v0 + 32 * 128; const int x0 = (r32 >> 1) & 7;
    const bf16x8 a00 = lds_vfrag(v0, hi, x0), a01 = lds_vfrag(v0, 2 + hi, x0), a02 = lds_vfrag(v0, 4 + hi, x0), a03 = lds_vfrag(v0, 6 + hi, x0);
    if (needmask) {
#pragma unroll
        for (int r = 0; r < 16; ++r) { const int c = crow(r, hi); S0[r] = (c >= loA && c <= upA) ? S0[r] : FA_NINF; S1[r] = (c >= loB && c <= upB) ? S1[r] : FA_NINF; }
    }
    float ra = mx2(mx2(mx2(S0[0], S0[1]), mx2(S0[2], S0[3])), mx2(mx2(S0[4], S0[5]), mx2(S0[6], S0[7])));
    ra = mx2(ra, mx2(mx2(mx2(S0[8], S0[9]), mx2(S0[10], S0[11])), mx2(mx2(S0[12], S0[13]), mx2(S0[14], S0[15]))));
    float rb = mx2(mx2(mx2(S1[0], S1[1]), mx2(S1[2], S1[3])), mx2(mx2(S1[4], S1[5]), mx2(S1[6], S1[7])));
    rb = mx2(rb, mx2(mx2(mx2(S1[8], S1[9]), mx2(S1[10], S1[11])), mx2(mx2(S1[12], S1[13]), mx2(S1[14], S1[15]))));
    float rm = mx2(ra, rb);
    rm = swap_max(rm);
    const bool big = rm > (a.seen ? FA_THR : -3.0e38f);
    if (__any(big)) { const float dl = big ? rm : 0.f; a.m += dl; const float f = __builtin_amdgcn_exp2f(-dl); a.l *= f;
#pragma unroll
        for (int r = 0; r < 16; ++r) { a.o0[r] *= f; a.o1[r] *= f; S0[r] -= dl; S1[r] -= dl; a.negm[r] = -a.m; } }
    a.seen = a.seen || (rm > -3.0e38f);
    float ps = 0.f, pt = 0.f;
#pragma unroll
    for (int r = 0; r < 16; ++r) { S0[r] = __builtin_amdgcn_exp2f(S0[r]); ps += S0[r]; S1[r] = __builtin_amdgcn_exp2f(S1[r]); pt += S1[r]; }
    ps += pt;
    v4u w0 = __builtin_bit_cast(v4u, pack8(S0, 0)), w1 = __builtin_bit_cast(v4u, pack8(S0, 1)), w2 = __builtin_bit_cast(v4u, pack8(S1, 0)), w3 = __builtin_bit_cast(v4u, pack8(S1, 1));
    a.l += ps;
    const bf16x8 p0 = __builtin_bit_cast(bf16x8, w0), p1 = __builtin_bit_cast(bf16x8, w1), p2 = __builtin_bit_cast(bf16x8, w2), p3 = __builtin_bit_cast(bf16x8, w3);
    const bf16x8 a10 = lds_vfrag(v1, hi, x0), a11 = lds_vfrag(v1, 2 + hi, x0), a12 = lds_vfrag(v1, 4 + hi, x0), a13 = lds_vfrag(v1, 6 + hi, x0);
    a.o0 = FA_MFMA(a00, p0, a.o0); a.o0 = FA_MFMA(a01, p1, a.o0); a.o0 = FA_MFMA(a02, p2, a.o0); a.o0 = FA_MFMA(a03, p3, a.o0);
    a.o1 = FA_MFMA(a10, p0, a.o1); a.o1 = FA_MFMA(a11, p1, a.o1); a.o1 = FA_MFMA(a12, p2, a.o1); a.o1 = FA_MFMA(a13, p3, a.o1);
}
__device__ __forceinline__ void park_store(LAS float* pp, const f32x16& t0, const f32x16& t1) {
#pragma unroll
    for (int r = 0; r < 16; ++r) { pp[r * 64] = t0[r]; pp[(16 + r) * 64] = t1[r]; }
}
__device__ __forceinline__ void park_add(LAS float* pp, const Acc& a, float gate) {
    const float l = swap_sum(a.l); const float sc = l > 0.f ? gate * __builtin_amdgcn_rcpf(l) : 0.f;
#pragma unroll
    for (int r = 0; r < 16; ++r) { pp[r * 64] += a.o0[r] * sc; pp[(16 + r) * 64] += a.o1[r] * sc; }
}
__device__ __forceinline__ void park_final(LAS float* pp, const Acc& a, float gate, f32x16& t0, f32x16& t1) {
    const float l = swap_sum(a.l); const float sc = l > 0.f ? gate * __builtin_amdgcn_rcpf(l) : 0.f;
#pragma unroll
    for (int r = 0; r < 16; ++r) { t0[r] = pp[r * 64] + a.o0[r] * sc; t1[r] = pp[(16 + r) * 64] + a.o1[r] * sc; }
}
__device__ __forceinline__ void store_out(bf16* dst  , const f32x16& t0, const f32x16& t1, int hi) {
#pragma unroll
    for (int rg = 0; rg < 4; ++rg) { v2u w; w.x = cvtpk(t0[4 * rg], t0[4 * rg + 1]); w.y = cvtpk(t0[4 * rg + 2], t0[4 * rg + 3]); *(GAS v2u*)(dst + 8 * rg + 4 * hi) = w;
        v2u x; x.x = cvtpk(t1[4 * rg], t1[4 * rg + 1]); x.y = cvtpk(t1[4 * rg + 2], t1[4 * rg + 3]); *(GAS v2u*)(dst + 32 + 8 * rg + 4 * hi) = x; }
}
constexpr int L_IMP = 0, L_VS = 8 * 32 * 33 * 4, L_SELM = L_VS + 64 * 33 * 4;

__device__ __forceinline__ void nsa_unit(unsigned char* ws, bf16* attout, LAS unsigned char* lds, int wave_s, int bg, int tb) {
    const int tid = fresh_tid(wave_s); asm volatile("" : "+s"(ws));
    const int lane = tid & 63, r32 = lane & 31, hi = lane >> 5, w = __builtin_amdgcn_readfirstlane(tid >> 6), rr = w & 3, th = w >> 2;
    if (w >= 4) __builtin_amdgcn_s_setprio(1);
    const int b = bg >> 1, g = bg & 1, head = 4 * g + rr, t = 64 * tb + 32 * th + r32;
    unsigned char* ar = ws + WS_ARENA + (size_t)b * ARENA_B;
    Qf q; load_rows(q, (const bf16*)(ar + A_QA) + ((size_t)head * SEQ + t) * 64 + hi * 8);
    const GAS float* gs = (const GAS float*)(ar + A_GS) + (size_t)t * 32 + head * 3;
    const float g0 = gs[0];
    f32x16 t0, t1;
    const bf16* Ks = (const bf16*)(ar + A_KS) + (size_t)g * SEQ * 64; const bf16* Vs = (const bf16*)(ar + A_VST) + (size_t)g * 64 * SEQ;
    TileRegs tr; tile_issue(tr, Ks, Vs, tid);
    LAS float* IMP = (LAS float*)(lds + L_IMP); LAS float* VS = (LAS float*)(lds + L_VS); LAS unsigned* SELM = (LAS unsigned*)(lds + L_SELM);
    {
        const int ntile = (tb >> 3) + 1;
        const int clim = t >= 31 ? (t - 31) >> 4 : -1;
        const bf16* K = (const bf16*)(ws + WS_KCB) + (size_t)bg * 128 * 64; const bf16* V = (const bf16*)(ws + WS_VCBT) + (size_t)bg * 64 * 128;
        f32x16 zero;
#pragma unroll
        for (int r = 0; r < 16; ++r) zero[r] = 0.f;
        f32x16 S[4]; float rm = FA_NINF;
        Qf kf[4]; bf16x8 vf[4][4];
#pragma unroll
        for (int ti = 0; ti < 4; ++ti) if (ti < ntile) load_rows(kf[ti], K + (size_t)(ti * 32 + r32) * 64 + hi * 8);
#pragma unroll
        for (int ti = 0; ti < 4; ++ti) if (ti < ntile) { const bf16* v0 = V + (size_t)r32 * 128 + ti * 32 + 4 * hi; const bf16* v1 = v0 + (size_t)32 * 128;
            vf[ti][0] = vfrag(v0); vf[ti][1] = vfrag(v0 + 16); vf[ti][2] = vfrag(v1); vf[ti][3] = vfrag(v1 + 16); }
        __builtin_amdgcn_sched_barrier(0);
#pragma unroll
        for (int ti = 0; ti < 4; ++ti) if (ti < ntile) { S[ti] = FA_MFMA(kf[ti].f[0], q.f[0], zero); S[ti] = FA_MFMA(kf[ti].f[1], q.f[1], S[ti]); S[ti] = FA_MFMA(kf[ti].f[2], q.f[2], S[ti]); S[ti] = FA_MFMA(kf[ti].f[3], q.f[3], S[ti]); }
#pragma unroll
        for (int ti = 0; ti < 4; ++ti) if (ti < ntile) {
#pragma unroll
            for (int r = 0; r < 16; ++r) { S[ti][r] = (32 * ti + crow(r, hi) <= clim) ? S[ti][r] : FA_NINF; rm = fmaxf(rm, S[ti][r]); } }
        rm = swap_max(rm); const float mref = rm > -3.0e38f ? rm : 0.f; float l = 0.f;
#pragma unroll
        for (int ti = 0; ti < 4; ++ti) if (ti < ntile) {
#pragma unroll
            for (int r = 0; r < 16; ++r) { S[ti][r] = __builtin_amdgcn_exp2f(S[ti][r] - mref); l += S[ti][r]; } }
        l = swap_sum(l); const float il = l > 0.f ? __builtin_amdgcn_rcpf(l) : 0.f;
#pragma unroll
        for (int r = 0; r < 16; ++r) { t0[r] = 0.f; t1[r] = 0.f; }
        LAS float* myimp = IMP + (w * 32 + r32) * 33; float carry = 0.f;
#pragma unroll
        for (int ti = 0; ti < 4; ++ti) if (ti < ntile) {
#pragma unroll
            for (int r = 0; r < 16; ++r) S[ti][r] *= il;
            float lo4[4];
#pragma unroll
            for (int rg = 0; rg < 4; ++rg) lo4[rg] = swap_other(S[ti][4 * rg + 3], hi);
#pragma unroll
            for (int rg = 0; rg < 4; ++rg) { const float gsum = (S[ti][4 * rg] + S[ti][4 * rg + 1]) + (S[ti][4 * rg + 2] + S[ti][4 * rg + 3]);
                const float prev = hi ? lo4[rg] : (rg > 0 ? lo4[rg > 0 ? rg - 1 : 0] : carry);
                myimp[2 * (4 * ti + rg) + hi] = gsum + prev; }
            carry = lo4[3];
            { const bf16x8 p0 = pack8(S[ti], 0), p1 = pack8(S[ti], 1);
              t0 = FA_MFMA(vf[ti][0], p0, t0); t0 = FA_MFMA(vf[ti][1], p1, t0); t1 = FA_MFMA(vf[ti][2], p0, t1); t1 = FA_MFMA(vf[ti][3], p1, t1); }
        }
#pragma unroll
        for (int r = 0; r < 16; ++r) { t0[r] *= g0; t1[r] *= g0; }
    }
    __syncthreads();
    {
        const int tk = tid >> 3, jg = tid & 7, tht = tk >> 5, qt = tk & 31;
#pragma unroll
        for (int i = 0; i < 4; ++i) { const int j = 4 * jg + i; float x = 0.f;
#pragma unroll
            for (int r = 0; r < 4; ++r) x += IMP[((tht * 4 + r) * 32 + qt) * 33 + j];
            VS[tk * 33 + j] = (j <= tb) ? x + ((j == 0 || j == tb || j == tb - 1) ? 1e4f : 0.f) : -1e30f; }
        if (tid < 64) SELM[tid] = 0u;
    }
    __syncthreads();
    {
        const int tk = tid >> 3, part = tid & 7; float v[32];
#pragma unroll
        for (int j = 0; j < 32; ++j) v[j] = VS[tk * 33 + j];
        unsigned bits = 0;
#pragma unroll
        for (int i = 0; i < 4; ++i) { const int j = 4 * part + i; const float vj = VS[tk * 33 + j]; int rank = 0;
#pragma unroll
            for (int k = 0; k < 32; ++k) rank += (v[k] > vj || (v[k] == vj && k < j)) ? 1 : 0;
            if (rank < 16 && j <= tb) bits |= 1u << j; }
        __hip_atomic_fetch_or((LAS unsigned*)&SELM[tk], bits, __ATOMIC_RELAXED, __HIP_MEMORY_SCOPE_WORKGROUP);
    }
    __syncthreads();
    const unsigned selm = SELM[32 * th + r32];

    LAS float* pp = (LAS float*)(lds + (w < 6 ? 81920 + w * 8192 : (w - 6) * 8192)) + lane;
    park_store(pp, t0, t1);
    Acc a; LAS unsigned char* tb0 = lds + L_TILE;
    const bf16* Kw = (const bf16*)(ar + A_KW) + (size_t)g * SEQ * 64; const bf16* Vw = (const bf16*)(ar + A_VWT) + (size_t)g * 64 * SEQ;
    const int jw0 = tb >= 8 ? tb - 8 : 0;
    {
        acc_reset(a);
        for (int j = 0; j < tb; ++j) {
            LAS unsigned char* buf = tb0 + (j & 1) * TILE_BYTES;
            tile_commit(buf, tr, tid);
            tile_issue(tr, Ks + (size_t)(64 * (j + 1)) * 64, Vs + 64 * (j + 1), tid);
            __syncthreads();
            const bool on = (selm >> j) & 1u; const unsigned long long bal = __ballot(on);
            if (bal != 0ull) step64l(a, q, buf, r32, hi, bal != ~0ull, on);
        }
        {
            LAS unsigned char* buf = tb0 + (tb & 1) * TILE_BYTES;
            tile_commit(buf, tr, tid);
            tile_issue(tr, Kw + (size_t)(64 * jw0) * 64, Vw + 64 * jw0, tid);
            __syncthreads();
            step64m(a, q, buf, r32, hi, true, 0, th ? 31 : r32, th ? 0 : 1, th ? r32 : 0);
        }
        park_add(pp, a, gs[1]);
    }

    __syncthreads();
    {
        acc_reset(a);
        const int as = 2 * tb + th, ks0 = as >= 16 ? as - 16 : 0;
        auto edge_tile = [&](int j) {
            LAS unsigned char* buf = tb0 + (j & 1) * TILE_BYTES;
            tile_commit(buf, tr, tid);
            if (j < tb) tile_issue(tr, Kw + (size_t)(64 * (j + 1)) * 64, Vw + 64 * (j + 1), tid);
            __syncthreads();
            const int ka = 2 * j, kb = 2 * j + 1;
            const bool fa_ = (as >= 16 && ka == as - 16), la_ = (ka == as), fb_ = (as >= 16 && kb == as - 16), lb_ = (kb == as);
            const bool acta = (ka >= ks0 && ka <= as), actb = (kb >= ks0 && kb <= as);
            if (acta || actb) step64m(a, q, buf, r32, hi, !(acta && actb && !fa_ && !la_ && !fb_ && !lb_),
                                      !acta ? 1 : (fa_ ? r32 + 1 : 0), !acta ? 0 : (la_ ? r32 : 31), !actb ? 1 : (fb_ ? r32 + 1 : 0), !actb ? 0 : (lb_ ? r32 : 31));
        };
        edge_tile(jw0);
        for (int j = jw0 + 1; j < tb; ++j) {
            LAS unsigned char* buf = tb0 + (j & 1) * TILE_BYTES;
            tile_commit(buf, tr, tid);
            tile_issue(tr, Kw + (size_t)(64 * (j + 1)) * 64, Vw + 64 * (j + 1), tid);
            __syncthreads();
            step64l(a, q, buf, r32, hi, false, true);
        }
        if (tb > jw0) edge_tile(tb);
        park_final(pp, a, gs[2], t0, t1);
    }
    store_out(attout + (size_t)b * OUT_BATCH_E + (size_t)t * 1024 + head * 64, t0, t1, hi);
    __builtin_amdgcn_s_setprio(0);

    __syncthreads();
}
__device__ __forceinline__ void moba_unit(unsigned char* ws, bf16* attout, LAS unsigned char* lds, int wave_s, int bh, int c8) {
    const int tid = fresh_tid(wave_s); asm volatile("" : "+s"(ws));
    const int lane = tid & 63, r32 = lane & 31, hi = lane >> 5, w = __builtin_amdgcn_readfirstlane(tid >> 6);
    if (w >= 4) __builtin_amdgcn_s_setprio(1);
    const int b = bh >> 3, h = bh & 7, t = 256 * c8 + 32 * w + r32;
    unsigned char* ar = ws + WS_ARENA + (size_t)b * ARENA_B;
    Qf q; load_rows(q, (const bf16*)(ar + A_QB) + ((size_t)h * SEQ + t) * 64 + hi * 8);
    const bf16* K = (const bf16*)(ar + A_KB) + (size_t)h * SEQ * 64; const bf16* V = (const bf16*)(ar + A_VBT) + (size_t)h * 64 * SEQ;
    TileRegs tr; tile_issue(tr, K, V, tid);
    unsigned selm = 0;
    if (c8 > 0) {
        LAS bf16* KMl = (LAS bf16*)(lds + L_TILE + 2 * TILE_BYTES);
        if (w < c8) { const int ko = lane >> 3, ch = lane & 7; const bf16* base = K + (size_t)(256 * w) * 64; float s8[8];
#pragma unroll
            for (int i = 0; i < 8; ++i) s8[i] = 0.f;
            for (int ib = 0; ib < 32; ib += 16) { v4u wv[16];
#pragma unroll
                for (int i = 0; i < 16; ++i) wv[i] = *(const GAS v4u*)(base + (size_t)(8 * (ib + i) + ko) * 64 + ch * 8);
                __builtin_amdgcn_sched_barrier(0);
#pragma unroll
                for (int i = 0; i < 16; ++i) {
                    s8[0] += __uint_as_float(wv[i].x << 16); s8[1] += __uint_as_float(wv[i].x & 0xffff0000u); s8[2] += __uint_as_float(wv[i].y << 16); s8[3] += __uint_as_float(wv[i].y & 0xffff0000u);
                    s8[4] += __uint_as_float(wv[i].z << 16); s8[5] += __uint_as_float(wv[i].z & 0xffff0000u); s8[6] += __uint_as_float(wv[i].w << 16); s8[7] += __uint_as_float(wv[i].w & 0xffff0000u); } }
#pragma unroll
            for (int i = 0; i < 8; ++i) { s8[i] += __shfl_xor(s8[i], 8); s8[i] += __shfl_xor(s8[i], 16); s8[i] += __shfl_xor(s8[i], 32); s8[i] *= (1.0f / 256.0f); }
            if (lane < 8) { v4u o; o.x = pk2(s8[0], s8[1]); o.y = pk2(s8[2], s8[3]); o.z = pk2(s8[4], s8[5]); o.w = pk2(s8[6], s8[7]); *(LAS v4u*)(KMl + w * 64 + ch * 8) = o; } }
        else if (lane < 8) { const v4u z = {0u, 0u, 0u, 0u}; *(LAS v4u*)(KMl + w * 64 + (lane & 7) * 8) = z; }
        __syncthreads();
        f32x16 zero;
#pragma unroll
        for (int r = 0; r < 16; ++r) zero[r] = 0.f;
        Qf k;
#pragma unroll
        for (int sx = 0; sx < 4; ++sx) k.f[sx] = *(const LAS bf16x8*)(KMl + (r32 & 7) * 64 + hi * 8 + 16 * sx);
        f32x16 S = FA_MFMA(k.f[0], q.f[0], zero); S = FA_MFMA(k.f[1], q.f[1], S); S = FA_MFMA(k.f[2], q.f[2], S); S = FA_MFMA(k.f[3], q.f[3], S);
        float gsc[8];
#pragma unroll
        for (int i = 0; i < 4; ++i) { auto sw = __builtin_amdgcn_permlane32_swap(__float_as_uint(S[i]), __float_as_uint(S[i]), false, false); gsc[i] = __uint_as_float(sw[0]); gsc[4 + i] = __uint_as_float(sw[1]); }
#pragma unroll
        for (int j = 0; j < 8; ++j) { int rank = 0;
#pragma unroll
            for (int i = 0; i < 8; ++i) rank += (i < c8 && (gsc[i] > gsc[j] || (gsc[i] == gsc[j] && i < j))) ? 1 : 0;
            if (j < c8 && rank < 3) selm |= 1u << j; }
    }
    Acc a; acc_reset(a); LAS unsigned char* tb0 = lds + L_TILE;
    const int nt = 4 * c8 + 4, npast = 4 * c8;
    for (int i = 0; i < npast; ++i) {
        LAS unsigned char* buf = tb0 + (i & 1) * TILE_BYTES;
        tile_commit(buf, tr, tid);
        tile_issue(tr, K + (size_t)(64 * (i + 1)) * 64, V + 64 * (i + 1), tid);
        __syncthreads();
        const bool on = (selm >> (i >> 2)) & 1u; const unsigned long long bal = __ballot(on);
        if (bal != 0ull) step64l(a, q, buf, r32, hi, bal != ~0ull, on);
    }
    for (int i = npast; i < nt; ++i) {
        LAS unsigned char* buf = tb0 + (i & 1) * TILE_BYTES;
        tile_commit(buf, tr, tid);
        if (i + 1 < nt) tile_issue(tr, K + (size_t)(64 * (i + 1)) * 64, V + 64 * (i + 1), tid);
        __syncthreads();
        const int ka = 2 * (i & 3), kb = ka + 1;
        if (ka <= w) step64m(a, q, buf, r32, hi, kb >= w, 0, ka == w ? r32 : 31, kb > w ? 1 : 0, kb > w ? 0 : (kb == w ? r32 : 31));
    }
    f32x16 t0, t1;
#pragma unroll
    for (int r = 0; r < 16; ++r) { t0[r] = 0.f; t1[r] = 0.f; }
    acc_finish(a, t0, t1, 1.0f);
    store_out(attout + (size_t)b * OUT_BATCH_E + (size_t)t * 1024 + 512 + h * 64, t0, t1, hi);
    __builtin_amdgcn_s_setprio(0);
    __syncthreads();
}
}
__device__ __forceinline__ void cmp_unit(Frame& F, const Args& A, int l, int u) {
    unsigned char* ws = F.ws; asm volatile("" : "+s"(ws)); const int tid = fresh_tid(F.wave_s), lane = tid & 63, r32 = lane & 31, hi = lane >> 5, w = __builtin_amdgcn_readfirstlane(tid >> 6), nt = w & 3, kh = w >> 2;
    LAS float* part = (LAS float*)F.lds;
    LAS float* hid = (LAS float*)(F.lds + 16896);
    LAS float* o2 = (LAS float*)(F.lds + 16896 + 16384);
    {
        const int kv = u >> 6, bg = (u >> 2) & 15, ct = u & 3, c0 = 32 * ct;
        const bf16* src = (const bf16*)(ws + WS_ARENA + (size_t)(bg >> 1) * ARENA_B + (kv ? A_VC : A_KC)) + (size_t)(bg & 1) * SEQ * 64;
        const bf16* w1t = (const bf16*)(ws + (kv ? WS_W1TV : WS_W1TK));
        fa::f32x16 acc;
#pragma unroll
        for (int r = 0; r < 16; ++r) acc[r] = 0.f;
        const bf16* ap = src + (size_t)(16 * (c0 + r32)) * 64 + 8 * hi;
        const bf16* bp = w1t + (size_t)(32 * nt + r32) * 2048 + 8 * hi;
        for (int sb = kh * 64; sb < kh * 64 + 64; sb += 16) {
            fa::bf16x8 af[16], bfr[16];
#pragma unroll
            for (int i = 0; i < 16; ++i) { const int s = sb + i;
                af[i] = *(const GAS fa::bf16x8*)(ap + (s >> 2) * 64 + 16 * (s & 3)); bfr[i] = *(const GAS fa::bf16x8*)(bp + 16 * s); }
            __builtin_amdgcn_sched_barrier(0);
#pragma unroll
            for (int i = 0; i < 16; ++i) acc = FA_MFMA(af[i], bfr[i], acc);
            __builtin_amdgcn_sched_barrier(0);
        }

        if (kh == 1) {
#pragma unroll
            for (int r = 0; r < 16; ++r) part[(nt * 32 + fa::crow(r, hi)) * 33 + r32] = acc[r];
        }
        __syncthreads();
        LAS bf16* hidb = (LAS bf16*)hid;
        if (kh == 0) { const float bias = ((const float*)(ws + WS_CBIAS))[kv * 128 + 32 * nt + r32];
#pragma unroll
            for (int r = 0; r < 16; ++r) { const int c = fa::crow(r, hi); hidb[c * 136 + 32 * nt + r32] = (bf16)f2bf(gelu_tanh(acc[r] + part[(nt * 32 + c) * 33 + r32] + bias)); }
        }
        __syncthreads();
        if (w < 2) {
            const bf16* w2t = (const bf16*)(ws + (kv ? WS_W2TV : WS_W2TK)) + (size_t)(32 * w + r32) * 128 + 8 * hi;
            fa::bf16x8 bq[8];
#pragma unroll
            for (int sx = 0; sx < 8; ++sx) bq[sx] = *(const GAS fa::bf16x8*)(w2t + 16 * sx);
            fa::f32x16 oacc;
#pragma unroll
            for (int r = 0; r < 16; ++r) oacc[r] = 0.f;
#pragma unroll
            for (int sx = 0; sx < 8; ++sx) { const fa::bf16x8 aq = *(const LAS fa::bf16x8*)(hidb + r32 * 136 + 16 * sx + 8 * hi); oacc = FA_MFMA(aq, bq[sx], oacc); }
#pragma unroll
            for (int r = 0; r < 16; ++r) o2[fa::crow(r, hi) * 64 + 32 * w + r32] = oacc[r];
        }
        __syncthreads();
        const int d = tid & 63, cq = tid >> 6;
#pragma unroll
        for (int i = 0; i < 4; ++i) { const int cl = cq + 8 * i, c = c0 + cl;
            if (kv == 0) { float r = 0.f;
                if (c < 127) { const int t = 16 * c + 31, dd = d & 31; const float cs = ((const float*)(ws + WS_ROPEC))[t * 32 + dd], sn = ((const float*)(ws + WS_ROPES))[t * 32 + dd];
                    const float x1 = o2[cl * 64 + dd], x2 = o2[cl * 64 + dd + 32]; r = d < 32 ? x1 * cs - x2 * sn : x2 * cs + x1 * sn; }
                ((bf16*)(ws + WS_KCB))[((size_t)bg * 128 + c) * 64 + d] = (bf16)f2bf(r); }
            else { const float r = c < 127 ? o2[cl * 64 + d] : 0.f; ((bf16*)(ws + WS_VCBT))[((size_t)bg * 64 + d) * 128 + c] = (bf16)f2bf(r); } }
        __syncthreads();
    }
}
__device__ __forceinline__ void phase_x(Frame& F, const Args& A, int l, bf16* attout) {
    const int vcu = (F.G % 8 == 0) ? (F.bx % 8) * (F.G / 8) + F.bx / 8 : F.bx;
    for (int mp = vcu; mp < 256; mp += F.G) { const int bh = mp >> 2, i = mp & 3;
        if (i < 2) { const int g8 = mp >> 5, j5 = mp & 31, a4 = (j5 >> 2) * 2 + (j5 & 1);
            cmp_unit(F, A, l, (a4 >> 3) * 64 + (2 * g8 + ((a4 >> 2) & 1)) * 4 + (a4 & 3)); }
        const int code = i == 0 ? 0x7 : i == 1 ? 0x06 : i == 2 ? 0x35 : 0x124, cnt = i == 0 ? 1 : i == 3 ? 3 : 2;
        for (int k = 0; k < cnt; ++k) fa::moba_unit(F.ws, attout, F.lds, F.wave_s, bh, (code >> (4 * k)) & 15); }
}
__device__ __forceinline__ void phase_y(Frame& F, bf16* attout) {
    const int vcu = (F.G % 8 == 0) ? (F.bx % 8) * (F.G / 8) + F.bx / 8 : F.bx;
    for (int np = vcu; np < 256; np += F.G) { const int bg = np >> 4, p = np & 15;
        for (int k = 0; k < 2; ++k) fa::nsa_unit(F.ws, attout, F.lds, F.wave_s, bg, k == 0 ? 31 - p : p); }
}
__global__ void __launch_bounds__(NWAVES * 64, 2) fwd_kernel(Args args) {
    extern __shared__ __attribute__((aligned(16))) unsigned char lds[];
    LAS unsigned char* ldsb = (LAS unsigned char*)lds;
    volatile LAS unsigned* MISC = (volatile LAS unsigned*)(ldsb + MISC_OFF);
    for (int u = threadIdx.x; u < (LDS_BYTES - LDSCTL_OFF) / 4; u += NWAVES * 64) ((LAS unsigned*)(ldsb + LDSCTL_OFF))[u] = 0u;
    __syncthreads();
    const int wave_s = __builtin_amdgcn_readfirstlane((int)threadIdx.x >> 6);
    XcdBarrier bar; bar.bar = (unsigned*)(args.ws + WS_CTL) + 4096; bar.x = 0; bar.st = nullptr;
    const bool multi = (args.ph_hi - args.ph_lo) > 1;
    if (multi) bar = xcd_barrier_post((unsigned*)(args.ws + WS_CTL) + 4096, MISC + 8);
    bool colocal = false, checked = !multi;
    for (int ph = args.ph_lo; ph < args.ph_hi; ++ph) {
        unsigned char* ws = args.ws; asm volatile("" : "+s"(ws));
        unsigned zero_ = 0u; asm volatile("" : "+s"(zero_));
        int tid_ = wave_s * 64 + (int)__builtin_amdgcn_mbcnt_hi(~0u, __builtin_amdgcn_mbcnt_lo(~0u, zero_)); asm volatile("" : "+v"(tid_));
        Frame F;
        F.lds = ldsb; F.ws = ws; F.ctl = (gu32*)(ws + WS_CTL);
        F.tid = tid_; F.lane = 0; F.wave = 0; F.G = gridDim.x; F.bx = blockIdx.x; F.wave_s = wave_s;
        const int l = ph / PH_PER_LAYER, k = (ph == PH_NORM) ? -1 : ph % PH_PER_LAYER;
        bf16* XB = (bf16*)(ws + WS_XB); float* rowss = (float*)(ws + WS_ROWSS);
        if (ph == PH_NORM) {
#ifndef NO_NORM
 phase_norm(F, args);
#endif
 }
        else if (k == PH_CONV) {
#ifndef NO_CONV
 phase_conv(F, args, l);
#endif
 }
        else if (k == PH_UP1 || k == PH_UP2) {
            pg8::Gemm g{XB, (const bf16*)(ws + (k == PH_UP1 ? WS_WUP1 : WS_WUP2)), MT, NUP, DM, 0}; pg8::StaticOrder S; S.init(MT, NUP, F.G, F.bx);
            pg8::EpiSwiglu E{(bf16*)(ws + WS_ARENA + A_H), rowss};

#ifndef NO_UP
 pg8::gemm_phase<pg8::EpiSwiglu, pg8::StaticOrder, true, true>(F.lds, g, S, E, F.tid);
#endif

        }
        else if (k == PH_DN1 || k == PH_DN2 || k == PH_OUT) {
            const bool isout = (k == PH_OUT);
            pg8::Gemm g{(const bf16*)(ws + WS_ARENA + (isout ? A_MRG : A_H)), (const bf16*)(ws + (isout ? WS_WOUT : (k == PH_DN1 ? WS_WDN1 : WS_WDN2))), MT, DM, isout ? DM : DFF,
                        ARENA_B - (size_t)SEQ * (isout ? DM : DFF) * 2}; pg8::StaticOrder S; S.init(MT, DM, F.G, F.bx);
            pg8::EpiResid E{XB, rowss, isout ? 1.0f : 0.5f, (LAS float*)(F.lds + 132096)};

#ifndef NO_DN
 pg8::gemm_phase<pg8::EpiResid, pg8::StaticOrder, true, true>(F.lds, g, S, E, F.tid);
#endif

        }
        else if (k == PH_WIN) {
            pg8::Gemm g{XB, (const bf16*)(ws + WS_WIN), MT, NWIN, DM, 0}; pg8::StaticOrder S; S.init(MT, NWIN, F.G, F.bx);
            pg8::EpiWin E{rowss, (const float*)(ws + WS_ROPEC), (const float*)(ws + WS_ROPES),
                pg8::WinBufs{(bf16*)(ws + WS_ARENA + A_QA), (bf16*)(ws + WS_ARENA + A_QB), (bf16*)(ws + WS_ARENA + A_KB), (bf16*)(ws + WS_ARENA + A_VBT), (bf16*)(ws + WS_ARENA + A_KC), (bf16*)(ws + WS_ARENA + A_VC), (bf16*)(ws + WS_ARENA + A_KS), (bf16*)(ws + WS_ARENA + A_VST),
                             (bf16*)(ws + WS_ARENA + A_KW), (bf16*)(ws + WS_ARENA + A_VWT), (bf16*)(ws + WS_ARENA + A_GA), (bf16*)(ws + WS_ARENA + A_GB), (float*)(ws + WS_ARENA + A_GS)}};

#ifndef NO_WIN
 pg8::gemm_phase<pg8::EpiWin, pg8::StaticOrder, true, true>(F.lds, g, S, E, F.tid);
#endif

        }
        else if (k == PH_CMP) {
#ifndef NO_CMP
 { bf16* attout = (bf16*)args.out; asm volatile("" : "+s"(attout)); phase_x(F, args, l, attout); }
#endif
 }
        else if (k == PH_ATT) {
#ifndef NO_ATT
 { bf16* attout = (bf16*)args.out; asm volatile("" : "+s"(attout)); phase_y(F, attout); }
#endif
 }
        else if (k == PH_MRG) {
            { pg8::Gemm g{(const bf16*)args.out, (const bf16*)(ws + WS_WPA), MT, DM, DM, (size_t)OUT_BATCH_E * 2 - (size_t)SEQ * DM * 2}; pg8::StaticOrder S; S.init(MT, DM, F.G, F.bx);
              pg8::EpiMergeF E{(const bf16*)(ws + WS_ARENA + A_GA), (const bf16*)(ws + WS_ARENA + A_GB), (bf16*)(ws + WS_ARENA + A_MRG)};
#ifndef NO_MRG
              pg8::gemm_phase<pg8::EpiMergeF, pg8::StaticOrder, true, true>(F.lds, g, S, E, F.tid);
#endif
            }
        }
        if (ph + 1 < args.ph_hi) {
            const bool full_seam = (k == PH_CONV) || (k == PH_DN2 && l == 0);
            const int tq = fresh_tid(wave_s);
            if (full_seam || !colocal) { xcd_barrier(bar, tq == 0); if (!checked) { colocal = colocal_check(bar, MISC + 10, fresh_tid(wave_s)); checked = true; } }
            else if (k == PH_UP1 || k == PH_UP2 || k == PH_MRG) team_barrier(bar, tq == 0, (blockIdx.x & 7u) * 8u + ((blockIdx.x >> 3) & 7u));
            else group_barrier(bar, tq == 0, blockIdx.x & 7u, gridDim.x >> 3);
        }
    }
}

extern "C" void kernel_launch(void* const* d_in, const int* in_sizes, int n_in, void* d_out, int out_size, void* d_ws, size_t ws_size, hipStream_t stream) {
    static int grid = 0;
    if (grid == 0) {
        if (n_in != 21 || in_sizes[0] != MT * DM || out_size != MT * DM || ws_size < WS_END) { fprintf(stderr, "kernel_launch: unexpected shapes (n_in %d, in0 %d, out %d, ws %zu)\n", n_in, n_in > 0 ? in_sizes[0] : -1, out_size, ws_size); grid = -1; return; }
        int dev = 0, cus = 0;
        if (hipGetDevice(&dev) != hipSuccess || hipDeviceGetAttribute(&cus, hipDeviceAttributeMultiprocessorCount, dev) != hipSuccess) { grid = -1; return; }
        if (hipFuncSetAttribute((const void*)fwd_kernel, hipFuncAttributeMaxDynamicSharedMemorySize, LDS_BYTES) != hipSuccess) { fprintf(stderr, "kernel_launch: hipFuncSetAttribute failed\n"); grid = -1; return; }
        (void)hipGetLastError();
        grid = cus;
    }
    if (grid < 0) return;
    (void)hipMemsetAsync((char*)d_ws + WS_CTL, 0, CTL_ZERO_BYTES, stream);
    Args a{};
    for (int i = 0; i < 21; ++i) a.in[i] = (const float*)d_in[i];
    a.out = (float*)d_out; a.ws = (unsigned char*)d_ws;
#ifndef MULTI_LAUNCH
    a.ph_lo = 0; a.ph_hi = PH_TOTAL;
    hipLaunchKernelGGL(fwd_kernel, dim3(grid), dim3(NWAVES * 64), LDS_BYTES, stream, a);
    return;
#endif
    for (int ph = 0; ph < PH_TOTAL; ++ph) {
        a.ph_lo = ph; a.ph_hi = ph + 1;
        hipLaunchKernelGGL(fwd_kernel, dim3(grid), dim3(NWAVES * 64), LDS_BYTES, stream, a);
    }
}
```

```cpp
#include <hip/hip_runtime.h>
#include <cstdio>
#include <cstdint>
namespace pg8 {
#define PG8_LAS __attribute__((address_space(3)))
typedef unsigned short bf16_t;
typedef short bf16x8 __attribute__((ext_vector_type(8)));
typedef float f32x4 __attribute__((ext_vector_type(4)));
typedef unsigned u32x4 __attribute__((ext_vector_type(4)));
constexpr int BM = 256, BK = 64, HALF = 128, HTB = HALF * BK * 2  , STAGE_BYTES = 8 * HTB, NXCD = 8, WGM = 8;

__host__ __device__ __forceinline__ int lds_byte(int r, int c) { const int st = (r >> 4) * 2 + (c >> 5), rr = r & 15, cc = c & 31, ob = rr * 64 + cc * 2; return st * 1024 + (ob ^ (((ob >> 9) & 1) << 5)); }
__host__ __device__ __forceinline__ void stage_rc(int b, int& R, int& C) { const int st = b / 1024, sb = b % 1024, swz = sb ^ (((sb >> 9) & 1) << 5); R = (st >> 1) * 16 + swz / 64; C = (st & 1) * 32 + (swz % 64) / 2; }
__host__ __device__ __forceinline__ int perm32(int rho) { const int n = rho >> 4, i = rho & 15; return 8 * (i >> 2) + 4 * n + (i & 3); }

struct Unit { int pm, pn; };
struct Gemm { const bf16_t* A; const bf16_t* Bt; int M, N, K; size_t abgap; };

struct StaticOrder {
    int nM, nN, nwg, G, c;
    __host__ __device__ void init(int M, int N, int G_, int c_) { nM = M / BM; nN = N / BM; nwg = nM * nN; G = G_; c = c_; }
    __host__ __device__ bool next(int i, Unit& u) const {
        const long L = (long)i * G + c; if (L >= nwg) return false;
        int wgid = (int)L; { const int q = nwg / NXCD, r = nwg % NXCD, xcd = wgid % NXCD, off = wgid / NXCD; wgid = (xcd < r ? xcd * (q + 1) : r * (q + 1) + (xcd - r) * q) + off; }
        const int nig = WGM * nN, gid = wgid / nig, fm = gid * WGM, gsz = (nM - fm) < WGM ? (nM - fm) : WGM;
        u.pm = fm + ((wgid % nig) % gsz); u.pn = (wgid % nig) / gsz; return true;
    }
    __device__ __forceinline__ void a_ready(const Unit&) const {}
    __device__ __forceinline__ void done(const Unit&) const {}
};

typedef unsigned u32x2 __attribute__((ext_vector_type(2)));
typedef float pk_f32x2 __attribute__((ext_vector_type(2)));
typedef __bf16 pk_bf16x2 __attribute__((ext_vector_type(2)));
__device__ __forceinline__ unsigned cvt_pk_bf16(float lo, float hi) { const pk_f32x2 v = {lo, hi}; const pk_bf16x2 b = __builtin_convertvector(v, pk_bf16x2); return __builtin_bit_cast(unsigned, b); }
__device__ __forceinline__ float rstd_of(const float* rowss, int row) { const f32x4 a = *(const __attribute__((address_space(1))) f32x4*)(rowss + (size_t)row * 4); return __builtin_amdgcn_rsqf(((a[0] + a[1]) + (a[2] + a[3])) * (1.0f / 1024.0f) + 1e-6f); }
__device__ __forceinline__ void rstd8(const float* rowss, int row0, float (&rs)[2][4]) {
    f32x4 a[2][4];
#pragma unroll
    for (int ai = 0; ai < 2; ++ai)
#pragma unroll
        for (int m = 0; m < 4; ++m) a[ai][m] = *(const __attribute__((address_space(1))) f32x4*)(rowss + (size_t)(row0 + ai * HALF + m * 16) * 4);
    __builtin_amdgcn_sched_barrier(0);
#pragma unroll
    for (int ai = 0; ai < 2; ++ai)
#pragma unroll
        for (int m = 0; m < 4; ++m) rs[ai][m] = __builtin_amdgcn_rsqf(((a[ai][m][0] + a[ai][m][1]) + (a[ai][m][2] + a[ai][m][3])) * (1.0f / 1024.0f) + 1e-6f);
}
__device__ __forceinline__ float sigm(float v) { return __builtin_amdgcn_rcpf(1.0f + __builtin_amdgcn_exp2f(-1.4426950408889634f * v)); }
__device__ __forceinline__ float bfl(unsigned w) { return __uint_as_float(w << 16); }
__device__ __forceinline__ float bfh(unsigned w) { return __uint_as_float(w & 0xffff0000u); }

struct EpiSwiglu {
    static constexpr bool PERM = false, AFTER_DRAIN = false, HAS_MID = false;
    bf16_t* H; const float* rowss;
    __device__ __forceinline__ void operator()(const f32x4 (&acc)[2][2][4][2], const Unit& u, int wr, int wc, int fr, int fq) const {
        const int row0 = u.pm * BM + wr * 64 + fr, col0 = u.pn * 128 + wc * 32 + 8 * fq;
        float rsa[2][4]; rstd8(rowss, row0, rsa);
#pragma unroll
        for (int ai = 0; ai < 2; ++ai)
#pragma unroll
            for (int m = 0; m < 4; ++m) { const int row = row0 + ai * HALF + m * 16; const float rs = rsa[ai][m];
                float hv[8];
#pragma unroll
                for (int n = 0; n < 2; ++n)
#pragma unroll
                    for (int i = 0; i < 4; ++i) { const float g = acc[ai][0][m][n][i] * rs, uu = acc[ai][1][m][n][i] * rs; hv[4 * n + i] = g * uu * sigm(g); }
                u32x4 w; w.x = cvt_pk_bf16(hv[0], hv[1]); w.y = cvt_pk_bf16(hv[2], hv[3]); w.z = cvt_pk_bf16(hv[4], hv[5]); w.w = cvt_pk_bf16(hv[6], hv[7]);
                *(u32x4*)(H + (size_t)(row >> 11) * (size_t)10526720 + (size_t)(row & 2047) * 2816 + col0) = w; asm volatile("" ::: "memory"); }
    }
};
struct EpiResid {
    static constexpr bool PERM = false, AFTER_DRAIN = false, HAS_MID = false;
    bf16_t* XB; float* rowss; float alpha; PG8_LAS float* ssl;
    __device__ __forceinline__ void operator()(const f32x4 (&acc)[2][2][4][2], const Unit& u, int wr, int wc, int fr, int fq) const {
        const int row0 = u.pm * BM + wr * 64 + fr, col0 = u.pn * BM + wc * 32 + 4 * fq;
        u32x2 xo[2][4][2][2];
#pragma unroll
        for (int ai = 0; ai < 2; ++ai)
#pragma unroll
            for (int m = 0; m < 4; ++m)
#pragma unroll
                for (int bj = 0; bj < 2; ++bj)
#pragma unroll
                    for (int n = 0; n < 2; ++n) xo[ai][m][bj][n] = *(const __attribute__((address_space(1))) u32x2*)(XB + (size_t)(row0 + ai * HALF + m * 16) * 1024 + col0 + bj * HALF + n * 16);
        __builtin_amdgcn_sched_barrier(0);
#pragma unroll
        for (int ai = 0; ai < 2; ++ai)
#pragma unroll
            for (int m = 0; m < 4; ++m) { const int row = row0 + ai * HALF + m * 16; const size_t off = (size_t)row * 1024 + col0; float ss = 0.f;
#pragma unroll
                for (int bj = 0; bj < 2; ++bj)
#pragma unroll
                    for (int n = 0; n < 2; ++n) { const size_t o = off + bj * HALF + n * 16; const f32x4 a = acc[ai][bj][m][n]; const u32x2 xv = xo[ai][m][bj][n];
                        const float x0 = bfl(xv.x) + a[0] * alpha, x1 = bfh(xv.x) + a[1] * alpha, x2 = bfl(xv.y) + a[2] * alpha, x3 = bfh(xv.y) + a[3] * alpha;
                        u32x2 w; w.x = cvt_pk_bf16(x0, x1); w.y = cvt_pk_bf16(x2, x3); *(__attribute__((address_space(1))) u32x2*)(XB + o) = w;
                        ss += (x0 * x0 + x1 * x1) + (x2 * x2 + x3 * x3); }
                ss += __shfl_xor(ss, 16); ss += __shfl_xor(ss, 32);
                if (fq == 0) ssl[(ai * HALF + wr * 64 + m * 16 + fr) * 4 + wc] = ss; }
        asm volatile("s_waitcnt lgkmcnt(0)" ::: "memory"); __builtin_amdgcn_s_barrier(); asm volatile("" ::: "memory");
        { const int tid = (wr * 4 + wc) * 64 + fq * 16 + fr;
          if (tid < 256) { const f32x4 p = *(const PG8_LAS f32x4*)(ssl + tid * 4); rowss[(size_t)(u.pm * BM + tid) * 4 + u.pn] = (p[0] + p[1]) + (p[2] + p[3]); } }
        asm volatile("s_waitcnt lgkmcnt(0)" ::: "memory"); __builtin_amdgcn_s_barrier(); asm volatile("" ::: "memory");
    }
};
struct EpiMergeF {
    static constexpr bool PERM = false, AFTER_DRAIN = false, HAS_MID = true; static constexpr int MID_T = 8;
    const bf16_t* GA; const bf16_t* GB; bf16_t* Mg;
    __device__ __forceinline__ void mid(f32x4 (&acc)[2][2][4][2], const Unit& u, int wr, int wc, int fr, int fq) const {
        int row0 = u.pm * BM + wr * 64 + fr, col0 = u.pn * BM + wc * 32 + 8 * fq;
        asm volatile("" : "+v"(row0), "+v"(col0));
#pragma unroll
        for (int ai = 0; ai < 2; ++ai) {
            u32x4 ga[4][2], gb[4][2];
#pragma unroll
            for (int m = 0; m < 4; ++m)
#pragma unroll
                for (int bj = 0; bj < 2; ++bj) { const int rw = row0 + ai * HALF + m * 16; const size_t o = (size_t)(rw >> 11) * (size_t)10526720 + (size_t)(rw & 2047) * 1024 + col0 + bj * HALF;
                    ga[m][bj] = *(const __attribute__((address_space(1))) u32x4*)(GA + o); gb[m][bj] = *(const __attribute__((address_space(1))) u32x4*)(GB + o); }
            __builtin_amdgcn_sched_barrier(0);
#pragma unroll
            for (int m = 0; m < 4; ++m)
#pragma unroll
                for (int bj = 0; bj < 2; ++bj) { const u32x4 a = ga[m][bj], b = gb[m][bj]; float r[8];
                    r[0] = bfl(a.x) * __builtin_amdgcn_rcpf(fmaxf(bfl(b.x), 1e-30f)); r[1] = bfh(a.x) * __builtin_amdgcn_rcpf(fmaxf(bfh(b.x), 1e-30f));
                    r[2] = bfl(a.y) * __builtin_amdgcn_rcpf(fmaxf(bfl(b.y), 1e-30f)); r[3] = bfh(a.y) * __builtin_amdgcn_rcpf(fmaxf(bfh(b.y), 1e-30f));
                    r[4] = bfl(a.z) * __builtin_amdgcn_rcpf(fmaxf(bfl(b.z), 1e-30f)); r[5] = bfh(a.z) * __builtin_amdgcn_rcpf(fmaxf(bfh(b.z), 1e-30f));
                    r[6] = bfl(a.w) * __builtin_amdgcn_rcpf(fmaxf(bfl(b.w), 1e-30f)); r[7] = bfh(a.w) * __builtin_amdgcn_rcpf(fmaxf(bfh(b.w), 1e-30f));
                    acc[ai][bj][m][0][0] *= r[0]; acc[ai][bj][m][0][1] *= r[1]; acc[ai][bj][m][0][2] *= r[2]; acc[ai][bj][m][0][3] *= r[3];
                    acc[ai][bj][m][1][0] *= r[4]; acc[ai][bj][m][1][1] *= r[5]; acc[ai][bj][m][1][2] *= r[6]; acc[ai][bj][m][1][3] *= r[7]; }
            asm volatile("" ::: "memory"); }
    }
    __device__ __forceinline__ void operator()(const f32x4 (&acc)[2][2][4][2], const Unit& u, int wr, int wc, int fr, int fq) const {
        const int row0 = u.pm * BM + wr * 64 + fr, col0 = u.pn * BM + wc * 32 + 8 * fq;
        u32x4 gb[2][4][2];
#pragma unroll
        for (int ai = 0; ai < 2; ++ai)
#pragma unroll
            for (int m = 0; m < 4; ++m)
#pragma unroll
                for (int bj = 0; bj < 2; ++bj) { const int rw = row0 + ai * HALF + m * 16; gb[ai][m][bj] = *(const __attribute__((address_space(1))) u32x4*)(GB + (size_t)(rw >> 11) * (size_t)10526720 + (size_t)(rw & 2047) * 1024 + col0 + bj * HALF); }
        __builtin_amdgcn_sched_barrier(0);
#pragma unroll
        for (int ai = 0; ai < 2; ++ai)
#pragma unroll
            for (int m = 0; m < 4; ++m) { const int row = row0 + ai * HALF + m * 16;
#pragma unroll
                for (int bj = 0; bj < 2; ++bj) { const size_t o = (size_t)(row >> 11) * (size_t)10526720 + (size_t)(row & 2047) * 1024 + col0 + bj * HALF; const u32x4 gw = gb[ai][m][bj];
                    float r[8]; const f32x4 a0 = acc[ai][bj][m][0], a1 = acc[ai][bj][m][1];
                    r[0] = fmaxf(bfl(gw.x), 1e-30f) * a0[0]; r[1] = fmaxf(bfh(gw.x), 1e-30f) * a0[1]; r[2] = fmaxf(bfl(gw.y), 1e-30f) * a0[2]; r[3] = fmaxf(bfh(gw.y), 1e-30f) * a0[3];
                    r[4] = fmaxf(bfl(gw.z), 1e-30f) * a1[0]; r[5] = fmaxf(bfh(gw.z), 1e-30f) * a1[1]; r[6] = fmaxf(bfl(gw.w), 1e-30f) * a1[2]; r[7] = fmaxf(bfh(gw.w), 1e-30f) * a1[3];
                    u32x4 w; w.x = cvt_pk_bf16(r[0], r[1]); w.y = cvt_pk_bf16(r[2], r[3]); w.z = cvt_pk_bf16(r[4], r[5]); w.w = cvt_pk_bf16(r[6], r[7]);
                    *(__attribute__((address_space(1))) u32x4*)(Mg + o) = w; } }
    }
};
constexpr float C2Q = 0.125f * 1.4426950408889634f;
enum { WT_ROPE = 0, WT_PLAIN = 1, WT_VT = 2, WT_SIG = 3, WT_GS = 4, WT_NONE = 5 };
struct WinBufs { bf16_t *QA, *QB, *KBb, *VBt, *KC, *VC, *KS, *VSt, *KW, *VWt, *GA, *GB; float* GS; };
struct EpiWin {
    static constexpr bool PERM = false, AFTER_DRAIN = false, HAS_MID = false;
    const float* rowss; const float* ropec; const float* ropes; WinBufs B;
    __device__ __forceinline__ void operator()(const f32x4 (&acc)[2][2][4][2], const Unit& u, int wr, int wc, int fr, int fq) const {
        const int row0 = u.pm * BM + wr * 64 + fr;
        float rs[2][4]; rstd8(rowss, row0, rs);
        const int hh = wc >> 1, w = wc & 1;
#pragma unroll
        for (int bj = 0; bj < 2; ++bj) {
            const int half = 2 * u.pn + bj;
            int type, nh = 8, hb = 0, cb = 0; bf16_t* dst = nullptr; float sc = 1.f;
            if (half < 4) { type = WT_ROPE; dst = B.QA; hb = 2 * half; sc = C2Q; }
            else if (half == 4) { type = WT_PLAIN; dst = B.KC; nh = 2; }
            else if (half == 5) { type = WT_PLAIN; dst = B.VC; nh = 2; }
            else if (half == 6) { type = WT_ROPE; dst = B.KS; nh = 2; }
            else if (half == 7) { type = WT_VT; dst = B.VSt; nh = 2; }
            else if (half == 8) { type = WT_ROPE; dst = B.KW; nh = 2; }
            else if (half == 9) { type = WT_VT; dst = B.VWt; nh = 2; }
            else if (half < 14) { type = WT_ROPE; dst = B.QB; hb = 2 * (half - 10); sc = C2Q; }
            else if (half < 18) { type = WT_ROPE; dst = B.KBb; hb = 2 * (half - 14); }
            else if (half < 22) { type = WT_VT; dst = B.VBt; hb = 2 * (half - 18); }
            else if (half < 30) { type = WT_SIG; dst = B.GA; cb = 128 * (half - 22); }
            else if (half < 38) { type = WT_SIG; dst = B.GB; cb = 128 * (half - 30); }
            else if (half == 38) { type = WT_GS; }
            else { type = WT_NONE; }
            const int head = hb + hh;
            if (type == WT_ROPE) {
#pragma unroll
                for (int ai = 0; ai < 2; ++ai) {
                    f32x4 cs4[4], sn4[4];
#pragma unroll
                    for (int m = 0; m < 4; ++m) { const int sp = (row0 + ai * HALF + m * 16) & 2047;
                        cs4[m] = *(const __attribute__((address_space(1))) f32x4*)(ropec + sp * 32 + 16 * w + 4 * fq); sn4[m] = *(const __attribute__((address_space(1))) f32x4*)(ropes + sp * 32 + 16 * w + 4 * fq); }
                    __builtin_amdgcn_sched_barrier(0);
#pragma unroll
                    for (int m = 0; m < 4; ++m) { const int row = row0 + ai * HALF + m * 16, b = row >> 11, s = row & 2047; const float r = rs[ai][m] * sc;
                        const f32x4 c4 = cs4[m], s4 = sn4[m];
                        const f32x4 x1 = acc[ai][bj][m][0] * r, x2 = acc[ai][bj][m][1] * r;
                        const f32x4 o1 = x1 * c4 - x2 * s4, o2 = x2 * c4 + x1 * s4;
                        bf16_t* p = dst + (size_t)b * (size_t)10526720 + ((size_t)head * 2048 + s) * 64 + 16 * w + 4 * fq;
                        u32x2 w1, w2; w1.x = cvt_pk_bf16(o1[0], o1[1]); w1.y = cvt_pk_bf16(o1[2], o1[3]); w2.x = cvt_pk_bf16(o2[0], o2[1]); w2.y = cvt_pk_bf16(o2[2], o2[3]);
                        *(u32x2*)p = w1; *(u32x2*)(p + 32) = w2; }
                    asm volatile("" ::: "memory"); }
            } else if (type == WT_PLAIN) {
#pragma unroll
                for (int ai = 0; ai < 2; ++ai)
#pragma unroll
                    for (int m = 0; m < 4; ++m) { const int row = row0 + ai * HALF + m * 16, b = row >> 11, s = row & 2047; const float r = rs[ai][m];
                        const f32x4 v0 = acc[ai][bj][m][0] * r, v1 = acc[ai][bj][m][1] * r;
                        bf16_t* p = dst + (size_t)b * (size_t)10526720 + ((size_t)head * 2048 + s) * 64 + 32 * w + 4 * fq;
                        u32x2 w1, w2; w1.x = cvt_pk_bf16(v0[0], v0[1]); w1.y = cvt_pk_bf16(v0[2], v0[3]); w2.x = cvt_pk_bf16(v1[0], v1[1]); w2.y = cvt_pk_bf16(v1[2], v1[3]);
                        *(u32x2*)p = w1; *(u32x2*)(p + 16) = w2; asm volatile("" ::: "memory"); }
            } else if (type == WT_VT) {
#pragma unroll
                for (int ai = 0; ai < 2; ++ai)
#pragma unroll
                    for (int m = 0; m < 4; ++m) { const int row = row0 + ai * HALF + m * 16, b = row >> 11, s = row & 2047; const float r = rs[ai][m];
                        bf16_t* p = dst + (size_t)b * (size_t)10526720 + ((size_t)head * 64 + 32 * w + 4 * fq) * 2048 + s;
#pragma unroll
                        for (int n = 0; n < 2; ++n) { const f32x4 v = acc[ai][bj][m][n] * r; const unsigned a = cvt_pk_bf16(v[0], v[1]), c = cvt_pk_bf16(v[2], v[3]);
                            bf16_t* q = p + (size_t)(16 * n) * 2048;
                            q[0] = (bf16_t)(a & 0xffffu); q[2048] = (bf16_t)(a >> 16); q[4096] = (bf16_t)(c & 0xffffu); q[6144] = (bf16_t)(c >> 16); } asm volatile("" ::: "memory"); }
            } else if (type == WT_SIG) {
#pragma unroll
                for (int ai = 0; ai < 2; ++ai)
#pragma unroll
                    for (int m = 0; m < 4; ++m) { const int row = row0 + ai * HALF + m * 16, b = row >> 11, s = row & 2047; const float r = rs[ai][m];
                        const f32x4 v0 = acc[ai][bj][m][0] * r, v1 = acc[ai][bj][m][1] * r;
                        u32x4 o; o.x = cvt_pk_bf16(sigm(v0[0]), sigm(v0[1])); o.y = cvt_pk_bf16(sigm(v0[2]), sigm(v0[3])); o.z = cvt_pk_bf16(sigm(v1[0]), sigm(v1[1])); o.w = cvt_pk_bf16(sigm(v1[2]), sigm(v1[3]));
                        *(u32x4*)(dst + (size_t)b * (size_t)10526720 + (size_t)s * 1024 + cb + 32 * wc + 8 * fq) = o; asm volatile("" ::: "memory"); }
            } else if (type == WT_GS) {
                if (wc == 0) {
#pragma unroll
                    for (int ai = 0; ai < 2; ++ai)
#pragma unroll
                        for (int m = 0; m < 4; ++m) { const int row = row0 + ai * HALF + m * 16; const float r = rs[ai][m];
#pragma unroll
                            for (int n = 0; n < 2; ++n) { const f32x4 v = acc[ai][bj][m][n] * r; f32x4 o; o[0] = sigm(v[0]); o[1] = sigm(v[1]); o[2] = sigm(v[2]); o[3] = sigm(v[3]);
                                *(f32x4*)(B.GS + (size_t)(row >> 11) * (size_t)5263360 + (size_t)(row & 2047) * 32 + 16 * n + 4 * fq) = o; } }
                }
            }
        }
    }
};
template <class Epi, class Sched, bool ALIGN_EPI = false, bool SP2 = false>
__device__ __forceinline__ void gemm_phase(PG8_LAS unsigned char* lds, const Gemm g, const Sched& S, const Epi& E, const int tid) {
    const int wid = __builtin_amdgcn_readfirstlane(tid >> 6), lane = tid & 63, wr = wid >> 2, wc = wid & 3, fr = lane & 15, fq = lane >> 4;
    const int K = g.K, nt = K / BK;
    unsigned voffA[2], voffB[2];
#pragma unroll
    for (int i = 0; i < 2; ++i) { int R, C; stage_rc(tid * 16 + i * 8192, R, C); const int Rb = Epi::PERM ? ((R & ~31) + perm32(R & 31)) : R;
        voffA[i] = (unsigned)(R * K + C) * 2u; voffB[i] = (unsigned)(Rb * K + C) * 2u; }
    const size_t kstep = (size_t)(BK * 2);
    const size_t hstep = (size_t)HALF * K * 2;
    const size_t tstep = 2 * hstep;
    const unsigned ldsw = (unsigned)wid * 1024u;
    const int aoff = lds_byte(wr * 64 + fr, fq * 8), boff = lds_byte(wc * 32 + fr, fq * 8);
#define PG8_SA(b, h) (((b) * 2 + (h)) * HTB)
#define PG8_SB(b, h) ((4 + (b) * 2 + (h)) * HTB)
#define PG8_STAGE(bufoff, gbase, voff) do { _Pragma("unroll") for (int _i = 0; _i < 2; ++_i) \
        __builtin_amdgcn_global_load_lds((const unsigned*)((const char*)(gbase) + (voff)[_i]), (PG8_LAS unsigned*)(lds + (bufoff) + ldsw + _i * 8192), 16, 0, 0); } while (0)
#define PG8_LDA(dst, b, h) do { _Pragma("unroll") for (int m = 0; m < 4; ++m) _Pragma("unroll") for (int k = 0; k < 2; ++k) dst[m][k] = *(const PG8_LAS bf16x8*)(lds + PG8_SA(b, h) + aoff + m * 2048 + k * 1024); } while (0)
#define PG8_LDB(dst, b, h) do { _Pragma("unroll") for (int n = 0; n < 2; ++n) _Pragma("unroll") for (int k = 0; k < 2; ++k) dst[n][k] = *(const PG8_LAS bf16x8*)(lds + PG8_SB(b, h) + boff + n * 2048 + k * 1024); } while (0)
#define PG8_MMA(ai, bj, At, Bt) do { __builtin_amdgcn_s_setprio(1); _Pragma("unroll") for (int m = 0; m < 4; ++m) _Pragma("unroll") for (int n = 0; n < 2; ++n) _Pragma("unroll") for (int k = 0; k < 2; ++k) \
        acc[ai][bj][m][n] = __builtin_amdgcn_mfma_f32_16x16x32_bf16(Bt[n][k], At[m][k], acc[ai][bj][m][n], 0, 0, 0); __builtin_amdgcn_s_setprio(0); } while (0)
#define PG8_WAIT_V(n) asm volatile("s_waitcnt vmcnt(" #n ")" ::: "memory")
#define PG8_WAIT_L(n) asm volatile("s_waitcnt lgkmcnt(" #n ")" ::: "memory")
#define PG8_BAR __builtin_amdgcn_s_barrier()
#define PG8_SCHED __builtin_amdgcn_sched_barrier(0)
    Unit cur, nxt; int ui = 0;
    if (!S.next(0, cur)) return;
    f32x4 acc[2][2][4][2];
#pragma unroll
    for (int a = 0; a < 2; ++a)
#pragma unroll
        for (int b = 0; b < 2; ++b)
#pragma unroll
            for (int m = 0; m < 4; ++m)
#pragma unroll
                for (int n = 0; n < 2; ++n) acc[a][b][m][n] = (f32x4){0.f, 0.f, 0.f, 0.f};
    bf16x8 At[4][2], B0[2][2], B1[2][2];
    const char* cA = (const char*)g.A + (size_t)cur.pm * tstep + (size_t)(cur.pm >> 3) * g.abgap; const char* cB = (const char*)g.Bt + (size_t)cur.pn * tstep;
    S.a_ready(cur);
    if constexpr (SP2) {
        PG8_STAGE(PG8_SB(0, 0), cB, voffB); PG8_STAGE(PG8_SB(0, 1), cB + hstep, voffB); PG8_STAGE(PG8_SA(0, 0), cA, voffA); PG8_STAGE(PG8_SA(0, 1), cA + hstep, voffA);
        if (wr == 1) PG8_BAR;
        PG8_WAIT_V(2); PG8_BAR;
        PG8_STAGE(PG8_SB(1, 0), cB + kstep, voffB); PG8_STAGE(PG8_SA(1, 0), cA + kstep, voffA); PG8_STAGE(PG8_SB(1, 1), cB + hstep + kstep, voffB);
        PG8_WAIT_V(6); PG8_BAR;
    } else {
        PG8_STAGE(PG8_SB(0, 0), cB, voffB); PG8_STAGE(PG8_SA(0, 0), cA, voffA); PG8_STAGE(PG8_SB(0, 1), cB + hstep, voffB); PG8_STAGE(PG8_SA(0, 1), cA + hstep, voffA);
        if (wr == 1) PG8_BAR;
        PG8_WAIT_V(4); PG8_BAR;
        PG8_STAGE(PG8_SB(1, 0), cB + kstep, voffB); PG8_STAGE(PG8_SA(1, 0), cA + kstep, voffA); PG8_STAGE(PG8_SB(1, 1), cB + hstep + kstep, voffB);
        PG8_WAIT_V(6); PG8_BAR;
    }
    for (;;) {
        const bool has_next = S.next(ui + 1, nxt);
        const char* nA = has_next ? (const char*)g.A + (size_t)nxt.pm * tstep + (size_t)(nxt.pm >> 3) * g.abgap : cA; const char* nB = has_next ? (const char*)g.Bt + (size_t)nxt.pn * tstep : cB;
        for (int t = 0; t < nt; t += 2) {
            const bool last = (t == nt - 2);
            const char* a1 = cA + (size_t)(t + 1) * kstep;
            const char* a2 = last ? nA : cA + (size_t)(t + 2) * kstep; const char* b2 = last ? nB : cB + (size_t)(t + 2) * kstep;
            const char* a3 = a2 + kstep; const char* b3 = b2 + kstep;
            if (last && has_next) S.a_ready(nxt);
            if constexpr (Epi::HAS_MID) { if (t == Epi::MID_T) { __builtin_amdgcn_sched_barrier(0); E.mid(acc, cur, wr, wc, fr, fq); __builtin_amdgcn_sched_barrier(0); } }
            if constexpr (SP2) {
            PG8_LDB(B0, 0, 0); PG8_LDB(B1, 0, 1); PG8_SCHED; PG8_LDA(At, 0, 0); PG8_STAGE(PG8_SA(1, 1), a1 + hstep, voffA);
            PG8_WAIT_V(8); PG8_WAIT_L(0); PG8_BAR; PG8_MMA(0, 0, At, B0); PG8_MMA(0, 1, At, B1); PG8_BAR; PG8_SCHED;
            PG8_LDA(At, 0, 1); PG8_STAGE(PG8_SB(0, 0), b2, voffB); PG8_STAGE(PG8_SB(0, 1), b2 + hstep, voffB); PG8_STAGE(PG8_SA(0, 0), a2, voffA);
            PG8_WAIT_V(8); PG8_WAIT_L(0); PG8_BAR; PG8_MMA(1, 0, At, B0); PG8_MMA(1, 1, At, B1); PG8_BAR; PG8_SCHED;
            PG8_LDB(B0, 1, 0); PG8_LDB(B1, 1, 1); PG8_SCHED; PG8_LDA(At, 1, 0); PG8_STAGE(PG8_SA(0, 1), a2 + hstep, voffA);
            PG8_WAIT_V(8); PG8_WAIT_L(0); PG8_BAR; PG8_MMA(0, 0, At, B0); PG8_MMA(0, 1, At, B1); PG8_BAR; PG8_SCHED;
            PG8_LDA(At, 1, 1); PG8_STAGE(PG8_SB(1, 0), b3, voffB); PG8_STAGE(PG8_SB(1, 1), b3 + hstep, voffB); PG8_STAGE(PG8_SA(1, 0), a3, voffA);
            PG8_WAIT_V(8); PG8_WAIT_L(0); PG8_BAR; PG8_MMA(1, 0, At, B0); PG8_MMA(1, 1, At, B1); PG8_BAR; PG8_SCHED;
            } else {
            PG8_LDB(B0, 0, 0); PG8_SCHED; PG8_LDA(At, 0, 0); PG8_STAGE(PG8_SA(1, 1), a1 + hstep, voffA);
            PG8_WAIT_L(8); PG8_BAR; PG8_WAIT_L(0); PG8_MMA(0, 0, At, B0); PG8_BAR; PG8_SCHED;
            PG8_LDB(B1, 0, 1); PG8_STAGE(PG8_SB(0, 0), b2, voffB);
            PG8_BAR; PG8_WAIT_L(0); PG8_MMA(0, 1, At, B1); PG8_BAR;
            PG8_LDA(At, 0, 1); PG8_STAGE(PG8_SA(0, 0), a2, voffA);
            PG8_BAR; PG8_WAIT_L(0); PG8_MMA(1, 0, At, B0); PG8_BAR; PG8_SCHED;
            PG8_STAGE(PG8_SB(0, 1), b2 + hstep, voffB);
            PG8_WAIT_V(6); PG8_BAR; PG8_MMA(1, 1, At, B1); PG8_BAR;
            PG8_LDB(B0, 1, 0); PG8_SCHED; PG8_LDA(At, 1, 0); PG8_STAGE(PG8_SA(0, 1), a2 + hstep, voffA);
            PG8_WAIT_L(8); PG8_BAR; PG8_WAIT_L(0); PG8_MMA(0, 0, At, B0); PG8_BAR; PG8_SCHED;
            PG8_LDB(B1, 1, 1); PG8_STAGE(PG8_SB(1, 0), b3, voffB);
            PG8_BAR; PG8_WAIT_L(0); PG8_MMA(0, 1, At, B1); PG8_BAR;
            PG8_LDA(At, 1, 1); PG8_STAGE(PG8_SA(1, 0), a3, voffA);
            PG8_BAR; PG8_WAIT_L(0); PG8_MMA(1, 0, At, B0); PG8_BAR; PG8_SCHED;
            PG8_STAGE(PG8_SB(1, 1), b3 + hstep, voffB);
            PG8_WAIT_V(6); PG8_BAR; PG8_MMA(1, 1, At, B1); PG8_BAR;
            }
        }
        if constexpr (ALIGN_EPI) { if (wr == 0) PG8_BAR; }
        if constexpr (!Epi::AFTER_DRAIN) { E(acc, cur, wr, wc, fr, fq); S.done(cur); }
        if (!has_next) break;
#pragma unroll
        for (int a = 0; a < 2; ++a)
#pragma unroll
            for (int b = 0; b < 2; ++b)
#pragma unroll
                for (int m = 0; m < 4; ++m)
#pragma unroll
                    for (int n = 0; n < 2; ++n) acc[a][b][m][n] = (f32x4){0.f, 0.f, 0.f, 0.f};
        cur = nxt; cA = nA; cB = nB; ++ui;
        if constexpr (ALIGN_EPI) { if (wr == 1) PG8_BAR; }
    }
    PG8_WAIT_V(0);
    if constexpr (!ALIGN_EPI) { if (wr == 0) PG8_BAR; }
    PG8_BAR;
    if constexpr (Epi::AFTER_DRAIN) { E.fused(acc, cur, wr, wc, fr, fq, lds, wid, lane); S.done(cur); }
#undef PG8_SA
#undef PG8_SB
#undef PG8_STAGE
#undef PG8_LDA
#undef PG8_LDB
#undef PG8_MMA
#undef PG8_WAIT_V
#undef PG8_WAIT_L
#undef PG8_BAR
#undef PG8_SCHED
}
}
constexpr int NB = 8, SEQ = 2048, DM = 1024, MT = NB * SEQ, DFF = 2816, INC = 4888, NWIN = 5120, NUP = 2 * DFF;
constexpr int NWAVES = 8;
typedef unsigned short bf16;
typedef float f32x4 __attribute__((ext_vector_type(4)));
typedef unsigned v4u __attribute__((ext_vector_type(4)));
typedef unsigned v2u __attribute__((ext_vector_type(2)));
#define LAS __attribute__((address_space(3)))
#define GAS __attribute__((address_space(1)))
typedef GAS unsigned gu32;
#define RLX_AGENT __ATOMIC_RELAXED, __HIP_MEMORY_SCOPE_AGENT
#define LDS_WAIT() asm volatile("s_waitcnt lgkmcnt(0)" ::: "memory")
#define VM_WAIT() asm volatile("s_waitcnt vmcnt(0)" ::: "memory")
constexpr size_t MiB = 1u << 20;
constexpr size_t WS_CTL = 0, CTL_ZERO_BYTES = 64 * 1024;
constexpr size_t WS_ROPEC = 1 * MiB, WS_ROPES = 1 * MiB + 256 * 1024;
constexpr size_t WS_ROWSS = 1 * MiB + 512 * 1024;
constexpr size_t WS_KCB = 2 * MiB + 512 * 1024, WS_VCBT = WS_KCB + 256 * 1024;
constexpr size_t WS_CBIAS = 3 * MiB + 512 * 1024;
constexpr size_t WS_W2TK = 3 * MiB + 576 * 1024, WS_W2TV = 3 * MiB + 592 * 1024;
constexpr size_t WS_W1TK = 51 * MiB, WS_W1TV = 51 * MiB + 512 * 1024;
constexpr size_t WS_WUP1 = 4 * MiB, WS_WDN1 = 15 * MiB, WS_WIN = 20 * MiB + 512 * 1024, WS_WPA = 30 * MiB + 512 * 1024  ,
                 WS_WOUT = 32 * MiB + 512 * 1024, WS_WUP2 = 34 * MiB + 512 * 1024, WS_WDN2 = 45 * MiB + 512 * 1024;
constexpr size_t WS_XB = 52 * MiB;
constexpr size_t WS_ARENA = 84 * MiB, ARENA_B = 20 * MiB + 80 * 1024  , ARENA_E = ARENA_B / 2;
constexpr size_t A_QA = 0, A_QB = 2 * MiB, A_KB = 4 * MiB, A_VBT = 6 * MiB, A_KC = 8 * MiB, A_VC = 8 * MiB + 512 * 1024, A_KS = 9 * MiB, A_VST = 9 * MiB + 512 * 1024,
                 A_KW = 10 * MiB, A_VWT = 10 * MiB + 512 * 1024, A_GA = 11 * MiB, A_GB = 15 * MiB, A_GS = 19 * MiB;
constexpr size_t A_H = 0;
constexpr size_t A_MRG = 2 * MiB;
constexpr size_t OUT_BATCH_E = 4 * MiB;
constexpr size_t WS_END = WS_ARENA + 8 * ARENA_B;
constexpr int RING_BYTES = 131072, LDSCTL_OFF = RING_BYTES, MISC_OFF = LDSCTL_OFF + 320, LDS_BYTES = 147456;

enum { PH_CONV = 0, PH_UP1, PH_DN1, PH_WIN, PH_CMP, PH_ATT, PH_MRG, PH_OUT, PH_UP2, PH_DN2, PH_PER_LAYER };
constexpr int PH_NORM = 2 * PH_PER_LAYER, PH_TOTAL = PH_NORM + 1;

struct Args { const float* in[21]; float* out; unsigned char* ws; int ph_lo, ph_hi; };
static_assert(sizeof(Args) == 21 * 8 + 8 + 8 + 8, "no padding in Args");
enum { I_X = 0, I_F1N, I_F1G, I_F1U, I_F1D, I_MIXN, I_WIN, I_CKP, I_CKW1, I_CKW2, I_CVP, I_CVW1, I_CVW2, I_WBA, I_WBB, I_WOUT, I_F2N, I_F2G, I_F2U, I_F2D, I_FINN };

struct Frame {
    LAS unsigned char* lds; gu32* ctl; unsigned char* ws;
    int tid, lane, wave, G, bx, wave_s;
};
__device__ __forceinline__ int fresh_tid(int wave_s) { unsigned z = 0u; asm volatile("" : "+s"(z)); int t = wave_s * 64 + (int)__builtin_amdgcn_mbcnt_hi(~0u, __builtin_amdgcn_mbcnt_lo(~0u, z)); asm volatile("" : "+v"(t)); return t; }
__device__ __forceinline__ void frame_refresh(Frame& F) { asm volatile("" : "+v"(F.tid)); F.lane = F.tid & 63; F.wave = __builtin_amdgcn_readfirstlane(F.tid >> 6); }
__device__ __forceinline__ float wave_sum(float v) {
#pragma unroll
    for (int o = 1; o < 64; o <<= 1) v += __shfl_xor(v, o);
    return v;
}
__device__ __forceinline__ unsigned f2bf(float f) { unsigned u = __builtin_bit_cast(unsigned, f); return (u + 0x7fffu + ((u >> 16) & 1u)) >> 16; }
__device__ __forceinline__ unsigned pk2(float lo, float hi) { return f2bf(lo) | (f2bf(hi) << 16); }
__device__ __forceinline__ float bf2f(bf16 h) { return __uint_as_float((unsigned)h << 16); }
__host__ __device__ __forceinline__ int perm32i(int rho) { const int n = rho >> 4, i = rho & 15; return 8 * (i >> 2) + 4 * n + (i & 3); }

enum { CV_UP = 0, CV_NAT = 1, CV_WIN = 2, CV_P32 = 3 };
__device__ __forceinline__ int win_src_col(int rho) {
    const int half = rho >> 7, p = rho & 127;
    const int hh = p >> 6, q = p & 63, dim = 16 * (q >> 5) + (q & 15) + 32 * ((q >> 4) & 1);
    const int rp = 64 * hh + dim, pp = (p & ~31) + perm32i(p & 31);
    if (half < 4) return 128 * half + rp;
    if (half == 4) return 536 + p;
    if (half == 5) return 664 + p;
    if (half == 6) return 792 + rp;
    if (half == 7) return 920 + p;
    if (half == 8) return 1048 + rp;
    if (half == 9) return 1176 + p;
    if (half < 14) return 1304 + 128 * (half - 10) + rp;
    if (half < 18) return 1816 + 128 * (half - 14) + rp;
    if (half < 22) return 2328 + 128 * (half - 18) + p;
    if (half < 30) return 2840 + 128 * (half - 22) + pp;
    if (half < 38) return 3864 + 128 * (half - 30) + pp;
    if (half == 38) return p < 24 ? 512 + p : -1;
    return -1;
}
struct ConvJob { const float* W0; const float* W1; const float* gain; bf16* dst; int K, Nsrc, Ndst, kind, items, dpitch, koff; };
__device__ __forceinline__ int win_block_col(int r0, int& nvalid) {
    const int half = r0 >> 7, p0 = r0 & 127; nvalid = 64;
    if (half < 4) return 128 * half + p0;
    if (half == 4) return 536 + p0;
    if (half == 5) return 664 + p0;
    if (half == 6) return 792 + p0;
    if (half == 7) return 920 + p0;
    if (half == 8) return 1048 + p0;
    if (half == 9) return 1176 + p0;
    if (half < 14) return 1304 + 128 * (half - 10) + p0;
    if (half < 18) return 1816 + 128 * (half - 14) + p0;
    if (half < 22) return 2328 + 128 * (half - 18) + p0;
    if (half < 30) return 2840 + 128 * (half - 22) + p0;
    if (half < 38) return 3864 + 128 * (half - 30) + p0;
    if (half == 38 && p0 == 0) { nvalid = 24; return 512; }
    nvalid = 0; return 0;
}
struct ConvRegs { f32x4 v[16]; f32x4 g0, g1; };
__device__ __forceinline__ int conv_swz(int k) { return ((k & 7) ^ (k >> 3)) & 7; }
__device__ __forceinline__ void conv_item(const ConvJob& J, int item, int& kb, int& rb) {
    const int nrb = J.Ndst / 64;
    if ((nrb & 3) == 0 && ((J.K / 64) & 1) == 0) { const int blk = item >> 3, q = nrb >> 2; rb = 4 * (blk % q) + (item & 3); kb = 2 * (blk / q) + ((item >> 2) & 1); }
    else { kb = item / nrb; rb = item % nrb; }
}
__device__ __forceinline__ void conv_load(const ConvJob& J, int item, int lane, ConvRegs& R) {
    int kb, rb; conv_item(J, item, kb, rb); const int k0 = 64 * kb, r0 = 64 * rb;
    const float* W = J.W0; int c0, nvalid = 64;
    if (J.kind == CV_UP) { const int pn = r0 >> 8, bj = (r0 >> 7) & 1; c0 = 128 * pn + (r0 & 127); if (bj) W = J.W1; }
    else if (J.kind == CV_WIN) c0 = win_block_col(r0, nvalid);
    else c0 = r0;
    const int kr = lane >> 4, c4 = lane & 15;
#pragma unroll
    for (int i = 0; i < 16; ++i) R.v[i] = (f32x4){0.f, 0.f, 0.f, 0.f};
    R.g0 = (f32x4){1.f, 1.f, 1.f, 1.f}; R.g1 = R.g0;
    if (J.gain) { const GAS f32x4* gp = (const GAS f32x4*)(J.gain + k0 + 8 * (lane & 7)); R.g0 = gp[0]; R.g1 = gp[1]; }
    if (4 * c4 < nvalid) {
#pragma unroll
        for (int i = 0; i < 16; ++i) R.v[i] = __builtin_nontemporal_load((const GAS f32x4*)(W + (size_t)(k0 + 4 * i + kr) * J.Nsrc + c0 + 4 * c4));
    }
}
__device__ __forceinline__ void conv_emit(const ConvJob& J, int item, LAS float* scr, int lane, const ConvRegs& R) {
    int kb, rb; conv_item(J, item, kb, rb); const int k0 = 64 * kb, r0 = 64 * rb;
    int c0 = r0, nvalid = 64;
    if (J.kind == CV_UP) c0 = 128 * (r0 >> 8) + (r0 & 127);
    else if (J.kind == CV_WIN) c0 = win_block_col(r0, nvalid);
    const int kr = lane >> 4, c4 = lane & 15;
#pragma unroll
    for (int i = 0; i < 16; ++i) { const int k = 4 * i + kr;
        *(LAS f32x4*)(scr + k * 64 + 4 * (c4 ^ conv_swz(k))) = R.v[i]; }
    LDS_WAIT(); asm volatile("" ::: "memory");
}
__device__ __forceinline__ void conv_emit_b(const ConvJob& J, int item, LAS float* scr, int lane, const ConvRegs& R) {
    int kb, rb; conv_item(J, item, kb, rb); const int k0 = 64 * kb, r0 = 64 * rb;
    int c0 = r0, nvalid = 64;
    if (J.kind == CV_UP) c0 = 128 * (r0 >> 8) + (r0 & 127);
    else if (J.kind == CV_WIN) c0 = win_block_col(r0, nvalid);
#pragma unroll
    for (int e = 0; e < 8; ++e) { const int id = lane + 64 * e, n = id >> 3, c = id & 7, rho = r0 + n; int sc;
        if (J.kind == CV_UP) { const int p = rho & 127; sc = ((p & ~31) + perm32i(p & 31)) - (r0 & 127); }
        else if (J.kind == CV_NAT) sc = n;
        else if (J.kind == CV_P32) sc = ((rho & ~31) + perm32i(rho & 31)) - r0;
        else { const int col = win_src_col(rho); sc = col >= 0 ? col - c0 : -1; }
        v4u o = {0u, 0u, 0u, 0u};
        if (sc >= 0) { float f[8];
#pragma unroll
            for (int i = 0; i < 8; ++i) { const int k = 8 * c + i; f[i] = scr[k * 64 + 4 * ((sc >> 2) ^ conv_swz(k)) + (sc & 3)] * (i < 4 ? R.g0[i & 3] : R.g1[i & 3]); }
            o.x = pk2(f[0], f[1]); o.y = pk2(f[2], f[3]); o.z = pk2(f[4], f[5]); o.w = pk2(f[6], f[7]); }
        *(GAS v4u*)(J.dst + (size_t)rho * J.dpitch + J.koff + k0 + 8 * c) = o; }
    LDS_WAIT(); asm volatile("" ::: "memory");
}
__device__ __forceinline__ unsigned topk16_mask(const float (&v)[32]) { unsigned msk = 0;
#pragma unroll
    for (int j = 0; j < 32; ++j) { int rank = 0;
#pragma unroll
        for (int i = 0; i < 32; ++i) rank += (v[i] > v[j] || (v[i] == v[j] && i < j)) ? 1 : 0;
        if (rank < 16) msk |= (1u << j); }
    return msk; }
#define XB_TMO      128
#define XB_XCNT(j)  (256  + 64 * (j))
#define XB_XSUB(j)  (1280 + 64 * (j))
#define XB_XGEN(j)  (2304 + 64 * (j))
#define XB_TOP      3328
#define XB_TOPGEN   3392
#define XCD_BAR_WORDS 3456
#define XB_LSUB(j)  (3584 + 64 * (j))
#define XB_LGEN(j)  (4608 + 64 * (j))
#define XB_XTAB     5632
#define XB_TSUB(t)  (6400 + 32 * (t))
#define XB_TGEN(t)  (6416 + 32 * (t))
#define XB_SPIN_CAP (1u << 18)

__device__ __forceinline__ unsigned xb_ld(unsigned* p)              { return __hip_atomic_load(p, __ATOMIC_RELAXED, __HIP_MEMORY_SCOPE_AGENT); }
__device__ __forceinline__ unsigned xb_add(unsigned* p, unsigned v) { return __hip_atomic_fetch_add(p, v, __ATOMIC_RELAXED, __HIP_MEMORY_SCOPE_AGENT); }
__device__ __forceinline__ unsigned xb_xcc_id() { return (unsigned)__builtin_amdgcn_s_getreg((3 << 11) | 20) & 0xFu; }
#define XB_SPIN(cond, bar) do { unsigned _sp = 0; while (cond) { __builtin_amdgcn_s_sleep(1); \
    if ((++_sp & 255u) == 0u) { if (xb_ld(&(bar)[XB_TMO])) break; if (_sp > XB_SPIN_CAP) { atomicAdd(&(bar)[XB_TMO], 1u); break; } } } } while (0)

struct XcdBarrier {
    unsigned* bar; unsigned x;
    volatile LAS unsigned* st;
};

__device__ __forceinline__ XcdBarrier xcd_barrier_post(unsigned* bar, volatile LAS unsigned* st) {
    XcdBarrier b; b.bar = bar; b.x = xb_xcc_id(); b.st = st;
    if (threadIdx.x == 0) { (void)xb_add(&bar[XB_XCNT(b.x)], 1u); __hip_atomic_store(&bar[XB_XTAB + blockIdx.x], b.x + 1u, __ATOMIC_RELAXED, __HIP_MEMORY_SCOPE_AGENT); }
    return b;
}
__device__ __forceinline__ void xcd_barrier_complete(unsigned* bar, unsigned x, unsigned& nloc, unsigned& nx) {
    const unsigned G = gridDim.x * gridDim.y * gridDim.z;
    unsigned sum, cnt, mine, sp = 0u;
    for (;;) {
        sum = 0u; cnt = 0u; mine = 0u;
#pragma unroll
        for (unsigned j = 0; j < 16; ++j) { const unsigned c = xb_ld(&bar[XB_XCNT(j)]); sum += c; cnt += (c > 0u) ? 1u : 0u; mine = (j == x) ? c : mine; }
        if (sum == G) break;
        __builtin_amdgcn_s_sleep(1);
        if ((++sp & 255u) == 0u) { if (xb_ld(&bar[XB_TMO])) break; if (sp > XB_SPIN_CAP) { atomicAdd(&bar[XB_TMO], 1u); break; } }
    }
    nloc = mine > 0u ? mine : 1u; nx = cnt > 0u ? cnt : 1u;
}

__device__ __forceinline__ void xcd_barrier(const XcdBarrier& b, const bool leader, const bool release_l2 = true) {
    asm volatile("s_waitcnt vmcnt(0)" ::: "memory");
    __syncthreads();
    if (leader) {
        unsigned* bar = b.bar;
        __builtin_amdgcn_s_waitcnt(0);
        unsigned nloc = b.st[0], nx = b.st[1];
        if (nloc == 0u) { xcd_barrier_complete(bar, b.x, nloc, nx); b.st[0] = nloc; b.st[1] = nx; }
        const unsigned old = xb_add(&bar[XB_XSUB(b.x)], 1u);
        const unsigned gen = old / nloc;
        if (old + 1u == (gen + 1u) * nloc) {
            if (release_l2) __builtin_amdgcn_fence(__ATOMIC_RELEASE, "agent");
            asm volatile("s_waitcnt vmcnt(0)" ::: "memory");
            const unsigned og = xb_add(&bar[XB_TOP], 1u);
            const unsigned tg = og / nx;
            if (og + 1u == (tg + 1u) * nx) xb_add(&bar[XB_TOPGEN], 1u);
            else XB_SPIN(xb_ld(&bar[XB_TOPGEN]) == tg, bar);
            __builtin_amdgcn_fence(__ATOMIC_ACQUIRE, "agent");
            xb_add(&bar[XB_XGEN(b.x)], 1u);
            asm volatile("s_waitcnt vmcnt(0)" ::: "memory");
        } else {
            XB_SPIN(xb_ld(&bar[XB_XGEN(b.x)]) == gen, bar);
            __builtin_amdgcn_fence(__ATOMIC_ACQUIRE, "agent");
            asm volatile("s_waitcnt vmcnt(0)" ::: "memory");
        }
    }
    __syncthreads();
}

__device__ __forceinline__ void group_barrier(const XcdBarrier& b, const bool leader, const unsigned grp, const unsigned nloc) {
    asm volatile("s_waitcnt vmcnt(0)" ::: "memory");
    __syncthreads();
    if (leader) {
        unsigned* bar = b.bar;
        __builtin_amdgcn_s_waitcnt(0);
        asm volatile("buffer_inv sc1" ::: "memory");
        const unsigned old = xb_add(&bar[XB_LSUB(grp)], 1u);
        const unsigned gen = old / nloc;
        if (old + 1u == (gen + 1u) * nloc) xb_add(&bar[XB_LGEN(grp)], 1u);
        else XB_SPIN(xb_ld(&bar[XB_LGEN(grp)]) == gen, bar);
        asm volatile("s_waitcnt vmcnt(0)" ::: "memory");
    }
    __syncthreads();
}
__device__ __forceinline__ void team_barrier(const XcdBarrier& b, const bool leader, const unsigned team) {
    asm volatile("s_waitcnt vmcnt(0)" ::: "memory");
    __syncthreads();
    if (leader) {
        unsigned* bar = b.bar;
        __builtin_amdgcn_s_waitcnt(0);
        asm volatile("buffer_inv sc1" ::: "memory");
        const unsigned old = xb_add(&bar[XB_TSUB(team)], 1u);
        const unsigned gen = old >> 2;
        if ((old & 3u) == 3u) xb_add(&bar[XB_TGEN(team)], 1u);
        else XB_SPIN(xb_ld(&bar[XB_TGEN(team)]) == gen, bar);
        asm volatile("s_waitcnt vmcnt(0)" ::: "memory");
    }
    __syncthreads();
}
__device__ __forceinline__ bool colocal_check(const XcdBarrier& b, volatile LAS unsigned* flag, int tid) {
    if (tid < 64) {
        bool ok = (gridDim.x == 256u);
        if (ok) {
#pragma unroll
            for (int r = 0; r < 4; ++r) { const unsigned t = (unsigned)tid + 64u * r; const unsigned v = xb_ld(&b.bar[XB_XTAB + t]), rep = xb_ld(&b.bar[XB_XTAB + (t & 7u)]); ok = ok && (v != 0u) && (v == rep); }
            if (tid < 8) { const unsigned mine = xb_ld(&b.bar[XB_XTAB + tid]);
#pragma unroll
                for (int u = 0; u < 8; ++u) { const unsigned o = xb_ld(&b.bar[XB_XTAB + u]); if (u != tid && o == mine) ok = false; } }
        }
        const bool all = (__ballot(ok) == ~0ull);
        if (tid == 0) flag[0] = all ? 1u : 2u;
    }
    __syncthreads();
    return flag[0] == 1u;
}
__device__ __forceinline__ void phase_conv(Frame& F, const Args& A, int l) {
    frame_refresh(F);
    LAS float* scr = (LAS float*)(F.lds + F.wave * 16384);
    const int gw = F.bx * NWAVES + F.wave, NGW = F.G * NWAVES;
    unsigned char* ws = F.ws;
    const size_t LU = (size_t)DM * DFF, LW = (size_t)DM * INC, LB = (size_t)512 * DM, LO = (size_t)DM * DM;
    auto job = [&](int j) -> ConvJob {
        switch (j) {
        case 0: return ConvJob{A.in[I_F1G] + l * LU, A.in[I_F1U] + l * LU, A.in[I_F1N] + l * DM, (bf16*)(ws + WS_WUP1), DM, DFF, NUP, CV_UP, (DM / 64) * (NUP / 64), DM, 0};
        case 1: return ConvJob{A.in[I_F1D] + l * LU, nullptr, nullptr, (bf16*)(ws + WS_WDN1), DFF, DM, DM, CV_NAT, (DFF / 64) * (DM / 64), DFF, 0};
        case 2: return ConvJob{A.in[I_WIN] + l * LW, nullptr, A.in[I_MIXN] + l * DM, (bf16*)(ws + WS_WIN), DM, INC, NWIN, CV_WIN, (DM / 64) * (NWIN / 64), DM, 0};
        case 3: return ConvJob{A.in[I_WBA] + l * LB, nullptr, nullptr, (bf16*)(ws + WS_WPA), 512, DM, DM, CV_P32, (512 / 64) * (DM / 64), 1024, 0};
        case 4: return ConvJob{A.in[I_WBB] + l * LB, nullptr, nullptr, (bf16*)(ws + WS_WPA), 512, DM, DM, CV_P32, (512 / 64) * (DM / 64), 1024, 512};
        case 5: return ConvJob{A.in[I_WOUT] + l * LO, nullptr, nullptr, (bf16*)(ws + WS_WOUT), DM, DM, DM, CV_NAT, (DM / 64) * (DM / 64), DM, 0};
        case 6: return ConvJob{A.in[I_F2G] + l * LU, A.in[I_F2U] + l * LU, A.in[I_F2N] + l * DM, (bf16*)(ws + WS_WUP2), DM, DFF, NUP, CV_UP, (DM / 64) * (NUP / 64), DM, 0};
        case 7: return ConvJob{A.in[I_F2D] + l * LU, nullptr, nullptr, (bf16*)(ws + WS_WDN2), DFF, DM, DM, CV_NAT, (DFF / 64) * (DM / 64), DFF, 0};
        case 8: return ConvJob{A.in[I_CKW1] + (size_t)l * 2048 * 128, nullptr, nullptr, (bf16*)(ws + WS_W1TK), 2048, 128, 128, CV_NAT, (2048 / 64) * (128 / 64), 2048, 0};
        case 9: return ConvJob{A.in[I_CVW1] + (size_t)l * 2048 * 128, nullptr, nullptr, (bf16*)(ws + WS_W1TV), 2048, 128, 128, CV_NAT, (2048 / 64) * (128 / 64), 2048, 0};
        case 10: return ConvJob{A.in[I_CKW2] + (size_t)l * 128 * 64, nullptr, nullptr, (bf16*)(ws + WS_W2TK), 128, 64, 64, CV_NAT, 2, 128, 0};
        default: return ConvJob{A.in[I_CVW2] + (size_t)l * 128 * 64, nullptr, nullptr, (bf16*)(ws + WS_W2TV), 128, 64, 64, CV_NAT, 2, 128, 0};
        }
    };
    constexpr int NI[12] = {(DM / 64) * (NUP / 64), (DFF / 64) * (DM / 64), (DM / 64) * (NWIN / 64), (512 / 64) * (DM / 64), (512 / 64) * (DM / 64), (DM / 64) * (DM / 64), (DM / 64) * (NUP / 64), (DFF / 64) * (DM / 64), 64, 64, 2, 2};
    int total = 0;
#pragma unroll
    for (int j = 0; j < 12; ++j) total += NI[j];
    auto locate = [&](int it, int& jj, int& r) { r = it; jj = 11;
#pragma unroll
        for (int j = 0; j < 12; ++j) { if (jj == 11 && j < 11 && r < NI[j]) jj = j; else if (jj == 11 && j < 11) r -= NI[j]; } };
    int it = gw; bool have = it < total; ConvRegs cur; int jc = 0, rc = 0;
    if (have) { locate(it, jc, rc); const ConvJob Jc = job(jc); conv_load(Jc, rc, F.lane, cur); }
    while (have) {
        const int nit = it + NGW; const bool hn = nit < total; ConvRegs nxt; int jn = 0, rn = 0;
        { const ConvJob Jc = job(jc); conv_emit(Jc, rc, scr, F.lane, cur); }
        __builtin_amdgcn_sched_barrier(0);
        if (hn) { locate(nit, jn, rn); const ConvJob Jn = job(jn); conv_load(Jn, rn, F.lane, nxt); }
        __builtin_amdgcn_sched_barrier(0);
        { const ConvJob Jc = job(jc); conv_emit_b(Jc, rc, scr, F.lane, cur); }
        it = nit; have = hn; jc = jn; rc = rn;
        if (hn) cur = nxt;
    }
    if (F.wave == 0) for (int o = F.bx; o < 256; o += F.G) {
        const int kv = o >> 7, n = o & 127; const float* w1 = A.in[kv ? I_CVW1 : I_CKW1] + (size_t)l * 2048 * 128; const float* pos = A.in[kv ? I_CVP : I_CKP] + (size_t)l * 2048; float sacc = 0.f;
#pragma unroll 8
        for (int k = F.lane; k < 2048; k += 64) sacc += pos[k] * w1[(size_t)k * 128 + n];
        sacc = wave_sum(sacc); if (F.lane == 0) ((float*)(ws + WS_CBIAS))[o] = sacc;
    }
    if (l == 0) {
        const float* x = A.in[I_X]; bf16* XB = (bf16*)(ws + WS_XB); float* rowss = (float*)(ws + WS_ROWSS);
        for (int m0 = 4 * gw; m0 < MT; m0 += 4 * NGW) {
            f32x4 v[4][4];
#pragma unroll
            for (int rr = 0; rr < 4; ++rr) { const GAS f32x4* xr = (const GAS f32x4*)(x + (size_t)(m0 + rr) * DM) + F.lane;
#pragma unroll
                for (int j = 0; j < 4; ++j) v[rr][j] = __builtin_nontemporal_load(xr + 64 * j); }
#pragma unroll
            for (int rr = 0; rr < 4; ++rr) { const int m = m0 + rr; float s = 0.f;
#pragma unroll
                for (int j = 0; j < 4; ++j) s += (v[rr][j][0] * v[rr][j][0] + v[rr][j][1] * v[rr][j][1]) + (v[rr][j][2] * v[rr][j][2] + v[rr][j][3] * v[rr][j][3]);
                s = wave_sum(s);
                GAS v2u* o8 = (GAS v2u*)(XB + (size_t)m * DM) + F.lane;
#pragma unroll
                for (int j = 0; j < 4; ++j) { v2u w; w.x = pk2(v[rr][j][0], v[rr][j][1]); w.y = pk2(v[rr][j][2], v[rr][j][3]); o8[64 * j] = w; }
                if (F.lane < 4) rowss[(size_t)m * 4 + F.lane] = F.lane == 0 ? s : 0.f; }
        }
        float* rc = (float*)(ws + WS_ROPEC); float* rsn = (float*)(ws + WS_ROPES);
        for (int e = F.bx * 512 + F.tid; e < SEQ * 32; e += F.G * 512) { const int t = e >> 5, d = e & 31;
            const float inv = __builtin_amdgcn_exp2f(-(float)d * 0.41524101186092029f);
            const float ang = (float)t * inv;
            const float rev = ang * 0.15915494309189535f; const float fr = rev - __builtin_rintf(rev);
            rc[e] = __builtin_amdgcn_cosf(fr); rsn[e] = __builtin_amdgcn_sinf(fr); }
    }
}
__device__ __forceinline__ float gelu_tanh(float v) { const float u = 0.7978845608028654f * (v + 0.044715f * v * v * v); const float e = __builtin_amdgcn_exp2f(-2.8853900817779268f * u); return v * __builtin_amdgcn_rcpf(1.0f + e); }
__device__ __forceinline__ void phase_norm(Frame& F, const Args& A) {
    frame_refresh(F);
    const int vcu = (F.G % 8 == 0) ? (F.bx % 8) * (F.G / 8) + F.bx / 8 : F.bx; const float* g = A.in[I_FINN]; const bf16* XB = (const bf16*)(F.ws + WS_XB); const float* rowss = (const float*)(F.ws + WS_ROWSS);
    f32x4 gg[4];
#pragma unroll
    for (int j = 0; j < 4; ++j) gg[j] = *((const GAS f32x4*)g + F.lane + 64 * j);
    for (int v = vcu; v < 256; v += F.G) {
        v2u w[8][4]; f32x4 ss[8];
#pragma unroll
        for (int r = 0; r < 8; ++r) { const int m = 2048 * (v >> 5) + 8 * (v & 31) + F.wave + 256 * r; const GAS v2u* xb = (const GAS v2u*)(XB + (size_t)m * DM) + F.lane;
#pragma unroll
            for (int j = 0; j < 4; ++j) w[r][j] = xb[64 * j];
            ss[r] = *(const GAS f32x4*)(rowss + (size_t)m * 4); }
        __builtin_amdgcn_sched_barrier(0);
#pragma unroll
        for (int r = 0; r < 8; ++r) { const int m = 2048 * (v >> 5) + 8 * (v & 31) + F.wave + 256 * r; GAS f32x4* xr = (GAS f32x4*)(A.out + (size_t)m * DM) + F.lane;
            const float rs = __builtin_amdgcn_rsqf(((ss[r][0] + ss[r][1]) + (ss[r][2] + ss[r][3])) * (1.0f / 1024.0f) + 1e-6f);
#pragma unroll
            for (int j = 0; j < 4; ++j) { f32x4 x; x[0] = __uint_as_float(w[r][j].x << 16); x[1] = __uint_as_float(w[r][j].x & 0xffff0000u); x[2] = __uint_as_float(w[r][j].y << 16); x[3] = __uint_as_float(w[r][j].y & 0xffff0000u);
                xr[64 * j] = x * rs * gg[j]; } }
    }
}
namespace fa {
typedef short bf16x8 __attribute__((ext_vector_type(8)));
typedef short s16x4 __attribute__((ext_vector_type(4)));
typedef float f32x16 __attribute__((ext_vector_type(16)));
typedef float f32x2_t __attribute__((ext_vector_type(2))); typedef __bf16 bf16x2_t __attribute__((ext_vector_type(2)));
#define FA_MFMA(a, b, c) __builtin_amdgcn_mfma_f32_32x32x16_bf16((a), (b), (c), 0, 0, 0)
constexpr float FA_THR = 6.0f, FA_NINF = -INFINITY;
__device__ __forceinline__ int crow(int r, int h) { return (r & 3) + 8 * (r >> 2) + 4 * h; }
__device__ __forceinline__ float opaque_inf() { float v = __builtin_inff(); asm volatile("" : "+s"(v)); return v; }
#define mx2(a, b) __builtin_amdgcn_fmed3f((a), (b), pinf_)
__device__ __forceinline__ unsigned cvtpk(float lo, float hi) { f32x2_t v = {lo, hi}; bf16x2_t b = __builtin_convertvector(v, bf16x2_t); return __builtin_bit_cast(unsigned, b); }
__device__ __forceinline__ float swap_max(float x) { auto rr = __builtin_amdgcn_permlane32_swap(__float_as_uint(x), __float_as_uint(x), false, false); return fmaxf(__uint_as_float(rr[0]), __uint_as_float(rr[1])); }
__device__ __forceinline__ float swap_sum(float x) { auto rr = __builtin_amdgcn_permlane32_swap(__float_as_uint(x), __float_as_uint(x), false, false); return __uint_as_float(rr[0]) + __uint_as_float(rr[1]); }
__device__ __forceinline__ float swap_other(float x, int hi) { auto rr = __builtin_amdgcn_permlane32_swap(__float_as_uint(x), __float_as_uint(x), false, false); return hi ? __uint_as_float(rr[0]) : __uint_as_float(rr[1]); }
__device__ __forceinline__ bf16x8 pack8(const f32x16& p, int s) { v4u w; w.x = cvtpk(p[8 * s], p[8 * s + 1]); w.y = cvtpk(p[8 * s + 2], p[8 * s + 3]); w.z = cvtpk(p[8 * s + 4], p[8 * s + 5]); w.w = cvtpk(p[8 * s + 6], p[8 * s + 7]); return __builtin_bit_cast(bf16x8, w); }
__device__ __forceinline__ bf16x8 vfrag(const bf16* p) { const s16x4 a = *(const GAS s16x4*)p, b = *(const GAS s16x4*)(p + 8); return (bf16x8){a[0], a[1], a[2], a[3], b[0], b[1], b[2], b[3]}; }
struct Qf { bf16x8 f[4]; };
__device__ __forceinline__ void load_rows(Qf& q, const bf16* rowp  ) {
#pragma unroll
    for (int s = 0; s < 4; ++s) q.f[s] = *(const GAS bf16x8*)(rowp + 16 * s);
}
__device__ __forceinline__ f32x16 qk_tile(const bf16* kbase, const Qf& q, const f32x16& c0, int r32, int hi) {
    Qf k; load_rows(k, kbase + r32 * 64 + hi * 8);
    f32x16 S = FA_MFMA(k.f[0], q.f[0], c0); S = FA_MFMA(k.f[1], q.f[1], S); S = FA_MFMA(k.f[2], q.f[2], S); S = FA_MFMA(k.f[3], q.f[3], S); return S;
}
__device__ __forceinline__ void pv_tile(f32x16& o0, f32x16& o1, const bf16* vbase, int vs, const f32x16& P, int r32, int hi) {
    const bf16* v0 = vbase + (size_t)r32 * vs + 4 * hi; const bf16* v1 = v0 + (size_t)32 * vs;
    const bf16x8 a00 = vfrag(v0), a01 = vfrag(v0 + 16), a10 = vfrag(v1), a11 = vfrag(v1 + 16);
    const bf16x8 p0 = pack8(P, 0), p1 = pack8(P, 1);
    o0 = FA_MFMA(a00, p0, o0); o0 = FA_MFMA(a01, p1, o0); o1 = FA_MFMA(a10, p0, o1); o1 = FA_MFMA(a11, p1, o1);
}
struct Acc { f32x16 o0, o1, negm; float m, l; bool seen; };
__device__ __forceinline__ void acc_reset(Acc& a) {
#pragma unroll
    for (int r = 0; r < 16; ++r) { a.o0[r] = 0.f; a.o1[r] = 0.f; a.negm[r] = 0.f; }
    a.m = 0.f; a.l = 0.f; a.seen = false;
}
__device__ __forceinline__ void step32(Acc& a, const Qf& q, const bf16* kbase, const bf16* vbase, int vs, int r32, int hi, bool needmask, int lo, int up, bool rowon) {
    f32x16 S = qk_tile(kbase, q, a.negm, r32, hi);
    if (needmask) {
#pragma unroll
        for (int r = 0; r < 16; ++r) { const int c = crow(r, hi); S[r] = (rowon && c >= lo && c <= up) ? S[r] : FA_NINF; }
    }
    float rm = fmaxf(fmaxf(fmaxf(S[0], S[1]), fmaxf(S[2], S[3])), fmaxf(fmaxf(S[4], S[5]), fmaxf(S[6], S[7])));
    rm = fmaxf(rm, fmaxf(fmaxf(fmaxf(S[8], S[9]), fmaxf(S[10], S[11])), fmaxf(fmaxf(S[12], S[13]), fmaxf(S[14], S[15]))));
    rm = swap_max(rm);
    const bool big = rm > (a.seen ? FA_THR : -3.0e38f);
    if (__any(big)) { const float dl = big ? rm : 0.f; a.m += dl; const float f = __builtin_amdgcn_exp2f(-dl); a.l *= f;
#pragma unroll
        for (int r = 0; r < 16; ++r) { a.o0[r] *= f; a.o1[r] *= f; S[r] -= dl; a.negm[r] = -a.m; } }
    a.seen = a.seen || (rm > -3.0e38f);
    float ps = 0.f;
#pragma unroll
    for (int r = 0; r < 16; ++r) { S[r] = __builtin_amdgcn_exp2f(S[r]); ps += S[r]; }
    a.l += ps;
    pv_tile(a.o0, a.o1, vbase, vs, S, r32, hi);
}
__device__ __forceinline__ void acc_finish(const Acc& a, f32x16& t0, f32x16& t1, float gate) {
    const float l = swap_sum(a.l); const float sc = l > 0.f ? gate * __builtin_amdgcn_rcpf(l) : 0.f;
#pragma unroll
    for (int r = 0; r < 16; ++r) { t0[r] += a.o0[r] * sc; t1[r] += a.o1[r] * sc; }
}
constexpr int L_TILE = 49152, TILE_BYTES = 16384;
struct TileRegs { v4u k, v; };
__device__ __forceinline__ void tile_issue(TileRegs& t, const bf16* kp  , const bf16* vp  , int tid) {
    t.k = *(const GAS v4u*)(kp + tid * 8); t.v = *(const GAS v4u*)(vp + (size_t)(tid >> 3) * SEQ + (tid & 7) * 8);
}
__device__ __forceinline__ void tile_commit(LAS unsigned char* buf, const TileRegs& t, int tid) {
    const int row = tid >> 3, pc = tid & 7;
    *(LAS v4u*)(buf + row * 128 + ((pc ^ ((row >> 1) & 7)) << 4)) = t.k;
    const int x = (row >> 1) & 7, g = pc >> 1, od = pc & 1; v2u lo, hi2; lo.x = t.v.x; lo.y = t.v.y; hi2.x = t.v.z; hi2.y = t.v.w;
    LAS unsigned char* vr = buf + 8192 + row * 128;
    *(LAS v2u*)(vr + (((2 * g) ^ x) << 4) + 8 * od) = lo; *(LAS v2u*)(vr + (((2 * g + 1) ^ x) << 4) + 8 * od) = hi2;
}
__device__ __forceinline__ bf16x8 lds_vfrag(const LAS unsigned char* vrow  , int c16, int x) { return *(const LAS bf16x8*)(vrow + ((c16 ^ x) << 4)); }
__device__ __forceinline__ void step32l(Acc& a, const Qf& q, const LAS unsigned char* buf, int kt, int r32, int hi, bool needmask, int lo, int up, bool rowon) {
    const float pinf_ = opaque_inf();
    const int key = 32 * kt + r32; const LAS unsigned char* kr = buf + key * 128; const int kx = (key >> 1) & 7;
    const bf16x8 k0 = *(const LAS bf16x8*)(kr + (((0 + hi) ^ kx) << 4)), k1 = *(const LAS bf16x8*)(kr + (((2 + hi) ^ kx) << 4)), k2 = *(const LAS bf16x8*)(kr + (((4 + hi) ^ kx) << 4)), k3 = *(const LAS bf16x8*)(kr + (((6 + hi) ^ kx) << 4));
    f32x16 S = FA_MFMA(k0, q.f[0], a.negm); S = FA_MFMA(k1, q.f[1], S); S = FA_MFMA(k2, q.f[2], S); S = FA_MFMA(k3, q.f[3], S);
    const LAS unsigned char* v0 = buf + 8192 + r32 * 128; const LAS unsigned char* v1 = v0 + 32 * 128; const int x0 = (r32 >> 1) & 7;
    const bf16x8 a00 = lds_vfrag(v0, 4 * kt + hi, x0), a01 = lds_vfrag(v0, 4 * kt + 2 + hi, x0), a10 = lds_vfrag(v1, 4 * kt + hi, x0), a11 = lds_vfrag(v1, 4 * kt + 2 + hi, x0);
    if (needmask) {
#pragma unroll
        for (int r = 0; r < 16; ++r) { const int c = crow(r, hi); S[r] = (rowon && c >= lo && c <= up) ? S[r] : FA_NINF; }
    }
    float rm = mx2(mx2(mx2(S[0], S[1]), mx2(S[2], S[3])), mx2(mx2(S[4], S[5]), mx2(S[6], S[7])));
    rm = mx2(rm, mx2(mx2(mx2(S[8], S[9]), mx2(S[10], S[11])), mx2(mx2(S[12], S[13]), mx2(S[14], S[15]))));
    rm = swap_max(rm);
    const bool big = rm > (a.seen ? FA_THR : -3.0e38f);
    if (__any(big)) { const float dl = big ? rm : 0.f; a.m += dl; const float f = __builtin_amdgcn_exp2f(-dl); a.l *= f;
#pragma unroll
        for (int r = 0; r < 16; ++r) { a.o0[r] *= f; a.o1[r] *= f; S[r] -= dl; a.negm[r] = -a.m; } }
    a.seen = a.seen || (rm > -3.0e38f);
    float ps = 0.f;
#pragma unroll
    for (int r = 0; r < 16; ++r) { S[r] = __builtin_amdgcn_exp2f(S[r]); ps += S[r]; }
    a.l += ps;
    const bf16x8 p0 = pack8(S, 0), p1 = pack8(S, 1);
    a.o0 = FA_MFMA(a00, p0, a.o0); a.o0 = FA_MFMA(a01, p1, a.o0); a.o1 = FA_MFMA(a10, p0, a.o1); a.o1 = FA_MFMA(a11, p1, a.o1);
}
__device__ __forceinline__ void step64l(Acc& a, const Qf& q, const LAS unsigned char* buf, int r32, int hi, bool rowmask, bool rowon) {
    const float pinf_ = opaque_inf();
    const LAS unsigned char* kr0 = buf + r32 * 128; const LAS unsigned char* kr1 = kr0 + 32 * 128; const int kx = (r32 >> 1) & 7;
    f32x16 S0, S1;
    { const bf16x8 k0 = *(const LAS bf16x8*)(kr0 + (((0 + hi) ^ kx) << 4)), k1 = *(const LAS bf16x8*)(kr0 + (((2 + hi) ^ kx) << 4)), k2 = *(const LAS bf16x8*)(kr0 + (((4 + hi) ^ kx) << 4)), k3 = *(const LAS bf16x8*)(kr0 + (((6 + hi) ^ kx) << 4));
      const bf16x8 j0 = *(const LAS bf16x8*)(kr1 + (((0 + hi) ^ kx) << 4)), j1 = *(const LAS bf16x8*)(kr1 + (((2 + hi) ^ kx) << 4)), j2 = *(const LAS bf16x8*)(kr1 + (((4 + hi) ^ kx) << 4)), j3 = *(const LAS bf16x8*)(kr1 + (((6 + hi) ^ kx) << 4));
      S0 = FA_MFMA(k0, q.f[0], a.negm); S1 = FA_MFMA(j0, q.f[0], a.negm); S0 = FA_MFMA(k1, q.f[1], S0); S1 = FA_MFMA(j1, q.f[1], S1);
      S0 = FA_MFMA(k2, q.f[2], S0); S1 = FA_MFMA(j2, q.f[2], S1); S0 = FA_MFMA(k3, q.f[3], S0); S1 = FA_MFMA(j3, q.f[3], S1); }
    const LAS unsigned char* v0 = buf + 8192 + r32 * 128; const LAS unsigned char* v1 = v0 + 32 * 128; const int x0 = (r32 >> 1) & 7;
    const bf16x8 a00 = lds_vfrag(v0, hi, x0), a01 = lds_vfrag(v0, 2 + hi, x0), a02 = lds_vfrag(v0, 4 + hi, x0), a03 = lds_vfrag(v0, 6 + hi, x0);
    float ra = mx2(mx2(mx2(S0[0], S0[1]), mx2(S0[2], S0[3])), mx2(mx2(S0[4], S0[5]), mx2(S0[6], S0[7])));
    ra = mx2(ra, mx2(mx2(mx2(S0[8], S0[9]), mx2(S0[10], S0[11])), mx2(mx2(S0[12], S0[13]), mx2(S0[14], S0[15]))));
    float rb = mx2(mx2(mx2(S1[0], S1[1]), mx2(S1[2], S1[3])), mx2(mx2(S1[4], S1[5]), mx2(S1[6], S1[7])));
    rb = mx2(rb, mx2(mx2(mx2(S1[8], S1[9]), mx2(S1[10], S1[11])), mx2(mx2(S1[12], S1[13]), mx2(S1[14], S1[15]))));
    float rm = mx2(ra, rb);
    if (rowmask) rm = rowon ? rm : FA_NINF;
    rm = swap_max(rm);
    const bool big = rm > (a.seen ? FA_THR : -3.0e38f);
    if (__any(big)) { const float dl = big ? rm : 0.f; a.m += dl; const float f = __builtin_amdgcn_exp2f(-dl); a.l *= f;
#pragma unroll
        for (int r = 0; r < 16; ++r) { a.o0[r] *= f; a.o1[r] *= f; S0[r] -= dl; S1[r] -= dl; a.negm[r] = -a.m; } }
    a.seen = a.seen || (rm > -3.0e38f);
    float ps = 0.f, pt = 0.f;
#pragma unroll
    for (int r = 0; r < 16; ++r) { S0[r] = __builtin_amdgcn_exp2f(S0[r]); ps += S0[r]; S1[r] = __builtin_amdgcn_exp2f(S1[r]); pt += S1[r]; }
    ps += pt;
    v4u w0 = __builtin_bit_cast(v4u, pack8(S0, 0)), w1 = __builtin_bit_cast(v4u, pack8(S0, 1)), w2 = __builtin_bit_cast(v4u, pack8(S1, 0)), w3 = __builtin_bit_cast(v4u, pack8(S1, 1));
    if (rowmask) { const unsigned km = rowon ? 0xffffffffu : 0u; ps = rowon ? ps : 0.f;
        w0.x &= km; w0.y &= km; w0.z &= km; w0.w &= km; w1.x &= km; w1.y &= km; w1.z &= km; w1.w &= km; w2.x &= km; w2.y &= km; w2.z &= km; w2.w &= km; w3.x &= km; w3.y &= km; w3.z &= km; w3.w &= km; }
    a.l += ps;
    const bf16x8 p0 = __builtin_bit_cast(bf16x8, w0), p1 = __builtin_bit_cast(bf16x8, w1), p2 = __builtin_bit_cast(bf16x8, w2), p3 = __builtin_bit_cast(bf16x8, w3);
    const bf16x8 a10 = lds_vfrag(v1, hi, x0), a11 = lds_vfrag(v1, 2 + hi, x0), a12 = lds_vfrag(v1, 4 + hi, x0), a13 = lds_vfrag(v1, 6 + hi, x0);
    a.o0 = FA_MFMA(a00, p0, a.o0); a.o0 = FA_MFMA(a01, p1, a.o0); a.o0 = FA_MFMA(a02, p2, a.o0); a.o0 = FA_MFMA(a03, p3, a.o0);
    a.o1 = FA_MFMA(a10, p0, a.o1); a.o1 = FA_MFMA(a11, p1, a.o1); a.o1 = FA_MFMA(a12, p2, a.o1); a.o1 = FA_MFMA(a13, p3, a.o1);
}
__device__ __forceinline__ void step64m(Acc& a, const Qf& q, const LAS unsigned char* buf, int r32, int hi, bool needmask, int loA, int upA, int loB, int upB) {
    const float pinf_ = opaque_inf();
    const LAS unsigned char* kr0 = buf + r32 * 128; const LAS unsigned char* kr1 = kr0 + 32 * 128; const int kx = (r32 >> 1) & 7;
    f32x16 S0, S1;
    { const bf16x8 k0 = *(const LAS bf16x8*)(kr0 + (((0 + hi) ^ kx) << 4)), k1 = *(const LAS bf16x8*)(kr0 + (((2 + hi) ^ kx) << 4)), k2 = *(const LAS bf16x8*)(kr0 + (((4 + hi) ^ kx) << 4)), k3 = *(const LAS bf16x8*)(kr0 + (((6 + hi) ^ kx) << 4));
      const bf16x8 j0 = *(const LAS bf16x8*)(kr1 + (((0 + hi) ^ kx) << 4)), j1 = *(const LAS bf16x8*)(kr1 + (((2 + hi) ^ kx) << 4)), j2 = *(const LAS bf16x8*)(kr1 + (((4 + hi) ^ kx) << 4)), j3 = *(const LAS bf16x8*)(kr1 + (((6 + hi) ^ kx) << 4));
      S0 = FA_MFMA(k0, q.f[0], a.negm); S1 = FA_MFMA(j0, q.f[0], a.negm); S0 = FA_MFMA(k1, q.f[1], S0); S1 = FA_MFMA(j1, q.f[1], S1);
      S0 = FA_MFMA(k2, q.f[2], S0); S1 = FA_MFMA(j2, q.f[2], S1); S0 = FA_MFMA(k3, q.f[3], S0); S1 = FA_MFMA(j3, q.f[3], S1); }
    const LAS unsigned char* v0 = buf + 8192 + r32 * 128; const LAS unsigned char* v1 = v0 + 32 * 128; const int x0 = (r32 >> 1) & 7;
    const bf16x8 a00 = lds_vfrag(v0, hi, x0), a01 = lds_vfrag(v0, 2 + hi, x0), a02 = lds_vfrag(v0, 4 + hi, x0), a03 = lds_vfrag(v0, 6 + hi, x0);
    if (needmask) {
#pragma unroll
        for (int r = 0; r < 16; ++r) { const int c = crow(r, hi); S0[r] = (c >= loA && c <= upA) ? S0[r] : FA_NINF; S1[r] = (c >= loB && c <= upB) ? S1[r] : FA_NINF; }
    }
    float ra = mx2(mx2(mx2(S0[0], S0[1]), mx2(S0[2], S0[3])), mx2(mx2(S0[4], S0[5]), mx2(S0[6], S0[7])));
    ra = mx2(ra, mx2(mx2(mx2(S0[8], S0[9]), mx2(S0[10], S0[11])), mx2(mx2(S0[12], S0[13]), mx2(S0[14], S0[15]))));
    float rb = mx2(mx2(mx2(S1[0], S1[1]), mx2(S1[2], S1[3])), mx2(mx2(S1[4], S1[5]), mx2(S1[6], S1[7])));
    rb = mx2(rb, mx2(mx2(mx2(S1[8], S1[9]), mx2(S1[10], S1[11])), mx2(mx2(S1[12], S1[13]), mx2(S1[14], S1[15]))));
    float rm = mx2(ra, rb);
    rm = swap_max(rm);
    const bool big = rm > (a.seen ? FA_THR : -3.0e38f);
    if (__any(big)) { const float dl = big ? rm : 0.f; a.m += dl; const float f = __builtin_amdgcn_exp2f(-dl); a.l *= f;
#pragma unroll
        for (int r = 0; r < 16; ++r) { a.o0[r] *= f; a.o1[r] *= f; S0[r] -= dl; S1[r] -= dl; a.negm[r] = -a.m; } }
    a.seen = a.seen || (rm > -3.0e38f);
    float ps = 0.f, pt = 0.f;
#pragma unroll
    for (int r = 0; r < 16; ++r) { S0[r] = __builtin_amdgcn_exp2f(S0[r]); ps += S0[r]; S1[r] = __builtin_amdgcn_exp2f(S1[r]); pt += S1[r]; }
    ps += pt;
    v4u w0 = __builtin_bit_cast(v4u, pack8(S0, 0)), w1 = __builtin_bit_cast(v4u, pack8(S0, 1)), w2 = __builtin_bit_cast(v4u, pack8(S1, 0)), w3 = __builtin_bit_cast(v4u, pack8(S1, 1));
    a.l += ps;
    const bf16x8 p0 = __builtin_bit_cast(bf16x8, w0), p1 = __builtin_bit_cast(bf16x8, w1), p2 = __builtin_bit_cast(bf16x8, w2), p3 = __builtin_bit_cast(bf16x8, w3);
    const bf16x8 a10 = lds_vfrag(v1, hi, x0), a11 = lds_vfrag(v1, 2 + hi, x0), a12 = lds_vfrag(v1, 4 + hi, x0), a13 = lds_vfrag(v1, 6 + hi, x0);
    a.o0 = FA_MFMA(a00, p0, a.o0); a.o0 = FA_MFMA(a01, p1, a.o0); a.o0 = FA_MFMA(a02, p2, a.o0); a.o0 = FA_MFMA(a03, p3, a.o0);
    a.o1 = FA_MFMA(a10, p0, a.o1); a.o1 = FA_MFMA(a11, p1, a.o1); a.o1 = FA_MFMA(a12, p2, a.o1); a.o1 = FA_MFMA(a13, p3, a.o1);
}
__device__ __forceinline__ void park_store(LAS float* pp, const f32x16& t0, const f32x16& t1) {
#pragma unroll
    for (int r = 0; r < 16; ++r) { pp[r * 64] = t0[r]; pp[(16 + r) * 64] = t1[r]; }
}
__device__ __forceinline__ void park_add(LAS float* pp, const Acc& a, float gate) {
    const float l = swap_sum(a.l); const float sc = l > 0.f ? gate * __builtin_amdgcn_rcpf(l) : 0.f;
#pragma unroll
    for (int r = 0; r < 16; ++r) { pp[r * 64] += a.o0[r] * sc; pp[(16 + r) * 64] += a.o1[r] * sc; }
}
__device__ __forceinline__ void park_final(LAS float* pp, const Acc& a, float gate, f32x16& t0, f32x16& t1) {
    const float l = swap_sum(a.l); const float sc = l > 0.f ? gate * __builtin_amdgcn_rcpf(l) : 0.f;
#pragma unroll
    for (int r = 0; r < 16; ++r) { t0[r] = pp[r * 64] + a.o0[r] * sc; t1[r] = pp[(16 + r) * 64] + a.o1[r] * sc; }
}
__device__ __forceinline__ void store_out(bf16* dst  , const f32x16& t0, const f32x16& t1, int hi) {
#pragma unroll
    for (int rg = 0; rg < 4; ++rg) { v2u w; w.x = cvtpk(t0[4 * rg], t0[4 * rg + 1]); w.y = cvtpk(t0[4 * rg + 2], t0[4 * rg + 3]); *(GAS v2u*)(dst + 8 * rg + 4 * hi) = w;
        v2u x; x.x = cvtpk(t1[4 * rg], t1[4 * rg + 1]); x.y = cvtpk(t1[4 * rg + 2], t1[4 * rg + 3]); *(GAS v2u*)(dst + 32 + 8 * rg + 4 * hi) = x; }
}
constexpr int L_IMP = 0, L_VS = 8 * 32 * 33 * 4, L_SELM = L_VS + 64 * 33 * 4;

__device__ __forceinline__ void nsa_unit(unsigned char* ws, bf16* attout, LAS unsigned char* lds, int wave_s, int bg, int tb) {
    const int tid = fresh_tid(wave_s); asm volatile("" : "+s"(ws));
    const int lane = tid & 63, r32 = lane & 31, hi = lane >> 5, w = __builtin_amdgcn_readfirstlane(tid >> 6), rr = w & 3, th = w >> 2;
    if (w >= 4) __builtin_amdgcn_s_setprio(1);
    const int b = bg >> 1, g = bg & 1, head = 4 * g + rr, t = 64 * tb + 32 * th + r32;
    unsigned char* ar = ws + WS_ARENA + (size_t)b * ARENA_B;
    Qf q; load_rows(q, (const bf16*)(ar + A_QA) + ((size_t)head * SEQ + t) * 64 + hi * 8);
    const GAS float* gs = (const GAS float*)(ar + A_GS) + (size_t)t * 32 + head * 3;
    const float g0 = gs[0];
    f32x16 t0, t1;
    const bf16* Ks = (const bf16*)(ar + A_KS) + (size_t)g * SEQ * 64; const bf16* Vs = (const bf16*)(ar + A_VST) + (size_t)g * 64 * SEQ;
    TileRegs tr; tile_issue(tr, Ks, Vs, tid);
    LAS float* IMP = (LAS float*)(lds + L_IMP); LAS float* VS = (LAS float*)(lds + L_VS); LAS unsigned* SELM = (LAS unsigned*)(lds + L_SELM);
    {
        const int ntile = (tb >> 3) + 1;
        const int clim = t >= 31 ? (t - 31) >> 4 : -1;
        const bf16* K = (const bf16*)(ws + WS_KCB) + (size_t)bg * 128 * 64; const bf16* V = (const bf16*)(ws + WS_VCBT) + (size_t)bg * 64 * 128;
        f32x16 zero;
#pragma unroll
        for (int r = 0; r < 16; ++r) zero[r] = 0.f;
        f32x16 S[4]; float rm = FA_NINF;
        Qf kf[4]; bf16x8 vf[4][4];
#pragma unroll
        for (int ti = 0; ti < 4; ++ti) if (ti < ntile) load_rows(kf[ti], K + (size_t)(ti * 32 + r32) * 64 + hi * 8);
#pragma unroll
        for (int ti = 0; ti < 4; ++ti) if (ti < ntile) { const bf16* v0 = V + (size_t)r32 * 128 + ti * 32 + 4 * hi; const bf16* v1 = v0 + (size_t)32 * 128;
            vf[ti][0] = vfrag(v0); vf[ti][1] = vfrag(v0 + 16); vf[ti][2] = vfrag(v1); vf[ti][3] = vfrag(v1 + 16); }
        __builtin_amdgcn_sched_barrier(0);
#pragma unroll
        for (int ti = 0; ti < 4; ++ti) if (ti < ntile) { S[ti] = FA_MFMA(kf[ti].f[0], q.f[0], zero); S[ti] = FA_MFMA(kf[ti].f[1], q.f[1], S[ti]); S[ti] = FA_MFMA(kf[ti].f[2], q.f[2], S[ti]); S[ti] = FA_MFMA(kf[ti].f[3], q.f[3], S[ti]); }
#pragma unroll
        for (int ti = 0; ti < 4; ++ti) if (ti < ntile) {
#pragma unroll
            for (int r = 0; r < 16; ++r) { S[ti][r] = (32 * ti + crow(r, hi) <= clim) ? S[ti][r] : FA_NINF; rm = fmaxf(rm, S[ti][r]); } }
        rm = swap_max(rm); const float mref = rm > -3.0e38f ? rm : 0.f; float l = 0.f;
#pragma unroll
        for (int ti = 0; ti < 4; ++ti) if (ti < ntile) {
#pragma unroll
            for (int r = 0; r < 16; ++r) { S[ti][r] = __builtin_amdgcn_exp2f(S[ti][r] - mref); l += S[ti][r]; } }
        l = swap_sum(l); const float il = l > 0.f ? __builtin_amdgcn_rcpf(l) : 0.f;
#pragma unroll
        for (int r = 0; r < 16; ++r) { t0[r] = 0.f; t1[r] = 0.f; }
        LAS float* myimp = IMP + (w * 32 + r32) * 33; float carry = 0.f;
#pragma unroll
        for (int ti = 0; ti < 4; ++ti) if (ti < ntile) {
#pragma unroll
            for (int r = 0; r < 16; ++r) S[ti][r] *= il;
            float lo4[4];
#pragma unroll
            for (int rg = 0; rg < 4; ++rg) lo4[rg] = swap_other(S[ti][4 * rg + 3], hi);
#pragma unroll
            for (int rg = 0; rg < 4; ++rg) { const float gsum = (S[ti][4 * rg] + S[ti][4 * rg + 1]) + (S[ti][4 * rg + 2] + S[ti][4 * rg + 3]);
                const float prev = hi ? lo4[rg] : (rg > 0 ? lo4[rg > 0 ? rg - 1 : 0] : carry);
                myimp[2 * (4 * ti + rg) + hi] = gsum + prev; }
            carry = lo4[3];
            { const bf16x8 p0 = pack8(S[ti], 0), p1 = pack8(S[ti], 1);
              t0 = FA_MFMA(vf[ti][0], p0, t0); t0 = FA_MFMA(vf[ti][1], p1, t0); t1 = FA_MFMA(vf[ti][2], p0, t1); t1 = FA_MFMA(vf[ti][3], p1, t1); }
        }
#pragma unroll
        for (int r = 0; r < 16; ++r) { t0[r] *= g0; t1[r] *= g0; }
    }
    __syncthreads();
    {
        const int tk = tid >> 3, jg = tid & 7, tht = tk >> 5, qt = tk & 31;
#pragma unroll
        for (int i = 0; i < 4; ++i) { const int j = 4 * jg + i; float x = 0.f;
#pragma unroll
            for (int r = 0; r < 4; ++r) x += IMP[((tht * 4 + r) * 32 + qt) * 33 + j];
            VS[tk * 33 + j] = (j <= tb) ? x + ((j == 0 || j == tb || j == tb - 1) ? 1e4f : 0.f) : -1e30f; }
        if (tid < 64) SELM[tid] = 0u;
    }
    __syncthreads();
    {
        const int tk = tid >> 3, part = tid & 7; float v[32];
#pragma unroll
        for (int j = 0; j < 32; ++j) v[j] = VS[tk * 33 + j];
        unsigned bits = 0;
#pragma unroll
        for (int i = 0; i < 4; ++i) { const int j = 4 * part + i; const float vj = VS[tk * 33 + j]; int rank = 0;
#pragma unroll
            for (int k = 0; k < 32; ++k) rank += (v[k] > vj || (v[k] == vj && k < j)) ? 1 : 0;
            if (rank < 16 && j <= tb) bits |= 1u << j; }
        __hip_atomic_fetch_or((LAS unsigned*)&SELM[tk], bits, __ATOMIC_RELAXED, __HIP_MEMORY_SCOPE_WORKGROUP);
    }
    __syncthreads();
    const unsigned selm = SELM[32 * th + r32];

    LAS float* pp = (LAS float*)(lds + (w < 6 ? 81920 + w * 8192 : (w - 6) * 8192)) + lane;
    park_store(pp, t0, t1);
    Acc a; LAS unsigned char* tb0 = lds + L_TILE;
    const bf16* Kw = (const bf16*)(ar + A_KW) + (size_t)g * SEQ * 64; const bf16* Vw = (const bf16*)(ar + A_VWT) + (size_t)g * 64 * SEQ;
    const int jw0 = tb >= 8 ? tb - 8 : 0;
    {
        acc_reset(a);
        for (int j = 0; j < tb; ++j) {
            LAS unsigned char* buf = tb0 + (j & 1) * TILE_BYTES;
            tile_commit(buf, tr, tid);
            tile_issue(tr, Ks + (size_t)(64 * (j + 1)) * 64, Vs + 64 * (j + 1), tid);
            __syncthreads();
            const bool on = (selm >> j) & 1u; const unsigned long long bal = __ballot(on);
            if (bal != 0ull) step64l(a, q, buf, r32, hi, bal != ~0ull, on);
        }
        {
            LAS unsigned char* buf = tb0 + (tb & 1) * TILE_BYTES;
            tile_commit(buf, tr, tid);
            tile_issue(tr, Kw + (size_t)(64 * jw0) * 64, Vw + 64 * jw0, tid);
            __syncthreads();
            step64m(a, q, buf, r32, hi, true, 0, th ? 31 : r32, th ? 0 : 1, th ? r32 : 0);
        }
        park_add(pp, a, gs[1]);
    }

    __syncthreads();
    {
        acc_reset(a);
        const int as = 2 * tb + th, ks0 = as >= 16 ? as - 16 : 0;
        auto edge_tile = [&](int j) {
            LAS unsigned char* buf = tb0 + (j & 1) * TILE_BYTES;
            tile_commit(buf, tr, tid);
            if (j < tb) tile_issue(tr, Kw + (size_t)(64 * (j + 1)) * 64, Vw + 64 * (j + 1), tid);
            __syncthreads();
            const int ka = 2 * j, kb = 2 * j + 1;
            const bool fa_ = (as >= 16 && ka == as - 16), la_ = (ka == as), fb_ = (as >= 16 && kb == as - 16), lb_ = (kb == as);
            const bool acta = (ka >= ks0 && ka <= as), actb = (kb >= ks0 && kb <= as);
            if (acta || actb) step64m(a, q, buf, r32, hi, !(acta && actb && !fa_ && !la_ && !fb_ && !lb_),
                                      !acta ? 1 : (fa_ ? r32 + 1 : 0), !acta ? 0 : (la_ ? r32 : 31), !actb ? 1 : (fb_ ? r32 + 1 : 0), !actb ? 0 : (lb_ ? r32 : 31));
        };
        edge_tile(jw0);
        for (int j = jw0 + 1; j < tb; ++j) {
            LAS unsigned char* buf = tb0 + (j & 1) * TILE_BYTES;
            tile_commit(buf, tr, tid);
            tile_issue(tr, Kw + (size_t)(64 * (j + 1)) * 64, Vw + 64 * (j + 1), tid);
            __syncthreads();
            step64l(a, q, buf, r32, hi, false, true);
        }
        if (tb > jw0) edge_tile(tb);
        park_final(pp, a, gs[2], t0, t1);
    }
    store_out(attout + (size_t)b * OUT_BATCH_E + (size_t)t * 1024 + head * 64, t0, t1, hi);
    __builtin_amdgcn_s_setprio(0);

    __syncthreads();
}
__device__ __forceinline__ void moba_unit(unsigned char* ws, bf16* attout, LAS unsigned char* lds, int wave_s, int bh, int c8) {
    const int tid = fresh_tid(wave_s); asm volatile("" : "+s"(ws));
    const int lane = tid & 63, r32 = lane & 31, hi = lane >> 5, w = __builtin_amdgcn_readfirstlane(tid >> 6);
    if (w >= 4) __builtin_amdgcn_s_setprio(1);
    const int b = bh >> 3, h = bh & 7, t = 256 * c8 + 32 * w + r32;
    unsigned char* ar = ws + WS_ARENA + (size_t)b * ARENA_B;
    Qf q; load_rows(q, (const bf16*)(ar + A_QB) + ((size_t)h * SEQ + t) * 64 + hi * 8);
    const bf16* K = (const bf16*)(ar + A_KB) + (size_t)h * SEQ * 64; const bf16* V = (const bf16*)(ar + A_VBT) + (size_t)h * 64 * SEQ;
    TileRegs tr; tile_issue(tr, K, V, tid);
    unsigned selm = 0;
    if (c8 > 0) {
        LAS bf16* KMl = (LAS bf16*)(lds + L_TILE + 2 * TILE_BYTES);
        if (w < c8) { const int ko = lane >> 3, ch = lane & 7; const bf16* base = K + (size_t)(256 * w) * 64; float s8[8];
#pragma unroll
            for (int i = 0; i < 8; ++i) s8[i] = 0.f;
            for (int ib = 0; ib < 32; ib += 16) { v4u wv[16];
#pragma unroll
                for (int i = 0; i < 16; ++i) wv[i] = *(const GAS v4u*)(base + (size_t)(8 * (ib + i) + ko) * 64 + ch * 8);
                __builtin_amdgcn_sched_barrier(0);
#pragma unroll
                for (int i = 0; i < 16; ++i) {
                    s8[0] += __uint_as_float(wv[i].x << 16); s8[1] += __uint_as_float(wv[i].x & 0xffff0000u); s8[2] += __uint_as_float(wv[i].y << 16); s8[3] += __uint_as_float(wv[i].y & 0xffff0000u);
                    s8[4] += __uint_as_float(wv[i].z << 16); s8[5] += __uint_as_float(wv[i].z & 0xffff0000u); s8[6] += __uint_as_float(wv[i].w << 16); s8[7] += __uint_as_float(wv[i].w & 0xffff0000u); } }
#pragma unroll
            for (int i = 0; i < 8; ++i) { s8[i] += __shfl_xor(s8[i], 8); s8[i] += __shfl_xor(s8[i], 16); s8[i] += __shfl_xor(s8[i], 32); s8[i] *= (1.0f / 256.0f); }
            if (lane < 8) { v4u o; o.x = pk2(s8[0], s8[1]); o.y = pk2(s8[2], s8[3]); o.z = pk2(s8[4], s8[5]); o.w = pk2(s8[6], s8[7]); *(LAS v4u*)(KMl + w * 64 + ch * 8) = o; } }
        else if (lane < 8) { const v4u z = {0u, 0u, 0u, 0u}; *(LAS v4u*)(KMl + w * 64 + (lane & 7) * 8) = z; }
        __syncthreads();
        f32x16 zero;
#pragma unroll
        for (int r = 0; r < 16; ++r) zero[r] = 0.f;
        Qf k;
#pragma unroll
        for (int sx = 0; sx < 4; ++sx) k.f[sx] = *(const LAS bf16x8*)(KMl + (r32 & 7) * 64 + hi * 8 + 16 * sx);
        f32x16 S = FA_MFMA(k.f[0], q.f[0], zero); S = FA_MFMA(k.f[1], q.f[1], S); S = FA_MFMA(k.f[2], q.f[2], S); S = FA_MFMA(k.f[3], q.f[3], S);
        float gsc[8];
#pragma unroll
        for (int i = 0; i < 4; ++i) { auto sw = __builtin_amdgcn_permlane32_swap(__float_as_uint(S[i]), __float_as_uint(S[i]), false, false); gsc[i] = __uint_as_float(sw[0]); gsc[4 + i] = __uint_as_float(sw[1]); }
#pragma unroll
        for (int j = 0; j < 8; ++j) { int rank = 0;
#pragma unroll
            for (int i = 0; i < 8; ++i) rank += (i < c8 && (gsc[i] > gsc[j] || (gsc[i] == gsc[j] && i < j))) ? 1 : 0;
            if (j < c8 && rank < 3) selm |= 1u << j; }
    }
    Acc a; acc_reset(a); LAS unsigned char* tb0 = lds + L_TILE;
    const int nt = 4 * c8 + 4, npast = 4 * c8;
    for (int i = 0; i < npast; ++i) {
        LAS unsigned char* buf = tb0 + (i & 1) * TILE_BYTES;
        tile_commit(buf, tr, tid);
        tile_issue(tr, K + (size_t)(64 * (i + 1)) * 64, V + 64 * (i + 1), tid);
        __syncthreads();
        const bool on = (selm >> (i >> 2)) & 1u; const unsigned long long bal = __ballot(on);
        if (bal != 0ull) step64l(a, q, buf, r32, hi, bal != ~0ull, on);
    }
    for (int i = npast; i < nt; ++i) {
        LAS unsigned char* buf = tb0 + (i & 1) * TILE_BYTES;
        tile_commit(buf, tr, tid);
        if (i + 1 < nt) tile_issue(tr, K + (size_t)(64 * (i + 1)) * 64, V + 64 * (i + 1), tid);
        __syncthreads();
        const int ka = 2 * (i & 3), kb = ka + 1;
        if (ka <= w) step64m(a, q, buf, r32, hi, kb >= w, 0, ka == w ? r32 : 31, kb > w ? 1 : 0, kb > w ? 0 : (kb == w ? r32 : 31));
    }
    f32x16 t0, t1;
#pragma unroll
    for (int r = 0; r < 16; ++r) { t0[r] = 0.f; t1[r] = 0.f; }
    acc_finish(a, t0, t1, 1.0f);
    store_out(attout + (size_t)b * OUT_BATCH_E + (size_t)t * 1024 + 512 + h * 64, t0, t1, hi);
    __builtin_amdgcn_s_setprio(0);
    __syncthreads();
}
}
__device__ __forceinline__ void cmp_unit(Frame& F, const Args& A, int l, int u) {
    unsigned char* ws = F.ws; asm volatile("" : "+s"(ws)); const int tid = fresh_tid(F.wave_s), lane = tid & 63, r32 = lane & 31, hi = lane >> 5, w = __builtin_amdgcn_readfirstlane(tid >> 6), nt = w & 3, kh = w >> 2;
    LAS float* part = (LAS float*)F.lds;
    LAS float* hid = (LAS float*)(F.lds + 16896);
    LAS float* o2 = (LAS float*)(F.lds + 16896 + 16384);
    {
        const int kv = u >> 6, bg = (u >> 2) & 15, ct = u & 3, c0 = 32 * ct;
        const bf16* src = (const bf16*)(ws + WS_ARENA + (size_t)(bg >> 1) * ARENA_B + (kv ? A_VC : A_KC)) + (size_t)(bg & 1) * SEQ * 64;
        const bf16* w1t = (const bf16*)(ws + (kv ? WS_W1TV : WS_W1TK));
        fa::f32x16 acc;
#pragma unroll
        for (int r = 0; r < 16; ++r) acc[r] = 0.f;
        const bf16* ap = src + (size_t)(16 * (c0 + r32)) * 64 + 8 * hi;
        const bf16* bp = w1t + (size_t)(32 * nt + r32) * 2048 + 8 * hi;
        for (int sb = kh * 64; sb < kh * 64 + 64; sb += 16) {
            fa::bf16x8 af[16], bfr[16];
#pragma unroll
            for (int i = 0; i < 16; ++i) { const int s = sb + i;
                af[i] = *(const GAS fa::bf16x8*)(ap + (s >> 2) * 64 + 16 * (s & 3)); bfr[i] = *(const GAS fa::bf16x8*)(bp + 16 * s); }
            __builtin_amdgcn_sched_barrier(0);
#pragma unroll
            for (int i = 0; i < 16; ++i) acc = FA_MFMA(af[i], bfr[i], acc);
            __builtin_amdgcn_sched_barrier(0);
        }

        if (kh == 1) {
#pragma unroll
            for (int r = 0; r < 16; ++r) part[(nt * 32 + fa::crow(r, hi)) * 33 + r32] = acc[r];
        }
        __syncthreads();
        LAS bf16* hidb = (LAS bf16*)hid;
        if (kh == 0) { const float bias = ((const float*)(ws + WS_CBIAS))[kv * 128 + 32 * nt + r32];
#pragma unroll
            for (int r = 0; r < 16; ++r) { const int c = fa::crow(r, hi); hidb[c * 136 + 32 * nt + r32] = (bf16)f2bf(gelu_tanh(acc[r] + part[(nt * 32 + c) * 33 + r32] + bias)); }
        }
        __syncthreads();
        if (w < 2) {
            const bf16* w2t = (const bf16*)(ws + (kv ? WS_W2TV : WS_W2TK)) + (size_t)(32 * w + r32) * 128 + 8 * hi;
            fa::bf16x8 bq[8];
#pragma unroll
            for (int sx = 0; sx < 8; ++sx) bq[sx] = *(const GAS fa::bf16x8*)(w2t + 16 * sx);
            fa::f32x16 oacc;
#pragma unroll
            for (int r = 0; r < 16; ++r) oacc[r] = 0.f;
#pragma unroll
            for (int sx = 0; sx < 8; ++sx) { const fa::bf16x8 aq = *(const LAS fa::bf16x8*)(hidb + r32 * 136 + 16 * sx + 8 * hi); oacc = FA_MFMA(aq, bq[sx], oacc); }
#pragma unroll
            for (int r = 0; r < 16; ++r) o2[fa::crow(r, hi) * 64 + 32 * w + r32] = oacc[r];
        }
        __syncthreads();
        const int d = tid & 63, cq = tid >> 6;
#pragma unroll
        for (int i = 0; i < 4; ++i) { const int cl = cq + 8 * i, c = c0 + cl;
            if (kv == 0) { float r = 0.f;
                if (c < 127) { const int t = 16 * c + 31, dd = d & 31; const float cs = ((const float*)(ws + WS_ROPEC))[t * 32 + dd], sn = ((const float*)(ws + WS_ROPES))[t * 32 + dd];
                    const float x1 = o2[cl * 64 + dd], x2 = o2[cl * 64 + dd + 32]; r = d < 32 ? x1 * cs - x2 * sn : x2 * cs + x1 * sn; }
                ((bf16*)(ws + WS_KCB))[((size_t)bg * 128 + c) * 64 + d] = (bf16)f2bf(r); }
            else { const float r = c < 127 ? o2[cl * 64 + d] : 0.f; ((bf16*)(ws + WS_VCBT))[((size_t)bg * 64 + d) * 128 + c] = (bf16)f2bf(r); } }
        __syncthreads();
    }
}
__device__ __forceinline__ void phase_x(Frame& F, const Args& A, int l, bf16* attout) {
    const int vcu = (F.G % 8 == 0) ? (F.bx % 8) * (F.G / 8) + F.bx / 8 : F.bx;
    for (int mp = vcu; mp < 256; mp += F.G) { const int bh = mp >> 2, i = mp & 3;
        if (i < 2) { const int g8 = mp >> 5, j5 = mp & 31, a4 = (j5 >> 2) * 2 + (j5 & 1);
            cmp_unit(F, A, l, (a4 >> 3) * 64 + (2 * g8 + ((a4 >> 2) & 1)) * 4 + (a4 & 3)); }
        const int code = i == 0 ? 0x7 : i == 1 ? 0x06 : i == 2 ? 0x35 : 0x124, cnt = i == 0 ? 1 : i == 3 ? 3 : 2;
        for (int k = 0; k < cnt; ++k) fa::moba_unit(F.ws, attout, F.lds, F.wave_s, bh, (code >> (4 * k)) & 15); }
}
__device__ __forceinline__ void phase_y(Frame& F, bf16* attout) {
    const int vcu = (F.G % 8 == 0) ? (F.bx % 8) * (F.G / 8) + F.bx / 8 : F.bx;
    for (int np = vcu; np < 256; np += F.G) { const int bg = np >> 4, p = np & 15;
        for (int k = 0; k < 2; ++k) fa::nsa_unit(F.ws, attout, F.lds, F.wave_s, bg, k == 0 ? 31 - p : p); }
}
__global__ void __launch_bounds__(NWAVES * 64, 2) fwd_kernel(Args args) {
    extern __shared__ __attribute__((aligned(16))) unsigned char lds[];
    LAS unsigned char* ldsb = (LAS unsigned char*)lds;
    volatile LAS unsigned* MISC = (volatile LAS unsigned*)(ldsb + MISC_OFF);
    for (int u = threadIdx.x; u < (LDS_BYTES - LDSCTL_OFF) / 4; u += NWAVES * 64) ((LAS unsigned*)(ldsb + LDSCTL_OFF))[u] = 0u;
    __syncthreads();
    const int wave_s = __builtin_amdgcn_readfirstlane((int)threadIdx.x >> 6);
    XcdBarrier bar; bar.bar = (unsigned*)(args.ws + WS_CTL) + 4096; bar.x = 0; bar.st = nullptr;
    const bool multi = (args.ph_hi - args.ph_lo) > 1;
    if (multi) bar = xcd_barrier_post((unsigned*)(args.ws + WS_CTL) + 4096, MISC + 8);
    bool colocal = false, checked = !multi;
    for (int ph = args.ph_lo; ph < args.ph_hi; ++ph) {
        unsigned char* ws = args.ws; asm volatile("" : "+s"(ws));
        unsigned zero_ = 0u; asm volatile("" : "+s"(zero_));
        int tid_ = wave_s * 64 + (int)__builtin_amdgcn_mbcnt_hi(~0u, __builtin_amdgcn_mbcnt_lo(~0u, zero_)); asm volatile("" : "+v"(tid_));
        Frame F;
        F.lds = ldsb; F.ws = ws; F.ctl = (gu32*)(ws + WS_CTL);
        F.tid = tid_; F.lane = 0; F.wave = 0; F.G = gridDim.x; F.bx = blockIdx.x; F.wave_s = wave_s;
        const int l = ph / PH_PER_LAYER, k = (ph == PH_NORM) ? -1 : ph % PH_PER_LAYER;
        bf16* XB = (bf16*)(ws + WS_XB); float* rowss = (float*)(ws + WS_ROWSS);
        if (ph == PH_NORM) {
#ifndef NO_NORM
 phase_norm(F, args);
#endif
 }
        else if (k == PH_CONV) {
#ifndef NO_CONV
 phase_conv(F, args, l);
#endif
 }
        else if (k == PH_UP1 || k == PH_UP2) {
            pg8::Gemm g{XB, (const bf16*)(ws + (k == PH_UP1 ? WS_WUP1 : WS_WUP2)), MT, NUP, DM, 0}; pg8::StaticOrder S; S.init(MT, NUP, F.G, F.bx);
            pg8::EpiSwiglu E{(bf16*)(ws + WS_ARENA + A_H), rowss};

#ifndef NO_UP
 pg8::gemm_phase<pg8::EpiSwiglu, pg8::StaticOrder, true, true>(F.lds, g, S, E, F.tid);
#endif

        }
        else if (k == PH_DN1 || k == PH_DN2 || k == PH_OUT) {
            const bool isout = (k == PH_OUT);
            pg8::Gemm g{(const bf16*)(ws + WS_ARENA + (isout ? A_MRG : A_H)), (const bf16*)(ws + (isout ? WS_WOUT : (k == PH_DN1 ? WS_WDN1 : WS_WDN2))), MT, DM, isout ? DM : DFF,
                        ARENA_B - (size_t)SEQ * (isout ? DM : DFF) * 2}; pg8::StaticOrder S; S.init(MT, DM, F.G, F.bx);
            pg8::EpiResid E{XB, rowss, isout ? 1.0f : 0.5f, (LAS float*)(F.lds + 132096)};

#ifndef NO_DN
 pg8::gemm_phase<pg8::EpiResid, pg8::StaticOrder, true, true>(F.lds, g, S, E, F.tid);
#endif

        }
        else if (k == PH_WIN) {
            pg8::Gemm g{XB, (const bf16*)(ws + WS_WIN), MT, NWIN, DM, 0}; pg8::StaticOrder S; S.init(MT, NWIN, F.G, F.bx);
            pg8::EpiWin E{rowss, (const float*)(ws + WS_ROPEC), (const float*)(ws + WS_ROPES),
                pg8::WinBufs{(bf16*)(ws + WS_ARENA + A_QA), (bf16*)(ws + WS_ARENA + A_QB), (bf16*)(ws + WS_ARENA + A_KB), (bf16*)(ws + WS_ARENA + A_VBT), (bf16*)(ws + WS_ARENA + A_KC), (bf16*)(ws + WS_ARENA + A_VC), (bf16*)(ws + WS_ARENA + A_KS), (bf16*)(ws + WS_ARENA + A_VST),
                             (bf16*)(ws + WS_ARENA + A_KW), (bf16*)(ws + WS_ARENA + A_VWT), (bf16*)(ws + WS_ARENA + A_GA), (bf16*)(ws + WS_ARENA + A_GB), (float*)(ws + WS_ARENA + A_GS)}};

#ifndef NO_WIN
 pg8::gemm_phase<pg8::EpiWin, pg8::StaticOrder, true, true>(F.lds, g, S, E, F.tid);
#endif

        }
        else if (k == PH_CMP) {
#ifndef NO_CMP
 { bf16* attout = (bf16*)args.out; asm volatile("" : "+s"(attout)); phase_x(F, args, l, attout); }
#endif
 }
        else if (k == PH_ATT) {
#ifndef NO_ATT
 { bf16* attout = (bf16*)args.out; asm volatile("" : "+s"(attout)); phase_y(F, attout); }
#endif
 }
        else if (k == PH_MRG) {
            { pg8::Gemm g{(const bf16*)args.out, (const bf16*)(ws + WS_WPA), MT, DM, DM, (size_t)OUT_BATCH_E * 2 - (size_t)SEQ * DM * 2}; pg8::StaticOrder S; S.init(MT, DM, F.G, F.bx);
              pg8::EpiMergeF E{(const bf16*)(ws + WS_ARENA + A_GA), (const bf16*)(ws + WS_ARENA + A_GB), (bf16*)(ws + WS_ARENA + A_MRG)};
#ifndef NO_MRG
              pg8::gemm_phase<pg8::EpiMergeF, pg8::StaticOrder, true, true>(F.lds, g, S, E, F.tid);
#endif
            }
        }
        if (ph + 1 < args.ph_hi) {
            const bool full_seam = (k == PH_CONV) || (k == PH_DN2 && l == 0);
            const int tq = fresh_tid(wave_s);
            if (full_seam || !colocal) { xcd_barrier(bar, tq == 0); if (!checked) { colocal = colocal_check(bar, MISC + 10, fresh_tid(wave_s)); checked = true; } }
            else if (k == PH_UP1 || k == PH_UP2 || k == PH_MRG) team_barrier(bar, tq == 0, (blockIdx.x & 7u) * 8u + ((blockIdx.x >> 3) & 7u));
            else group_barrier(bar, tq == 0, blockIdx.x & 7u, gridDim.x >> 3);
        }
    }
}

extern "C" void kernel_launch(void* const* d_in, const int* in_sizes, int n_in, void* d_out, int out_size, void* d_ws, size_t ws_size, hipStream_t stream) {
    static int grid = 0;
    if (grid == 0) {
        if (n_in != 21 || in_sizes[0] != MT * DM || out_size != MT * DM || ws_size < WS_END) { fprintf(stderr, "kernel_launch: unexpected shapes (n_in %d, in0 %d, out %d, ws %zu)\n", n_in, n_in > 0 ? in_sizes[0] : -1, out_size, ws_size); grid = -1; return; }
        int dev = 0, cus = 0;
        if (hipGetDevice(&dev) != hipSuccess || hipDeviceGetAttribute(&cus, hipDeviceAttributeMultiprocessorCount, dev) != hipSuccess) { grid = -1; return; }
        if (hipFuncSetAttribute((const void*)fwd_kernel, hipFuncAttributeMaxDynamicSharedMemorySize, LDS_BYTES) != hipSuccess) { fprintf(stderr, "kernel_launch: hipFuncSetAttribute failed\n"); grid = -1; return; }
        (void)hipGetLastError();
        grid = cus;
    }
    if (grid < 0) return;
    (void)hipMemsetAsync((char*)d_ws + WS_CTL, 0, CTL_ZERO_BYTES, stream);
    Args a{};
    for (int i = 0; i < 21; ++i) a.in[i] = (const float*)d_in[i];
    a.out = (float*)d_out; a.ws = (unsigned char*)d_ws;
#ifndef MULTI_LAUNCH
    a.ph_lo = 0; a.ph_hi = PH_TOTAL;
    hipLaunchKernelGGL(fwd_kernel, dim3(grid), dim3(NWAVES * 64), LDS_BYTES, stream, a);
    return;
#endif
    for (int ph = 0; ph < PH_TOTAL; ++ph) {
        a.ph_lo = ph; a.ph_hi = ph + 1;
        hipLaunchKernelGGL(fwd_kernel, dim3(grid), dim3(NWAVES * 64), LDS_BYTES, stream, a);
    }
}
```

```cpp
#include <hip/hip_runtime.h>
#include <cstdio>
#include <cstdint>
namespace pg8 {
#define PG8_LAS __attribute__((address_space(3)))
typedef unsigned short bf16_t;
typedef short bf16x8 __attribute__((ext_vector_type(8)));
typedef float f32x4 __attribute__((ext_vector_type(4)));
typedef unsigned u32x4 __attribute__((ext_vector_type(4)));
constexpr int BM = 256, BK = 64, HALF = 128, HTB = HALF * BK * 2  , STAGE_BYTES = 8 * HTB, NXCD = 8, WGM = 8;

__host__ __device__ __forceinline__ int lds_byte(int r, int c) { const int st = (r >> 4) * 2 + (c >> 5), rr = r & 15, cc = c & 31, ob = rr * 64 + cc * 2; return st * 1024 + (ob ^ (((ob >> 9) & 1) << 5)); }
__host__ __device__ __forceinline__ void stage_rc(int b, int& R, int& C) { const int st = b / 1024, sb = b % 1024, swz = sb ^ (((sb >> 9) & 1) << 5); R = (st >> 1) * 16 + swz / 64; C = (st & 1) * 32 + (swz % 64) / 2; }
__host__ __device__ __forceinline__ int perm32(int rho) { const int n = rho >> 4, i = rho & 15; return 8 * (i >> 2) + 4 * n + (i & 3); }

struct Unit { int pm, pn; };
struct Gemm { const bf16_t* A; const bf16_t* Bt; int M, N, K; size_t abgap; };

struct StaticOrder {
    int nM, nN, nwg, G, c;
    __host__ __device__ void init(int M, int N, int G_, int c_) { nM = M / BM; nN = N / BM; nwg = nM * nN; G = G_; c = c_; }
    __host__ __device__ bool next(int i, Unit& u) const {
        const long L = (long)i * G + c; if (L >= nwg) return false;
        int wgid = (int)L; { const int q = nwg / NXCD, r = nwg % NXCD, xcd = wgid % NXCD, off = wgid / NXCD; wgid = (xcd < r ? xcd * (q + 1) : r * (q + 1) + (xcd - r) * q) + off; }
        const int nig = WGM * nN, gid = wgid / nig, fm = gid * WGM, gsz = (nM - fm) < WGM ? (nM - fm) : WGM;
        u.pm = fm + ((wgid % nig) % gsz); u.pn = (wgid % nig) / gsz; return true;
    }
    __device__ __forceinline__ void a_ready(const Unit&) const {}
    __device__ __forceinline__ void done(const Unit&) const {}
};

typedef unsigned u32x2 __attribute__((ext_vector_type(2)));
typedef float pk_f32x2 __attribute__((ext_vector_type(2)));
typedef __bf16 pk_bf16x2 __attribute__((ext_vector_type(2)));
__device__ __forceinline__ unsigned cvt_pk_bf16(float lo, float hi) { const pk_f32x2 v = {lo, hi}; const pk_bf16x2 b = __builtin_convertvector(v, pk_bf16x2); return __builtin_bit_cast(unsigned, b); }
__device__ __forceinline__ float rstd_of(const float* rowss, int row) { const f32x4 a = *(const __attribute__((address_space(1))) f32x4*)(rowss + (size_t)row * 4); return __builtin_amdgcn_rsqf(((a[0] + a[1]) + (a[2] + a[3])) * (1.0f / 1024.0f) + 1e-6f); }
__device__ __forceinline__ void rstd8(const float* rowss, int row0, float (&rs)[2][4]) {
    f32x4 a[2][4];
#pragma unroll
    for (int ai = 0; ai < 2; ++ai)
#pragma unroll
        for (int m = 0; m < 4; ++m) a[ai][m] = *(const __attribute__((address_space(1))) f32x4*)(rowss + (size_t)(row0 + ai * HALF + m * 16) * 4);
    __builtin_amdgcn_sched_barrier(0);
#pragma unroll
    for (int ai = 0; ai < 2; ++ai)
#pragma unroll
        for (int m = 0; m < 4; ++m) rs[ai][m] = __builtin_amdgcn_rsqf(((a[ai][m][0] + a[ai][m][1]) + (a[ai][m][2] + a[ai][m][3])) * (1.0f / 1024.0f) + 1e-6f);
}
__device__ __forceinline__ float sigm(float v) { return __builtin_amdgcn_rcpf(1.0f + __builtin_amdgcn_exp2f(-1.4426950408889634f * v)); }
__device__ __forceinline__ float bfl(unsigned w) { return __uint_as_float(w << 16); }
__device__ __forceinline__ float bfh(unsigned w) { return __uint_as_float(w & 0xffff0000u); }

struct EpiSwiglu {
    static constexpr bool PERM = false, AFTER_DRAIN = false, HAS_MID = false;
    bf16_t* H; const float* rowss;
    __device__ __forceinline__ void operator()(const f32x4 (&acc)[2][2][4][2], const Unit& u, int wr, int wc, int fr, int fq) const {
        const int row0 = u.pm * BM + wr * 64 + fr, col0 = u.pn * 128 + wc * 32 + 8 * fq;
        float rsa[2][4]; rstd8(rowss, row0, rsa);
#pragma unroll
        for (int ai = 0; ai < 2; ++ai)
#pragma unroll
            for (int m = 0; m < 4; ++m) { const int row = row0 + ai * HALF + m * 16; const float rs = rsa[ai][m];
                float hv[8];
#pragma unroll
                for (int n = 0; n < 2; ++n)
#pragma unroll
                    for (int i = 0; i < 4; ++i) { const float g = acc[ai][0][m][n][i] * rs, uu = acc[ai][1][m][n][i] * rs; hv[4 * n + i] = g * uu * sigm(g); }
                u32x4 w; w.x = cvt_pk_bf16(hv[0], hv[1]); w.y = cvt_pk_bf16(hv[2], hv[3]); w.z = cvt_pk_bf16(hv[4], hv[5]); w.w = cvt_pk_bf16(hv[6], hv[7]);
                *(u32x4*)(H + (size_t)(row >> 11) * (size_t)10526720 + (size_t)(row & 2047) * 2816 + col0) = w; asm volatile("" ::: "memory"); }
    }
};
struct EpiResid {
    static constexpr bool PERM = false, AFTER_DRAIN = false, HAS_MID = false;
    bf16_t* XB; float* rowss; float alpha; PG8_LAS float* ssl;
    __device__ __forceinline__ void operator()(const f32x4 (&acc)[2][2][4][2], const Unit& u, int wr, int wc, int fr, int fq) const {
        const int row0 = u.pm * BM + wr * 64 + fr, col0 = u.pn * BM + wc * 32 + 4 * fq;
        u32x2 xo[2][4][2][2];
#pragma unroll
        for (int ai = 0; ai < 2; ++ai)
#pragma unroll
            for (int m = 0; m < 4; ++m)
#pragma unroll
                for (int bj = 0; bj < 2; ++bj)
#pragma unroll
                    for (int n = 0; n < 2; ++n) xo[ai][m][bj][n] = *(const __attribute__((address_space(1))) u32x2*)(XB + (size_t)(row0 + ai * HALF + m * 16) * 1024 + col0 + bj * HALF + n * 16);
        __builtin_amdgcn_sched_barrier(0);
#pragma unroll
        for (int ai = 0; ai < 2; ++ai)
#pragma unroll
            for (int m = 0; m < 4; ++m) { const int row = row0 + ai * HALF + m * 16; const size_t off = (size_t)row * 1024 + col0; float ss = 0.f;
#pragma unroll
                for (int bj = 0; bj < 2; ++bj)
#pragma unroll
                    for (int n = 0; n < 2; ++n) { const size_t o = off + bj * HALF + n * 16; const f32x4 a = acc[ai][bj][m][n]; const u32x2 xv = xo[ai][m][bj][n];
                        const float x0 = bfl(xv.x) + a[0] * alpha, x1 = bfh(xv.x) + a[1] * alpha, x2 = bfl(xv.y) + a[2] * alpha, x3 = bfh(xv.y) + a[3] * alpha;
                        u32x2 w; w.x = cvt_pk_bf16(x0, x1); w.y = cvt_pk_bf16(x2, x3); *(__attribute__((address_space(1))) u32x2*)(XB + o) = w;
                        ss += (x0 * x0 + x1 * x1) + (x2 * x2 + x3 * x3); }
                ss += __shfl_xor(ss, 16); ss += __shfl_xor(ss, 32);
                if (fq == 0) ssl[(ai * HALF + wr * 64 + m * 16 + fr) * 4 + wc] = ss; }
        asm volatile("s_waitcnt lgkmcnt(0)" ::: "memory"); __builtin_amdgcn_s_barrier(); asm volatile("" ::: "memory");
        { const int tid = (wr * 4 + wc) * 64 + fq * 16 + fr;
          if (tid < 256) { const f32x4 p = *(const PG8_LAS f32x4*)(ssl + tid * 4); rowss[(size_t)(u.pm * BM + tid) * 4 + u.pn] = (p[0] + p[1]) + (p[2] + p[3]); } }
        asm volatile("s_waitcnt lgkmcnt(0)" ::: "memory"); __builtin_amdgcn_s_barrier(); asm volatile("" ::: "memory");
    }
};
struct EpiMergeF {
    static constexpr bool PERM = false, AFTER_DRAIN = false, HAS_MID = true; static constexpr int MID_T = 8;
    const bf16_t* GA; const bf16_t* GB; bf16_t* Mg;
    __device__ __forceinline__ void mid(f32x4 (&acc)[2][2][4][2], const Unit& u, int wr, int wc, int fr, int fq) const {
        int row0 = u.pm * BM + wr * 64 + fr, col0 = u.pn * BM + wc * 32 + 8 * fq;
        asm volatile("" : "+v"(row0), "+v"(col0));
#pragma unroll
        for (int ai = 0; ai < 2; ++ai) {
            u32x4 ga[4][2], gb[4][2];
#pragma unroll
            for (int m = 0; m < 4; ++m)
#pragma unroll
                for (int bj = 0; bj < 2; ++bj) { const int rw = row0 + ai * HALF + m * 16; const size_t o = (size_t)(rw >> 11) * (size_t)10526720 + (size_t)(rw & 2047) * 1024 + col0 + bj * HALF;
                    ga[m][bj] = *(const __attribute__((address_space(1))) u32x4*)(GA + o); gb[m][bj] = *(const __attribute__((address_space(1))) u32x4*)(GB + o); }
            __builtin_amdgcn_sched_barrier(0);
#pragma unroll
            for (int m = 0; m < 4; ++m)
#pragma unroll
                for (int bj = 0; bj < 2; ++bj) { const u32x4 a = ga[m][bj], b = gb[m][bj]; float r[8];
                    r[0] = bfl(a.x) * __builtin_amdgcn_rcpf(fmaxf(bfl(b.x), 1e-30f)); r[1] = bfh(a.x) * __builtin_amdgcn_rcpf(fmaxf(bfh(b.x), 1e-30f));
                    r[2] = bfl(a.y) * __builtin_amdgcn_rcpf(fmaxf(bfl(b.y), 1e-30f)); r[3] = bfh(a.y) * __builtin_amdgcn_rcpf(fmaxf(bfh(b.y), 1e-30f));
                    r[4] = bfl(a.z) * __builtin_amdgcn_rcpf(fmaxf(bfl(b.z), 1e-30f)); r[5] = bfh(a.z) * __builtin_amdgcn_rcpf(fmaxf(bfh(b.z), 1e-30f));
                    r[6] = bfl(a.w) * __builtin_amdgcn_rcpf(fmaxf(bfl(b.w), 1e-30f)); r[7] = bfh(a.w) * __builtin_amdgcn_rcpf(fmaxf(bfh(b.w), 1e-30f));
                    acc[ai][bj][m][0][0] *= r[0]; acc[ai][bj][m][0][1] *= r[1]; acc[ai][bj][m][0][2] *= r[2]; acc[ai][bj][m][0][3] *= r[3];
                    acc[ai][bj][m][1][0] *= r[4]; acc[ai][bj][m][1][1] *= r[5]; acc[ai][bj][m][1][2] *= r[6]; acc[ai][bj][m][1][3] *= r[7]; }
            asm volatile("" ::: "memory"); }
    }
    __device__ __forceinline__ void operator()(const f32x4 (&acc)[2][2][4][2], const Unit& u, int wr, int wc, int fr, int fq) const {
        const int row0 = u.pm * BM + wr * 64 + fr, col0 = u.pn * BM + wc * 32 + 8 * fq;
        u32x4 gb[2][4][2];
#pragma unroll
        for (int ai = 0; ai < 2; ++ai)
#pragma unroll
            for (int m = 0; m < 4; ++m)
#pragma unroll
                for (int bj = 0; bj < 2; ++bj) { const int rw = row0 + ai * HALF + m * 16; gb[ai][m][bj] = *(const __attribute__((address_space(1))) u32x4*)(GB + (size_t)(rw >> 11) * (size_t)10526720 + (size_t)(rw & 2047) * 1024 + col0 + bj * HALF); }
        __builtin_amdgcn_sched_barrier(0);
#pragma unroll
        for (int ai = 0; ai < 2; ++ai)
#pragma unroll
            for (int m = 0; m < 4; ++m) { const int row = row0 + ai * HALF + m * 16;
#pragma unroll
                for (int bj = 0; bj < 2; ++bj) { const size_t o = (size_t)(row >> 11) * (size_t)10526720 + (size_t)(row & 2047) * 1024 + col0 + bj * HALF; const u32x4 gw = gb[ai][m][bj];
                    float r[8]; const f32x4 a0 = acc[ai][bj][m][0], a1 = acc[ai][bj][m][1];
                    r[0] = fmaxf(bfl(gw.x), 1e-30f) * a0[0]; r[1] = fmaxf(bfh(gw.x), 1e-30f) * a0[1]; r[2] = fmaxf(bfl(gw.y), 1e-30f) * a0[2]; r[3] = fmaxf(bfh(gw.y), 1e-30f) * a0[3];
                    r[4] = fmaxf(bfl(gw.z), 1e-30f) * a1[0]; r[5] = fmaxf(bfh(gw.z), 1e-30f) * a1[1]; r[6] = fmaxf(bfl(gw.w), 1e-30f) * a1[2]; r[7] = fmaxf(bfh(gw.w), 1e-30f) * a1[3];
                    u32x4 w; w.x = cvt_pk_bf16(r[0], r[1]); w.y = cvt_pk_bf16(r[2], r[3]); w.z = cvt_pk_bf16(r[4], r[5]); w.w = cvt_pk_bf16(r[6], r[7]);
                    *(__attribute__((address_space(1))) u32x4*)(Mg + o) = w; } }
    }
};
constexpr float C2Q = 0.125f * 1.4426950408889634f;
enum { WT_ROPE = 0, WT_PLAIN = 1, WT_VT = 2, WT_SIG = 3, WT_GS = 4, WT_NONE = 5 };
struct WinBufs { bf16_t *QA, *QB, *KBb, *VBt, *KC, *VC, *KS, *VSt, *KW, *VWt, *GA, *GB; float* GS; };
struct EpiWin {
    static constexpr bool PERM = false, AFTER_DRAIN = false, HAS_MID = false;
    const float* rowss; const float* ropec; const float* ropes; WinBufs B;
    __device__ __forceinline__ void operator()(const f32x4 (&acc)[2][2][4][2], const Unit& u, int wr, int wc, int fr, int fq) const {
        const int row0 = u.pm * BM + wr * 64 + fr;
        float rs[2][4]; rstd8(rowss, row0, rs);
        const int hh = wc >> 1, w = wc & 1;
#pragma unroll
        for (int bj = 0; bj < 2; ++bj) {
            const int half = 2 * u.pn + bj;
            int type, nh = 8, hb = 0, cb = 0; bf16_t* dst = nullptr; float sc = 1.f;
            if (half < 4) { type = WT_ROPE; dst = B.QA; hb = 2 * half; sc = C2Q; }
            else if (half == 4) { type = WT_PLAIN; dst = B.KC; nh = 2; }
            else if (half == 5) { type = WT_PLAIN; dst = B.VC; nh = 2; }
            else if (half == 6) { type = WT_ROPE; dst = B.KS; nh = 2; }
            else if (half == 7) { type = WT_VT; dst = B.VSt; nh = 2; }
            else if (half == 8) { type = WT_ROPE; dst = B.KW; nh = 2; }
            else if (half == 9) { type = WT_VT; dst = B.VWt; nh = 2; }
            else if (half < 14) { type = WT_ROPE; dst = B.QB; hb = 2 * (half - 10); sc = C2Q; }
            else if (half < 18) { type = WT_ROPE; dst = B.KBb; hb = 2 * (half - 14); }
            else if (half < 22) { type = WT_VT; dst = B.VBt; hb = 2 * (half - 18); }
            else if (half < 30) { type = WT_SIG; dst = B.GA; cb = 128 * (half - 22); }
            else if (half < 38) { type = WT_SIG; dst = B.GB; cb = 128 * (half - 30); }
            else if (half == 38) { type = WT_GS; }
            else { type = WT_NONE; }
            const int head = hb + hh;
            if (type == WT_ROPE) {
#pragma unroll
                for (int ai = 0; ai < 2; ++ai) {
                    f32x4 cs4[4], sn4[4];
#pragma unroll
                    for (int m = 0; m < 4; ++m) { const int sp = (row0 + ai * HALF + m * 16) & 2047;
                        cs4[m] = *(const __attribute__((address_space(1))) f32x4*)(ropec + sp * 32 + 16 * w + 4 * fq); sn4[m] = *(const __attribute__((address_space(1))) f32x4*)(ropes + sp * 32 + 16 * w + 4 * fq); }
                    __builtin_amdgcn_sched_barrier(0);
#pragma unroll
                    for (int m = 0; m < 4; ++m) { const int row = row0 + ai * HALF + m * 16, b = row >> 11, s = row & 2047; const float r = rs[ai][m] * sc;
                        const f32x4 c4 = cs4[m], s4 = sn4[m];
                        const f32x4 x1 = acc[ai][bj][m][0] * r, x2 = acc[ai][bj][m][1] * r;
                        const f32x4 o1 = x1 * c4 - x2 * s4, o2 = x2 * c4 + x1 * s4;
                        bf16_t* p = dst + (size_t)b * (size_t)10526720 + ((size_t)head * 2048 + s) * 64 + 16 * w + 4 * fq;
                        u32x2 w1, w2; w1.x = cvt_pk_bf16(o1[0], o1[1]); w1.y = cvt_pk_bf16(o1[2], o1[3]); w2.x = cvt_pk_bf16(o2[0], o2[1]); w2.y = cvt_pk_bf16(o2[2], o2[3]);
                        *(u32x2*)p = w1; *(u32x2*)(p + 32) = w2; }
                    asm volatile("" ::: "memory"); }
            } else if (type == WT_PLAIN) {
#pragma unroll
                for (int ai = 0; ai < 2; ++ai)
#pragma unroll
                    for (int m = 0; m < 4; ++m) { const int row = row0 + ai * HALF + m * 16, b = row >> 11, s = row & 2047; const float r = rs[ai][m];
                        const f32x4 v0 = acc[ai][bj][m][0] * r, v1 = acc[ai][bj][m][1] * r;
                        bf16_t* p = dst + (size_t)b * (size_t)10526720 + ((size_t)head * 2048 + s) * 64 + 32 * w + 4 * fq;
                        u32x2 w1, w2; w1.x = cvt_pk_bf16(v0[0], v0[1]); w1.y = cvt_pk_bf16(v0[2], v0[3]); w2.x = cvt_pk_bf16(v1[0], v1[1]); w2.y = cvt_pk_bf16(v1[2], v1[3]);
                        *(u32x2*)p = w1; *(u32x2*)(p + 16) = w2; asm volatile("" ::: "memory"); }
            } else if (type == WT_VT) {
#pragma unroll
                for (int ai = 0; ai < 2; ++ai)
#pragma unroll
                    for (int m = 0; m < 4; ++m) { const int row = row0 + ai * HALF + m * 16, b = row >> 11, s = row & 2047; const float r = rs[ai][m];
                        bf16_t* p = dst + (size_t)b * (size_t)10526720 + ((size_t)head * 64 + 32 * w + 4 * fq) * 2048 + s;
#pragma unroll
                        for (int n = 0; n < 2; ++n) { const f32x4 v = acc[ai][bj][m][n] * r; const unsigned a = cvt_pk_bf16(v[0], v[1]), c = cvt_pk_bf16(v[2], v[3]);
                            bf16_t* q = p + (size_t)(16 * n) * 2048;
                            q[0] = (bf16_t)(a & 0xffffu); q[2048] = (bf16_t)(a >> 16); q[4096] = (bf16_t)(c & 0xffffu); q[6144] = (bf16_t)(c >> 16); } asm volatile("" ::: "memory"); }
            } else if (type == WT_SIG) {
#pragma unroll
                for (int ai = 0; ai < 2; ++ai)
#pragma unroll
                    for (int m = 0; m < 4; ++m) { const int row = row0 + ai * HALF + m * 16, b = row >> 11, s = row & 2047; const float r = rs[ai][m];
                        const f32x4 v0 = acc[ai][bj][m][0] * r, v1 = acc[ai][bj][m][1] * r;
                        u32x4 o; o.x = cvt_pk_bf16(sigm(v0[0]), sigm(v0[1])); o.y = cvt_pk_bf16(sigm(v0[2]), sigm(v0[3])); o.z = cvt_pk_bf16(sigm(v1[0]), sigm(v1[1])); o.w = cvt_pk_bf16(sigm(v1[2]), sigm(v1[3]));
                        *(u32x4*)(dst + (size_t)b * (size_t)10526720 + (size_t)s * 1024 + cb + 32 * wc + 8 * fq) = o; asm volatile("" ::: "memory"); }
            } else if (type == WT_GS) {
                if (wc == 0) {
#pragma unroll
                    for (int ai = 0; ai < 2; ++ai)
#pragma unroll
                        for (int m = 0; m < 4; ++m) { const int row = row0 + ai * HALF + m * 16; const float r = rs[ai][m];
#pragma unroll
                            for (int n = 0; n < 2; ++n) { const f32x4 v = acc[ai][bj][m][n] * r; f32x4 o; o[0] = sigm(v[0]); o[1] = sigm(v[1]); o[2] = sigm(v[2]); o[3] = sigm(v[3]);
                                *(f32x4*)(B.GS + (size_t)(row >> 11) * (size_t)5263360 + (size_t)(row & 2047) * 32 + 16 * n + 4 * fq) = o; } }
                }
            }
        }
    }
};
template <class Epi, class Sched, bool ALIGN_EPI = false, bool SP2 = false>
__device__ __forceinline__ void gemm_phase(PG8_LAS unsigned char* lds, const Gemm g, const Sched& S, const Epi& E, const int tid) {
    const int wid = __builtin_amdgcn_readfirstlane(tid >> 6), lane = tid & 63, wr = wid >> 2, wc = wid & 3, fr = lane & 15, fq = lane >> 4;
    const int K = g.K, nt = K / BK;
    unsigned voffA[2], voffB[2];
#pragma unroll
    for (int i = 0; i < 2; ++i) { int R, C; stage_rc(tid * 16 + i * 8192, R, C); const int Rb = Epi::PERM ? ((R & ~31) + perm32(R & 31)) : R;
        voffA[i] = (unsigned)(R * K + C) * 2u; voffB[i] = (unsigned)(Rb * K + C) * 2u; }
    const size_t kstep = (size_t)(BK * 2);
    const size_t hstep = (size_t)HALF * K * 2;
    const size_t tstep = 2 * hstep;
    const unsigned ldsw = (unsigned)wid * 1024u;
    const int aoff = lds_byte(wr * 64 + fr, fq * 8), boff = lds_byte(wc * 32 + fr, fq * 8);
#define PG8_SA(b, h) (((b) * 2 + (h)) * HTB)
#define PG8_SB(b, h) ((4 + (b) * 2 + (h)) * HTB)
#define PG8_STAGE(bufoff, gbase, voff) do { _Pragma("unroll") for (int _i = 0; _i < 2; ++_i) \
        __builtin_amdgcn_global_load_lds((const unsigned*)((const char*)(gbase) + (voff)[_i]), (PG8_LAS unsigned*)(lds + (bufoff) + ldsw + _i * 8192), 16, 0, 0); } while (0)
#define PG8_LDA(dst, b, h) do { _Pragma("unroll") for (int m = 0; m < 4; ++m) _Pragma("unroll") for (int k = 0; k < 2; ++k) dst[m][k] = *(const PG8_LAS bf16x8*)(lds + PG8_SA(b, h) + aoff + m * 2048 + k * 1024); } while (0)
#define PG8_LDB(dst, b, h) do { _Pragma("unroll") for (int n = 0; n < 2; ++n) _Pragma("unroll") for (int k = 0; k < 2; ++k) dst[n][k] = *(const PG8_LAS bf16x8*)(lds + PG8_SB(b, h) + boff + n * 2048 + k * 1024); } while (0)
#define PG8_MMA(ai, bj, At, Bt) do { __builtin_amdgcn_s_setprio(1); _Pragma("unroll") for (int m = 0; m < 4; ++m) _Pragma("unroll") for (int n = 0; n < 2; ++n) _Pragma("unroll") for (int k = 0; k < 2; ++k) \
        acc[ai][bj][m][n] = __builtin_amdgcn_mfma_f32_16x16x32_bf16(Bt[n][k], At[m][k], acc[ai][bj][m][n], 0, 0, 0); __builtin_amdgcn_s_setprio(0); } while (0)
#define PG8_WAIT_V(n) asm volatile("s_waitcnt vmcnt(" #n ")" ::: "memory")
#define PG8_WAIT_L(n) asm volatile("s_waitcnt lgkmcnt(" #n ")" ::: "memory")
#define PG8_BAR __builtin_amdgcn_s_barrier()
#define PG8_SCHED __builtin_amdgcn_sched_barrier(0)
    Unit cur, nxt; int ui = 0;
    if (!S.next(0, cur)) return;
    f32x4 acc[2][2][4][2];
#pragma unroll
    for (int a = 0; a < 2; ++a)
#pragma unroll
        for (int b = 0; b < 2; ++b)
#pragma unroll
            for (int m = 0; m < 4; ++m)
#pragma unroll
                for (int n = 0; n < 2; ++n) acc[a][b][m][n] = (f32x4){0.f, 0.f, 0.f, 0.f};
    bf16x8 At[4][2], B0[2][2], B1[2][2];
    const char* cA = (const char*)g.A + (size_t)cur.pm * tstep + (size_t)(cur.pm >> 3) * g.abgap; const char* cB = (const char*)g.Bt + (size_t)cur.pn * tstep;
    S.a_ready(cur);
    if constexpr (SP2) {
        PG8_STAGE(PG8_SB(0, 0), cB, voffB); PG8_STAGE(PG8_SB(0, 1), cB + hstep, voffB); PG8_STAGE(PG8_SA(0, 0), cA, voffA); PG8_STAGE(PG8_SA(0, 1), cA + hstep, voffA);
        if (wr == 1) PG8_BAR;
        PG8_WAIT_V(2); PG8_BAR;
        PG8_STAGE(PG8_SB(1, 0), cB + kstep, voffB); PG8_STAGE(PG8_SA(1, 0), cA + kstep, voffA); PG8_STAGE(PG8_SB(1, 1), cB + hstep + kstep, voffB);
        PG8_WAIT_V(6); PG8_BAR;
    } else {
        PG8_STAGE(PG8_SB(0, 0), cB, voffB); PG8_STAGE(PG8_SA(0, 0), cA, voffA); PG8_STAGE(PG8_SB(0, 1), cB + hstep, voffB); PG8_STAGE(PG8_SA(0, 1), cA + hstep, voffA);
        if (wr == 1) PG8_BAR;
        PG8_WAIT_V(4); PG8_BAR;
        PG8_STAGE(PG8_SB(1, 0), cB + kstep, voffB); PG8_STAGE(PG8_SA(1, 0), cA + kstep, voffA); PG8_STAGE(PG8_SB(1, 1), cB + hstep + kstep, voffB);
        PG8_WAIT_V(6); PG8_BAR;
    }
    for (;;) {
        const bool has_next = S.next(ui + 1, nxt);
        const char* nA = has_next ? (const char*)g.A + (size_t)nxt.pm * tstep + (size_t)(nxt.pm >> 3) * g.abgap : cA; const char* nB = has_next ? (const char*)g.Bt + (size_t)nxt.pn * tstep : cB;
        for (int t = 0; t < nt; t += 2) {
            const bool last = (t == nt - 2);
            const char* a1 = cA + (size_t)(t + 1) * kstep;
            const char* a2 = last ? nA : cA + (size_t)(t + 2) * kstep; const char* b2 = last ? nB : cB + (size_t)(t + 2) * kstep;
            const char* a3 = a2 + kstep; const char* b3 = b2 + kstep;
            if (last && has_next) S.a_ready(nxt);
            if constexpr (Epi::HAS_MID) { if (t == Epi::MID_T) { __builtin_amdgcn_sched_barrier(0); E.mid(acc, cur, wr, wc, fr, fq); __builtin_amdgcn_sched_barrier(0); } }
            if constexpr (SP2) {
            PG8_LDB(B0, 0, 0); PG8_LDB(B1, 0, 1); PG8_SCHED; PG8_LDA(At, 0, 0); PG8_STAGE(PG8_SA(1, 1), a1 + hstep, voffA);
            PG8_WAIT_V(8); PG8_WAIT_L(0); PG8_BAR; PG8_MMA(0, 0, At, B0); PG8_MMA(0, 1, At, B1); PG8_BAR; PG8_SCHED;
            PG8_LDA(At, 0, 1); PG8_STAGE(PG8_SB(0, 0), b2, voffB); PG8_STAGE(PG8_SB(0, 1), b2 + hstep, voffB); PG8_STAGE(PG8_SA(0, 0), a2, voffA);
            PG8_WAIT_V(8); PG8_WAIT_L(0); PG8_BAR; PG8_MMA(1, 0, At, B0); PG8_MMA(1, 1, At, B1); PG8_BAR; PG8_SCHED;
            PG8_LDB(B0, 1, 0); PG8_LDB(B1, 1, 1); PG8_SCHED; PG8_LDA(At, 1, 0); PG8_STAGE(PG8_SA(0, 1), a2 + hstep, voffA);
            PG8_WAIT_V(8); PG8_WAIT_L(0); PG8_BAR; PG8_MMA(0, 0, At, B0); PG8_MMA(0, 1, At, B1); PG8_BAR; PG8_SCHED;
            PG8_LDA(At, 1, 1); PG8_STAGE(PG8_SB(1, 0), b3, voffB); PG8_STAGE(PG8_SB(1, 1), b3 + hstep, voffB); PG8_STAGE(PG8_SA(1, 0), a3, voffA);
            PG8_WAIT_V(8); PG8_WAIT_L(0); PG8_BAR; PG8_MMA(1, 0, At, B0); PG8_MMA(1, 1, At, B1); PG8_BAR; PG8_SCHED;
            } else {
            PG8_LDB(B0, 0, 0); PG8_SCHED; PG8_LDA(At, 0, 0); PG8_STAGE(PG8_SA(1, 1), a1 + hstep, voffA);
            PG8_WAIT_L(8); PG8_BAR; PG8_WAIT_L(0); PG8_MMA(0, 0, At, B0); PG8_BAR; PG8_SCHED;
            PG8_LDB(B1, 0, 1); PG8_STAGE(PG8_SB(0, 0), b2, voffB);
            PG8_BAR; PG8_WAIT_L(0); PG8_MMA(0, 1, At, B1); PG8_BAR;
            PG8_LDA(At, 0, 1); PG8_STAGE(PG8_SA(0, 0), a2, voffA);
            PG8_BAR; PG8_WAIT_L(0); PG8_MMA(1, 0, At, B0); PG8_BAR; PG8_SCHED;
            PG8_STAGE(PG8_SB(0, 1), b2 + hstep, voffB);
            PG8_WAIT_V(6); PG8_BAR; PG8_MMA(1, 1, At, B1); PG8_BAR;
            PG8_LDB(B0, 1, 0); PG8_SCHED; PG8_LDA(At, 1, 0); PG8_STAGE(PG8_SA(0, 1), a2 + hstep, voffA);
            PG8_WAIT_L(8); PG8_BAR; PG8_WAIT_L(0); PG8_MMA(0, 0, At, B0); PG8_BAR; PG8_SCHED;
            PG8_LDB(B1, 1, 1); PG8_STAGE(PG8_SB(1, 0), b3, voffB);
            PG8_BAR; PG8_WAIT_L(0); PG8_MMA(0, 1, At, B1); PG8_BAR;
            PG8_LDA(At, 1, 1); PG8_STAGE(PG8_SA(1, 0), a3, voffA);
            PG8_BAR; PG8_WAIT_L(0); PG8_MMA(1, 0, At, B0); PG8_BAR; PG8_SCHED;
            PG8_STAGE(PG8_SB(1, 1), b3 + hstep, voffB);
            PG8_WAIT_V(6); PG8_BAR; PG8_MMA(1, 1, At, B1); PG8_BAR;
            }
        }
        if constexpr (ALIGN_EPI) { if (wr == 0) PG8_BAR; }
        if constexpr (!Epi::AFTER_DRAIN) { E(acc, cur, wr, wc, fr, fq); S.done(cur); }
        if (!has_next) break;
#pragma unroll
        for (int a = 0; a < 2; ++a)
#pragma unroll
            for (int b = 0; b < 2; ++b)
#pragma unroll
                for (int m = 0; m < 4; ++m)
#pragma unroll
                    for (int n = 0; n < 2; ++n) acc[a][b][m][n] = (f32x4){0.f, 0.f, 0.f, 0.f};
        cur = nxt; cA = nA; cB = nB; ++ui;
        if constexpr (ALIGN_EPI) { if (wr == 1) PG8_BAR; }
    }
    PG8_WAIT_V(0);
    if constexpr (!ALIGN_EPI) { if (wr == 0) PG8_BAR; }
    PG8_BAR;
    if constexpr (Epi::AFTER_DRAIN) { E.fused(acc, cur, wr, wc, fr, fq, lds, wid, lane); S.done(cur); }
#undef PG8_SA
#undef PG8_SB
#undef PG8_STAGE
#undef PG8_LDA
#undef PG8_LDB
#undef PG8_MMA
#undef PG8_WAIT_V
#undef PG8_WAIT_L
#undef PG8_BAR
#undef PG8_SCHED
}
}
constexpr int NB = 8, SEQ = 2048, DM = 1024, MT = NB * SEQ, DFF = 2816, INC = 4888, NWIN = 5120, NUP = 2 * DFF;
constexpr int NWAVES = 8;
typedef unsigned short bf16;
typedef float f32x4 __attribute__((ext_vector_type(4)));
typedef unsigned v4u __attribute__((ext_vector_type(4)));
typedef unsigned v2u __attribute__((ext_vector_type(2)));
#define LAS __attribute__((address_space(3)))
#define GAS __attribute__((address_space(1)))
typedef GAS unsigned gu32;
#define RLX_AGENT __ATOMIC_RELAXED, __HIP_MEMORY_SCOPE_AGENT
#define LDS_WAIT() asm volatile("s_waitcnt lgkmcnt(0)" ::: "memory")
#define VM_WAIT() asm volatile("s_waitcnt vmcnt(0)" ::: "memory")
constexpr size_t MiB = 1u << 20;
constexpr size_t WS_CTL = 0, CTL_ZERO_BYTES = 64 * 1024;
constexpr size_t WS_ROPEC = 1 * MiB, WS_ROPES = 1 * MiB + 256 * 1024;
constexpr size_t WS_ROWSS = 1 * MiB + 512 * 1024;
constexpr size_t WS_KCB = 2 * MiB + 512 * 1024, WS_VCBT = WS_KCB + 256 * 1024;
constexpr size_t WS_CBIAS = 3 * MiB + 512 * 1024;
constexpr size_t WS_W2TK = 3 * MiB + 576 * 1024, WS_W2TV = 3 * MiB + 592 * 1024;
constexpr size_t WS_W1TK = 51 * MiB, WS_W1TV = 51 * MiB + 512 * 1024;
constexpr size_t WS_WUP1 = 4 * MiB, WS_WDN1 = 15 * MiB, WS_WIN = 20 * MiB + 512 * 1024, WS_WPA = 30 * MiB + 512 * 1024  ,
                 WS_WOUT = 32 * MiB + 512 * 1024, WS_WUP2 = 34 * MiB + 512 * 1024, WS_WDN2 = 45 * MiB + 512 * 1024;
constexpr size_t WS_XB = 52 * MiB;
constexpr size_t WS_ARENA = 84 * MiB, ARENA_B = 20 * MiB + 80 * 1024  , ARENA_E = ARENA_B / 2;
constexpr size_t A_QA = 0, A_QB = 2 * MiB, A_KB = 4 * MiB, A_VBT = 6 * MiB, A_KC = 8 * MiB, A_VC = 8 * MiB + 512 * 1024, A_KS = 9 * MiB, A_VST = 9 * MiB + 512 * 1024,
                 A_KW = 10 * MiB, A_VWT = 10 * MiB + 512 * 1024, A_GA = 11 * MiB, A_GB = 15 * MiB, A_GS = 19 * MiB;
constexpr size_t A_H = 0;
constexpr size_t A_MRG = 2 * MiB;
constexpr size_t OUT_BATCH_E = 4 * MiB;
constexpr size_t WS_END = WS_ARENA + 8 * ARENA_B;
constexpr int RING_BYTES = 131072, LDSCTL_OFF = RING_BYTES, MISC_OFF = LDSCTL_OFF + 320, LDS_BYTES = 147456;

enum { PH_CONV = 0, PH_UP1, PH_DN1, PH_WIN, PH_CMP, PH_ATT, PH_MRG, PH_OUT, PH_UP2, PH_DN2, PH_PER_LAYER };
constexpr int PH_NORM = 2 * PH_PER_LAYER, PH_TOTAL = PH_NORM + 1;

struct Args { const float* in[21]; float* out; unsigned char* ws; int ph_lo, ph_hi; };
static_assert(sizeof(Args) == 21 * 8 + 8 + 8 + 8, "no padding in Args");
enum { I_X = 0, I_F1N, I_F1G, I_F1U, I_F1D, I_MIXN, I_WIN, I_CKP, I_CKW1, I_CKW2, I_CVP, I_CVW1, I_CVW2, I_WBA, I_WBB, I_WOUT, I_F2N, I_F2G, I_F2U, I_F2D, I_FINN };

struct Frame {
    LAS unsigned char* lds; gu32* ctl; unsigned char* ws;
    int tid, lane, wave, G, bx, wave_s;
};
__device__ __forceinline__ int fresh_tid(int wave_s) { unsigned z = 0u; asm volatile("" : "+s"(z)); int t = wave_s * 64 + (int)__builtin_amdgcn_mbcnt_hi(~0u, __builtin_amdgcn_mbcnt_lo(~0u, z)); asm volatile("" : "+v"(t)); return t; }
__device__ __forceinline__ void frame_refresh(Frame& F) { asm volatile("" : "+v"(F.tid)); F.lane = F.tid & 63; F.wave = __builtin_amdgcn_readfirstlane(F.tid >> 6); }
__device__ __forceinline__ float wave_sum(float v) {
#pragma unroll
    for (int o = 1; o < 64; o <<= 1) v += __shfl_xor(v, o);
    return v;
}
__device__ __forceinline__ unsigned f2bf(float f) { unsigned u = __builtin_bit_cast(unsigned, f); return (u + 0x7fffu + ((u >> 16) & 1u)) >> 16; }
__device__ __forceinline__ unsigned pk2(float lo, float hi) { return f2bf(lo) | (f2bf(hi) << 16); }
__device__ __forceinline__ float bf2f(bf16 h) { return __uint_as_float((unsigned)h << 16); }
__host__ __device__ __forceinline__ int perm32i(int rho) { const int n = rho >> 4, i = rho & 15; return 8 * (i >> 2) + 4 * n + (i & 3); }

enum { CV_UP = 0, CV_NAT = 1, CV_WIN = 2, CV_P32 = 3 };
__device__ __forceinline__ int win_src_col(int rho) {
    const int half = rho >> 7, p = rho & 127;
    const int hh = p >> 6, q = p & 63, dim = 16 * (q >> 5) + (q & 15) + 32 * ((q >> 4) & 1);
    const int rp = 64 * hh + dim, pp = (p & ~31) + perm32i(p & 31);
    if (half < 4) return 128 * half + rp;
    if (half == 4) return 536 + p;
    if (half == 5) return 664 + p;
    if (half == 6) return 792 + rp;
    if (half == 7) return 920 + p;
    if (half == 8) return 1048 + rp;
    if (half == 9) return 1176 + p;
    if (half < 14) return 1304 + 128 * (half - 10) + rp;
    if (half < 18) return 1816 + 128 * (half - 14) + rp;
    if (half < 22) return 2328 + 128 * (half - 18) + p;
    if (half < 30) return 2840 + 128 * (half - 22) + pp;
    if (half < 38) return 3864 + 128 * (half - 30) + pp;
    if (half == 38) return p < 24 ? 512 + p : -1;
    return -1;
}
struct ConvJob { const float* W0; const float* W1; const float* gain; bf16* dst; int K, Nsrc, Ndst, kind, items, dpitch, koff; };
__device__ __forceinline__ int win_block_col(int r0, int& nvalid) {
    const int half = r0 >> 7, p0 = r0 & 127; nvalid = 64;
    if (half < 4) return 128 * half + p0;
    if (half == 4) return 536 + p0;
    if (half == 5) return 664 + p0;
    if (half == 6) return 792 + p0;
    if (half == 7) return 920 + p0;
    if (half == 8) return 1048 + p0;
    if (half == 9) return 1176 + p0;
    if (half < 14) return 1304 + 128 * (half - 10) + p0;
    if (half < 18) return 1816 + 128 * (half - 14) + p0;
    if (half < 22) return 2328 + 128 * (half - 18) + p0;
    if (half < 30) return 2840 + 128 * (half - 22) + p0;
    if (half < 38) return 3864 + 128 * (half - 30) + p0;
    if (half == 38 && p0 == 0) { nvalid = 24; return 512; }
    nvalid = 0; return 0;
}
struct ConvRegs { f32x4 v[16]; f32x4 g0, g1; };
__device__ __forceinline__ int conv_swz(int k) { return ((k & 7) ^ (k >> 3)) & 7; }
__device__ __forceinline__ void conv_item(const ConvJob& J, int item, int& kb, int& rb) {
    const int nrb = J.Ndst / 64;
    if ((nrb & 3) == 0 && ((J.K / 64) & 1) == 0) { const int blk = item >> 3, q = nrb >> 2; rb = 4 * (blk % q) + (item & 3); kb = 2 * (blk / q) + ((item >> 2) & 1); }
    else { kb = item / nrb; rb = item % nrb; }
}
__device__ __forceinline__ void conv_load(const ConvJob& J, int item, int lane, ConvRegs& R) {
    int kb, rb; conv_item(J, item, kb, rb); const int k0 = 64 * kb, r0 = 64 * rb;
    const float* W = J.W0; int c0, nvalid = 64;
    if (J.kind == CV_UP) { const int pn = r0 >> 8, bj = (r0 >> 7) & 1; c0 = 128 * pn + (r0 & 127); if (bj) W = J.W1; }
    else if (J.kind == CV_WIN) c0 = win_block_col(r0, nvalid);
    else c0 = r0;
    const int kr = lane >> 4, c4 = lane & 15;
#pragma unroll
    for (int i = 0; i < 16; ++i) R.v[i] = (f32x4){0.f, 0.f, 0.f, 0.f};
    R.g0 = (f32x4){1.f, 1.f, 1.f, 1.f}; R.g1 = R.g0;
    if (J.gain) { const GAS f32x4* gp = (const GAS f32x4*)(J.gain + k0 + 8 * (lane & 7)); R.g0 = gp[0]; R.g1 = gp[1]; }
    if (4 * c4 < nvalid) {
#pragma unroll
        for (int i = 0; i < 16; ++i) R.v[i] = __builtin_nontemporal_load((const GAS f32x4*)(W + (size_t)(k0 + 4 * i + kr) * J.Nsrc + c0 + 4 * c4));
    }
}
__device__ __forceinline__ void conv_emit(const ConvJob& J, int item, LAS float* scr, int lane, const ConvRegs& R) {
    int kb, rb; conv_item(J, item, kb, rb); const int k0 = 64 * kb, r0 = 64 * rb;
    int c0 = r0, nvalid = 64;
    if (J.kind == CV_UP) c0 = 128 * (r0 >> 8) + (r0 & 127);
    else if (J.kind == CV_WIN) c0 = win_block_col(r0, nvalid);
    const int kr = lane >> 4, c4 = lane & 15;
#pragma unroll
    for (int i = 0; i < 16; ++i) { const int k = 4 * i + kr;
        *(LAS f32x4*)(scr + k * 64 + 4 * (c4 ^ conv_swz(k))) = R.v[i]; }
    LDS_WAIT(); asm volatile("" ::: "memory");
}
__device__ __forceinline__ void conv_emit_b(const ConvJob& J, int item, LAS float* scr, int lane, const ConvRegs& R) {
    int kb, rb; conv_item(J, item, kb, rb); const int k0 = 64 * kb, r0 = 64 * rb;
    int c0 = r0, nvalid = 64;
    if (J.kind == CV_UP) c0 = 128 * (r0 >> 8) + (r0 & 127);
    else if (J.kind == CV_WIN) c0 = win_block_col(r0, nvalid);
#pragma unroll
    for (int e = 0; e < 8; ++e) { const int id = lane + 64 * e, n = id >> 3, c = id & 7, rho = r0 + n; int sc;
        if (J.kind == CV_UP) { const int p = rho & 127; sc = ((p & ~31) + perm32i(p & 31)) - (r0 & 127); }
        else if (J.kind == CV_NAT) sc = n;
        else if (J.kind == CV_P32) sc = ((rho & ~31) + perm32i(rho & 31)) - r0;
        else { const int col = win_src_col(rho); sc = col >= 0 ? col - c0 : -1; }
        v4u o = {0u, 0u, 0u, 0u};
        if (sc >= 0) { float f[8];
#pragma unroll
            for (int i = 0; i < 8; ++i) { const int k = 8 * c + i; f[i] = scr[k * 64 + 4 * ((sc >> 2) ^ conv_swz(k)) + (sc & 3)] * (i < 4 ? R.g0[i & 3] : R.g1[i & 3]); }
            o.x = pk2(f[0], f[1]); o.y = pk2(f[2], f[3]); o.z = pk2(f[4], f[5]); o.w = pk2(f[6], f[7]); }
        *(GAS v4u*)(J.dst + (size_t)rho * J.dpitch + J.koff + k0 + 8 * c) = o; }
    LDS_WAIT(); asm volatile("" ::: "memory");
}
__device__ __forceinline__ unsigned topk16_mask(const float (&v)[32]) { unsigned msk = 0;
#pragma unroll
    for (int j = 0; j < 32; ++j) { int rank = 0;
#pragma unroll
        for (int i = 0; i < 32; ++i) rank += (v[i] > v[j] || (v[i] == v[j] && i < j)) ? 1 : 0;
        if (rank < 16) msk |= (1u << j); }
    return msk; }
#define XB_TMO      128
#define XB_XCNT(j)  (256  + 64 * (j))
#define XB_XSUB(j)  (1280 + 64 * (j))
#define XB_XGEN(j)  (2304 + 64 * (j))
#define XB_TOP      3328
#define XB_TOPGEN   3392
#define XCD_BAR_WORDS 3456
#define XB_LSUB(j)  (3584 + 64 * (j))
#define XB_LGEN(j)  (4608 + 64 * (j))
#define XB_XTAB     5632
#define XB_TSUB(t)  (6400 + 32 * (t))
#define XB_TGEN(t)  (6416 + 32 * (t))
#define XB_SPIN_CAP (1u << 18)

__device__ __forceinline__ unsigned xb_ld(unsigned* p)              { return __hip_atomic_load(p, __ATOMIC_RELAXED, __HIP_MEMORY_SCOPE_AGENT); }
__device__ __forceinline__ unsigned xb_add(unsigned* p, unsigned v) { return __hip_atomic_fetch_add(p, v, __ATOMIC_RELAXED, __HIP_MEMORY_SCOPE_AGENT); }
__device__ __forceinline__ unsigned xb_xcc_id() { return (unsigned)__builtin_amdgcn_s_getreg((3 << 11) | 20) & 0xFu; }
#define XB_SPIN(cond, bar) do { unsigned _sp = 0; while (cond) { __builtin_amdgcn_s_sleep(1); \
    if ((++_sp & 255u) == 0u) { if (xb_ld(&(bar)[XB_TMO])) break; if (_sp > XB_SPIN_CAP) { atomicAdd(&(bar)[XB_TMO], 1u); break; } } } } while (0)

struct XcdBarrier {
    unsigned* bar; unsigned x;
    volatile LAS unsigned* st;
};

__device__ __forceinline__ XcdBarrier xcd_barrier_post(unsigned* bar, volatile LAS unsigned* st) {
    XcdBarrier b; b.bar = bar; b.x = xb_xcc_id(); b.st = st;
    if (threadIdx.x == 0) { (void)xb_add(&bar[XB_XCNT(b.x)], 1u); __hip_atomic_store(&bar[XB_XTAB + blockIdx.x], b.x + 1u, __ATOMIC_RELAXED, __HIP_MEMORY_SCOPE_AGENT); }
    return b;
}
__device__ __forceinline__ void xcd_barrier_complete(unsigned* bar, unsigned x, unsigned& nloc, unsigned& nx) {
    const unsigned G = gridDim.x * gridDim.y * gridDim.z;
    unsigned sum, cnt, mine, sp = 0u;
    for (;;) {
        sum = 0u; cnt = 0u; mine = 0u;
#pragma unroll
        for (unsigned j = 0; j < 16; ++j) { const unsigned c = xb_ld(&bar[XB_XCNT(j)]); sum += c; cnt += (c > 0u) ? 1u : 0u; mine = (j == x) ? c : mine; }
        if (sum == G) break;
        __builtin_amdgcn_s_sleep(1);
        if ((++sp & 255u) == 0u) { if (xb_ld(&bar[XB_TMO])) break; if (sp > XB_SPIN_CAP) { atomicAdd(&bar[XB_TMO], 1u); break; } }
    }
    nloc = mine > 0u ? mine : 1u; nx = cnt > 0u ? cnt : 1u;
}

__device__ __forceinline__ void xcd_barrier(const XcdBarrier& b, const bool leader, const bool release_l2 = true) {
    asm volatile("s_waitcnt vmcnt(0)" ::: "memory");
    __syncthreads();
    if (leader) {
        unsigned* bar = b.bar;
        __builtin_amdgcn_s_waitcnt(0);
        unsigned nloc = b.st[0], nx = b.st[1];
        if (nloc == 0u) { xcd_barrier_complete(bar, b.x, nloc, nx); b.st[0] = nloc; b.st[1] = nx; }
        const unsigned old = xb_add(&bar[XB_XSUB(b.x)], 1u);
        const unsigned gen = old / nloc;
        if (old + 1u == (gen + 1u) * nloc) {
            if (release_l2) __builtin_amdgcn_fence(__ATOMIC_RELEASE, "agent");
            asm volatile("s_waitcnt vmcnt(0)" ::: "memory");
            const unsigned og = xb_add(&bar[XB_TOP], 1u);
            const unsigned tg = og / nx;
            if (og + 1u == (tg + 1u) * nx) xb_add(&bar[XB_TOPGEN], 1u);
            else XB_SPIN(xb_ld(&bar[XB_TOPGEN]) == tg, bar);
            __builtin_amdgcn_fence(__ATOMIC_ACQUIRE, "agent");
            xb_add(&bar[XB_XGEN(b.x)], 1u);
            asm volatile("s_waitcnt vmcnt(0)" ::: "memory");
        } else {
            XB_SPIN(xb_ld(&bar[XB_XGEN(b.x)]) == gen, bar);
            __builtin_amdgcn_fence(__ATOMIC_ACQUIRE, "agent");
            asm volatile("s_waitcnt vmcnt(0)" ::: "memory");
        }
    }
    __syncthreads();
}

__device__ __forceinline__ void group_barrier(const XcdBarrier& b, const bool leader, const unsigned grp, const unsigned nloc) {
    asm volatile("s_waitcnt vmcnt(0)" ::: "memory");
    __syncthreads();
    if (leader) {
        unsigned* bar = b.bar;
        __builtin_amdgcn_s_waitcnt(0);
        asm volatile("buffer_inv sc1" ::: "memory");
        const unsigned old = xb_add(&bar[XB_LSUB(grp)], 1u);
        const unsigned gen = old / nloc;
        if (old + 1u == (gen + 1u) * nloc) xb_add(&bar[XB_LGEN(grp)], 1u);
        else XB_SPIN(xb_ld(&bar[XB_LGEN(grp)]) == gen, bar);
        asm volatile("s_waitcnt vmcnt(0)" ::: "memory");
    }
    __syncthreads();
}
__device__ __forceinline__ void team_barrier(const XcdBarrier& b, const bool leader, const unsigned team) {
    asm volatile("s_waitcnt vmcnt(0)" ::: "memory");
    __syncthreads();
    if (leader) {
        unsigned* bar = b.bar;
        __builtin_amdgcn_s_waitcnt(0);
        asm volatile("buffer_inv sc1" ::: "memory");
        const unsigned old = xb_add(&bar[XB_TSUB(team)], 1u);
        const unsigned gen = old >> 2;
        if ((old & 3u) == 3u) xb_add(&bar[XB_TGEN(team)], 1u);
        else XB_SPIN(xb_ld(&bar[XB_TGEN(team)]) == gen, bar);
        asm volatile("s_waitcnt vmcnt(0)" ::: "memory");
    }
    __syncthreads();
}
__device__ __forceinline__ bool colocal_check(const XcdBarrier& b, volatile LAS unsigned* flag, int tid) {
    if (tid < 64) {
        bool ok = (gridDim.x == 256u);
        if (ok) {
#pragma unroll
            for (int r = 0; r < 4; ++r) { const unsigned t = (unsigned)tid + 64u * r; const unsigned v = xb_ld(&b.bar[XB_XTAB + t]), rep = xb_ld(&b.bar[XB_XTAB + (t & 7u)]); ok = ok && (v != 0u) && (v == rep); }
            if (tid < 8) { const unsigned mine = xb_ld(&b.bar[XB_XTAB + tid]);
#pragma unroll
                for (int u = 0; u < 8; ++u) { const unsigned o = xb_ld(&b.bar[XB_XTAB + u]); if (u != tid && o == mine) ok = false; } }
        }
        const bool all = (__ballot(ok) == ~0ull);
        if (tid == 0) flag[0] = all ? 1u : 2u;
    }
    __syncthreads();
    return flag[0] == 1u;
}
__device__ __forceinline__ void phase_conv(Frame& F, const Args& A, int l) {
    frame_refresh(F);
    LAS float* scr = (LAS float*)(F.lds + F.wave * 16384);
    const int gw = F.bx * NWAVES + F.wave, NGW = F.G * NWAVES;
    unsigned char* ws = F.ws;
    const size_t LU = (size_t)DM * DFF, LW = (size_t)DM * INC, LB = (size_t)512 * DM, LO = (size_t)DM * DM;
    auto job = [&](int j) -> ConvJob {
        switch (j) {
        case 0: return ConvJob{A.in[I_F1G] + l * LU, A.in[I_F1U] + l * LU, A.in[I_F1N] + l * DM, (bf16*)(ws + WS_WUP1), DM, DFF, NUP, CV_UP, (DM / 64) * (NUP / 64), DM, 0};
        case 1: return ConvJob{A.in[I_F1D] + l * LU, nullptr, nullptr, (bf16*)(ws + WS_WDN1), DFF, DM, DM, CV_NAT, (DFF / 64) * (DM / 64), DFF, 0};
        case 2: return ConvJob{A.in[I_WIN] + l * LW, nullptr, A.in[I_MIXN] + l * DM, (bf16*)(ws + WS_WIN), DM, INC, NWIN, CV_WIN, (DM / 64) * (NWIN / 64), DM, 0};
        case 3: return ConvJob{A.in[I_WBA] + l * LB, nullptr, nullptr, (bf16*)(ws + WS_WPA), 512, DM, DM, CV_P32, (512 / 64) * (DM / 64), 1024, 0};
        case 4: return ConvJob{A.in[I_WBB] + l * LB, nullptr, nullptr, (bf16*)(ws + WS_WPA), 512, DM, DM, CV_P32, (512 / 64) * (DM / 64), 1024, 512};
        case 5: return ConvJob{A.in[I_WOUT] + l * LO, nullptr, nullptr, (bf16*)(ws + WS_WOUT), DM, DM, DM, CV_NAT, (DM / 64) * (DM / 64), DM, 0};
        case 6: return ConvJob{A.in[I_F2G] + l * LU, A.in[I_F2U] + l * LU, A.in[I_F2N] + l * DM, (bf16*)(ws + WS_WUP2), DM, DFF, NUP, CV_UP, (DM / 64) * (NUP / 64), DM, 0};
        case 7: return ConvJob{A.in[I_F2D] + l * LU, nullptr, nullptr, (bf16*)(ws + WS_WDN2), DFF, DM, DM, CV_NAT, (DFF / 64) * (DM / 64), DFF, 0};
        case 8: return ConvJob{A.in[I_CKW1] + (size_t)l * 2048 * 128, nullptr, nullptr, (bf16*)(ws + WS_W1TK), 2048, 128, 128, CV_NAT, (2048 / 64) * (128 / 64), 2048, 0};
        case 9: return ConvJob{A.in[I_CVW1] + (size_t)l * 2048 * 128, nullptr, nullptr, (bf16*)(ws + WS_W1TV), 2048, 128, 128, CV_NAT, (2048 / 64) * (128 / 64), 2048, 0};
        case 10: return ConvJob{A.in[I_CKW2] + (size_t)l * 128 * 64, nullptr, nullptr, (bf16*)(ws + WS_W2TK), 128, 64, 64, CV_NAT, 2, 128, 0};
        default: return ConvJob{A.in[I_CVW2] + (size_t)l * 128 * 64, nullptr, nullptr, (bf16*)(ws + WS_W2TV), 128, 64, 64, CV_NAT, 2, 128, 0};
        }
    };
    constexpr int NI[12] = {(DM / 64) * (NUP / 64), (DFF / 64) * (DM / 64), (DM / 64) * (NWIN / 64), (512 / 64) * (DM / 64), (512 / 64) * (DM / 64), (DM / 64) * (DM / 64), (DM / 64) * (NUP / 64), (DFF / 64) * (DM / 64), 64, 64, 2, 2};
    int total = 0;
#pragma unroll
    for (int j = 0; j < 12; ++j) total += NI[j];
    auto locate = [&](int it, int& jj, int& r) { r = it; jj = 11;
#pragma unroll
        for (int j = 0; j < 12; ++j) { if (jj == 11 && j < 11 && r < NI[j]) jj = j; else if (jj == 11 && j < 11) r -= NI[j]; } };
    int it = gw; bool have = it < total; ConvRegs cur; int jc = 0, rc = 0;
    if (have) { locate(it, jc, rc); const ConvJob Jc = job(jc); conv_load(Jc, rc, F.lane, cur); }
    while (have) {
        const int nit = it + NGW; const bool hn = nit < total; ConvRegs nxt; int jn = 0, rn = 0;
        { const ConvJob Jc = job(jc); conv_emit(Jc, rc, scr, F.lane, cur); }
        __builtin_amdgcn_sched_barrier(0);
        if (hn) { locate(nit, jn, rn); const ConvJob Jn = job(jn); conv_load(Jn, rn, F.lane, nxt); }
        __builtin_amdgcn_sched_barrier(0);
        { const ConvJob Jc = job(jc); conv_emit_b(Jc, rc, scr, F.lane, cur); }
        it = nit; have = hn; jc = jn; rc = rn;
        if (hn) cur = nxt;
    }
    if (F.wave == 0) for (int o = F.bx; o < 256; o += F.G) {
        const int kv = o >> 7, n = o & 127; const float* w1 = A.in[kv ? I_CVW1 : I_CKW1] + (size_t)l * 2048 * 128; const float* pos = A.in[kv ? I_CVP : I_CKP] + (size_t)l * 2048; float sacc = 0.f;
#pragma unroll 8
        for (int k = F.lane; k < 2048; k += 64) sacc += pos[k] * w1[(size_t)k * 128 + n];
        sacc = wave_sum(sacc); if (F.lane == 0) ((float*)(ws + WS_CBIAS))[o] = sacc;
    }
    if (l == 0) {
        const float* x = A.in[I_X]; bf16* XB = (bf16*)(ws + WS_XB); float* rowss = (float*)(ws + WS_ROWSS);
        for (int m0 = 4 * gw; m0 < MT; m0 += 8 * NGW) {
            f32x4 v[2][4][4];
#pragma unroll
            for (int h = 0; h < 2; ++h) { const int mh = m0 + h * 4 * NGW;
                if (mh < MT) {
#pragma unroll
                    for (int rr = 0; rr < 4; ++rr) { const GAS f32x4* xr = (const GAS f32x4*)(x + (size_t)(mh + rr) * DM) + F.lane;
#pragma unroll
                        for (int j = 0; j < 4; ++j) v[h][rr][j] = __builtin_nontemporal_load(xr + 64 * j); } } }
            __builtin_amdgcn_sched_barrier(0);
#pragma unroll
            for (int h = 0; h < 2; ++h) { const int mh = m0 + h * 4 * NGW;
                if (mh < MT) {
#pragma unroll
                    for (int rr = 0; rr < 4; ++rr) { const int m = mh + rr; float s = 0.f;
#pragma unroll
                        for (int j = 0; j < 4; ++j) s += (v[h][rr][j][0] * v[h][rr][j][0] + v[h][rr][j][1] * v[h][rr][j][1]) + (v[h][rr][j][2] * v[h][rr][j][2] + v[h][rr][j][3] * v[h][rr][j][3]);
                        s = wave_sum(s);
                        GAS v2u* o8 = (GAS v2u*)(XB + (size_t)m * DM) + F.lane;
#pragma unroll
                        for (int j = 0; j < 4; ++j) { v2u w; w.x = pk2(v[h][rr][j][0], v[h][rr][j][1]); w.y = pk2(v[h][rr][j][2], v[h][rr][j][3]); o8[64 * j] = w; }
                        if (F.lane < 4) rowss[(size_t)m * 4 + F.lane] = F.lane == 0 ? s : 0.f; } } }
        }
        float* rc = (float*)(ws + WS_ROPEC); float* rsn = (float*)(ws + WS_ROPES);
        for (int e = F.bx * 512 + F.tid; e < SEQ * 32; e += F.G * 512) { const int t = e >> 5, d = e & 31;
            const float inv = __builtin_amdgcn_exp2f(-(float)d * 0.41524101186092029f);
            const float ang = (float)t * inv;
            const float rev = ang * 0.15915494309189535f; const float fr = rev - __builtin_rintf(rev);
            rc[e] = __builtin_amdgcn_cosf(fr); rsn[e] = __builtin_amdgcn_sinf(fr); }
    }
}
__device__ __forceinline__ float gelu_tanh(float v) { const float u = 0.7978845608028654f * (v + 0.044715f * v * v * v); const float e = __builtin_amdgcn_exp2f(-2.8853900817779268f * u); return v * __builtin_amdgcn_rcpf(1.0f + e); }
__device__ __forceinline__ void phase_norm(Frame& F, const Args& A) {
    frame_refresh(F);
    const int vcu = (F.G % 8 == 0) ? (F.bx % 8) * (F.G / 8) + F.bx / 8 : F.bx; const float* g = A.in[I_FINN]; const bf16* XB = (const bf16*)(F.ws + WS_XB); const float* rowss = (const float*)(F.ws + WS_ROWSS);
    f32x4 gg[4];
#pragma unroll
    for (int j = 0; j < 4; ++j) gg[j] = *((const GAS f32x4*)g + F.lane + 64 * j);
    for (int v = vcu; v < 256; v += F.G) {
        v2u w[8][4]; f32x4 ss[8];
#pragma unroll
        for (int r = 0; r < 8; ++r) { const int m = 2048 * (v >> 5) + 8 * (v & 31) + F.wave + 256 * r; const GAS v2u* xb = (const GAS v2u*)(XB + (size_t)m * DM) + F.lane;
#pragma unroll
            for (int j = 0; j < 4; ++j) w[r][j] = xb[64 * j];
            ss[r] = *(const GAS f32x4*)(rowss + (size_t)m * 4); }
        __builtin_amdgcn_sched_barrier(0);
#pragma unroll
        for (int r = 0; r < 8; ++r) { const int m = 2048 * (v >> 5) + 8 * (v & 31) + F.wave + 256 * r; GAS f32x4* xr = (GAS f32x4*)(A.out + (size_t)m * DM) + F.lane;
            const float rs = __builtin_amdgcn_rsqf(((ss[r][0] + ss[r][1]) + (ss[r][2] + ss[r][3])) * (1.0f / 1024.0f) + 1e-6f);
#pragma unroll
            for (int j = 0; j < 4; ++j) { f32x4 x; x[0] = __uint_as_float(w[r][j].x << 16); x[1] = __uint_as_float(w[r][j].x & 0xffff0000u); x[2] = __uint_as_float(w[r][j].y << 16); x[3] = __uint_as_float(w[r][j].y & 0xffff0000u);
                xr[64 * j] = x * rs * gg[j]; } }
    }
}
namespace fa {
typedef short bf16x8 __attribute__((ext_vector_type(8)));
typedef short s16x4 __attribute__((ext_vector_type(4)));
typedef float f32x16 __attribute__((ext_vector_type(16)));
typedef float f32x2_t __attribute__((ext_vector_type(2))); typedef __bf16 bf16x2_t __attribute__((ext_vector_type(2)));
#define FA_MFMA(a, b, c) __builtin_amdgcn_mfma_f32_32x32x16_bf16((a), (b), (c), 0, 0, 0)
constexpr float FA_THR = 6.0f, FA_NINF = -INFINITY;
__device__ __forceinline__ int crow(int r, int h) { return (r & 3) + 8 * (r >> 2) + 4 * h; }
__device__ __forceinline__ float opaque_inf() { float v = __builtin_inff(); asm volatile("" : "+s"(v)); return v; }
#define mx2(a, b) __builtin_amdgcn_fmed3f((a), (b), pinf_)
__device__ __forceinline__ unsigned cvtpk(float lo, float hi) { f32x2_t v = {lo, hi}; bf16x2_t b = __builtin_convertvector(v, bf16x2_t); return __builtin_bit_cast(unsigned, b); }
__device__ __forceinline__ float swap_max(float x) { auto rr = __builtin_amdgcn_permlane32_swap(__float_as_uint(x), __float_as_uint(x), false, false); return fmaxf(__uint_as_float(rr[0]), __uint_as_float(rr[1])); }
__device__ __forceinline__ float swap_sum(float x) { auto rr = __builtin_amdgcn_permlane32_swap(__float_as_uint(x), __float_as_uint(x), false, false); return __uint_as_float(rr[0]) + __uint_as_float(rr[1]); }
__device__ __forceinline__ float swap_other(float x, int hi) { auto rr = __builtin_amdgcn_permlane32_swap(__float_as_uint(x), __float_as_uint(x), false, false); return hi ? __uint_as_float(rr[0]) : __uint_as_float(rr[1]); }
__device__ __forceinline__ bf16x8 pack8(const f32x16& p, int s) { v4u w; w.x = cvtpk(p[8 * s], p[8 * s + 1]); w.y = cvtpk(p[8 * s + 2], p[8 * s + 3]); w.z = cvtpk(p[8 * s + 4], p[8 * s + 5]); w.w = cvtpk(p[8 * s + 6], p[8 * s + 7]); return __builtin_bit_cast(bf16x8, w); }
__device__ __forceinline__ bf16x8 vfrag(const bf16* p) { const s16x4 a = *(const GAS s16x4*)p, b = *(const GAS s16x4*)(p + 8); return (bf16x8){a[0], a[1], a[2], a[3], b[0], b[1], b[2], b[3]}; }
struct Qf { bf16x8 f[4]; };
__device__ __forceinline__ void load_rows(Qf& q, const bf16* rowp  ) {
#pragma unroll
    for (int s = 0; s < 4; ++s) q.f[s] = *(const GAS bf16x8*)(rowp + 16 * s);
}
__device__ __forceinline__ f32x16 qk_tile(const bf16* kbase, const Qf& q, const f32x16& c0, int r32, int hi) {
    Qf k; load_rows(k, kbase + r32 * 64 + hi * 8);
    f32x16 S = FA_MFMA(k.f[0], q.f[0], c0); S = FA_MFMA(k.f[1], q.f[1], S); S = FA_MFMA(k.f[2], q.f[2], S); S = FA_MFMA(k.f[3], q.f[3], S); return S;
}
__device__ __forceinline__ void pv_tile(f32x16& o0, f32x16& o1, const bf16* vbase, int vs, const f32x16& P, int r32, int hi) {
    const bf16* v0 = vbase + (size_t)r32 * vs + 4 * hi; const bf16* v1 = v0 + (size_t)32 * vs;
    const bf16x8 a00 = vfrag(v0), a01 = vfrag(v0 + 16), a10 = vfrag(v1), a11 = vfrag(v1 + 16);
    const bf16x8 p0 = pack8(P, 0), p1 = pack8(P, 1);
    o0 = FA_MFMA(a00, p0, o0); o0 = FA_MFMA(a01, p1, o0); o1 = FA_MFMA(a10, p0, o1); o1 = FA_MFMA(a11, p1, o1);
}
struct Acc { f32x16 o0, o1, negm; float m, l; bool seen; };
__device__ __forceinline__ void acc_reset(Acc& a) {
#pragma unroll
    for (int r = 0; r < 16; ++r) { a.o0[r] = 0.f; a.o1[r] = 0.f; a.negm[r] = 0.f; }
    a.m = 0.f; a.l = 0.f; a.seen = false;
}
__device__ __forceinline__ void step32(Acc& a, const Qf& q, const bf16* kbase, const bf16* vbase, int vs, int r32, int hi, bool needmask, int lo, int up, bool rowon) {
    f32x16 S = qk_tile(kbase, q, a.negm, r32, hi);
    if (needmask) {
#pragma unroll
        for (int r = 0; r < 16; ++r) { const int c = crow(r, hi); S[r] = (rowon && c >= lo && c <= up) ? S[r] : FA_NINF; }
    }
    float rm = fmaxf(fmaxf(fmaxf(S[0], S[1]), fmaxf(S[2], S[3])), fmaxf(fmaxf(S[4], S[5]), fmaxf(S[6], S[7])));
    rm = fmaxf(rm, fmaxf(fmaxf(fmaxf(S[8], S[9]), fmaxf(S[10], S[11])), fmaxf(fmaxf(S[12], S[13]), fmaxf(S[14], S[15]))));
    rm = swap_max(rm);
    const bool big = rm > (a.seen ? FA_THR : -3.0e38f);
    if (__any(big)) { const float dl = big ? rm : 0.f; a.m += dl; const float f = __builtin_amdgcn_exp2f(-dl); a.l *= f;
#pragma unroll
        for (int r = 0; r < 16; ++r) { a.o0[r] *= f; a.o1[r] *= f; S[r] -= dl; a.negm[r] = -a.m; } }
    a.seen = a.seen || (rm > -3.0e38f);
    float ps = 0.f;
#pragma unroll
    for (int r = 0; r < 16; ++r) { S[r] = __builtin_amdgcn_exp2f(S[r]); ps += S[r]; }
    a.l += ps;
    pv_tile(a.o0, a.o1, vbase, vs, S, r32, hi);
}
__device__ __forceinline__ void acc_finish(const Acc& a, f32x16& t0, f32x16& t1, float gate) {
    const float l = swap_sum(a.l); const float sc = l > 0.f ? gate * __builtin_amdgcn_rcpf(l) : 0.f;
#pragma unroll
    for (int r = 0; r < 16; ++r) { t0[r] += a.o0[r] * sc; t1[r] += a.o1[r] * sc; }
}
constexpr int L_TILE = 49152, TILE_BYTES = 16384;
struct TileRegs { v4u k, v; };
__device__ __forceinline__ void tile_issue(TileRegs& t, const bf16* kp  , const bf16* vp  , int tid) {
    t.k = *(const GAS v4u*)(kp + tid * 8); t.v = *(const GAS v4u*)(vp + (size_t)(tid >> 3) * SEQ + (tid & 7) * 8);
}
__device__ __forceinline__ void tile_commit(LAS unsigned char* buf, const TileRegs& t, int tid) {
    const int row = tid >> 3, pc = tid & 7;
    *(LAS v4u*)(buf + row * 128 + ((pc ^ ((row >> 1) & 7)) << 4)) = t.k;
    const int x = (row >> 1) & 7, g = pc >> 1, od = pc & 1; v2u lo, hi2; lo.x = t.v.x; lo.y = t.v.y; hi2.x = t.v.z; hi2.y = t.v.w;
    LAS unsigned char* vr = buf + 8192 + row * 128;
    *(LAS v2u*)(vr + (((2 * g) ^ x) << 4) + 8 * od) = lo; *(LAS v2u*)(vr + (((2 * g + 1) ^ x) << 4) + 8 * od) = hi2;
}
__device__ __forceinline__ bf16x8 lds_vfrag(const LAS unsigned char* vrow  , int c16, int x) { return *(const LAS bf16x8*)(vrow + ((c16 ^ x) << 4)); }
__device__ __forceinline__ void step32l(Acc& a, const Qf& q, const LAS unsigned char* buf, int kt, int r32, int hi, bool needmask, int lo, int up, bool rowon) {
    const float pinf_ = opaque_inf();
    const int key = 32 * kt + r32; const LAS unsigned char* kr = buf + key * 128; const int kx = (key >> 1) & 7;
    const bf16x8 k0 = *(const LAS bf16x8*)(kr + (((0 + hi) ^ kx) << 4)), k1 = *(const LAS bf16x8*)(kr + (((2 + hi) ^ kx) << 4)), k2 = *(const LAS bf16x8*)(kr + (((4 + hi) ^ kx) << 4)), k3 = *(const LAS bf16x8*)(kr + (((6 + hi) ^ kx) << 4));
    f32x16 S = FA_MFMA(k0, q.f[0], a.negm); S = FA_MFMA(k1, q.f[1], S); S = FA_MFMA(k2, q.f[2], S); S = FA_MFMA(k3, q.f[3], S);
    const LAS unsigned char* v0 = buf + 8192 + r32 * 128; const LAS unsigned char* v1 = v0 + 32 * 128; const int x0 = (r32 >> 1) & 7;
    const bf16x8 a00 = lds_vfrag(v0, 4 * kt + hi, x0), a01 = lds_vfrag(v0, 4 * kt + 2 + hi, x0), a10 = lds_vfrag(v1, 4 * kt + hi, x0), a11 = lds_vfrag(v1, 4 * kt + 2 + hi, x0);
    if (needmask) {
#pragma unroll
        for (int r = 0; r < 16; ++r) { const int c = crow(r, hi); S[r] = (rowon && c >= lo && c <= up) ? S[r] : FA_NINF; }
    }
    float rm = mx2(mx2(mx2(S[0], S[1]), mx2(S[2], S[3])), mx2(mx2(S[4], S[5]), mx2(S[6], S[7])));
    rm = mx2(rm, mx2(mx2(mx2(S[8], S[9]), mx2(S[10], S[11])), mx2(mx2(S[12], S[13]), mx2(S[14], S[15]))));
    rm = swap_max(rm);
    const bool big = rm > (a.seen ? FA_THR : -3.0e38f);
    if (__any(big)) { const float dl = big ? rm : 0.f; a.m += dl; const float f = __builtin_amdgcn_exp2f(-dl); a.l *= f;
#pragma unroll
        for (int r = 0; r < 16; ++r) { a.o0[r] *= f; a.o1[r] *= f; S[r] -= dl; a.negm[r] = -a.m; } }
    a.seen = a.seen || (rm > -3.0e38f);
    float ps = 0.f;
#pragma unroll
    for (int r = 0; r < 16; ++r) { S[r] = __builtin_amdgcn_exp2f(S[r]); ps += S[r]; }
    a.l += ps;
    const bf16x8 p0 = pack8(S, 0), p1 = pack8(S, 1);
    a.o0 = FA_MFMA(a00, p0, a.o0); a.o0 = FA_MFMA(a01, p1, a.o0); a.o1 = FA_MFMA(a10, p0, a.o1); a.o1 = FA_MFMA(a11, p1, a.o1);
}
__device__ __forceinline__ void step64l(Acc& a, const Qf& q, const LAS unsigned char* buf, int r32, int hi, bool rowmask, bool rowon) {
    const float pinf_ = opaque_inf();
    const LAS unsigned char* kr0 = buf + r32 * 128; const LAS unsigned char* kr1 = kr0 + 32 * 128; const int kx = (r32 >> 1) & 7;
    f32x16 S0, S1;
    { const bf16x8 k0 = *(const LAS bf16x8*)(kr0 + (((0 + hi) ^ kx) << 4)), k1 = *(const LAS bf16x8*)(kr0 + (((2 + hi) ^ kx) << 4)), k2 = *(const LAS bf16x8*)(kr0 + (((4 + hi) ^ kx) << 4)), k3 = *(const LAS bf16x8*)(kr0 + (((6 + hi) ^ kx) << 4));
      const bf16x8 j0 = *(const LAS bf16x8*)(kr1 + (((0 + hi) ^ kx) << 4)), j1 = *(const LAS bf16x8*)(kr1 + (((2 + hi) ^ kx) << 4)), j2 = *(const LAS bf16x8*)(kr1 + (((4 + hi) ^ kx) << 4)), j3 = *(const LAS bf16x8*)(kr1 + (((6 + hi) ^ kx) << 4));
      S0 = FA_MFMA(k0, q.f[0], a.negm); S1 = FA_MFMA(j0, q.f[0], a.negm); S0 = FA_MFMA(k1, q.f[1], S0); S1 = FA_MFMA(j1, q.f[1], S1);
      S0 = FA_MFMA(k2, q.f[2], S0); S1 = FA_MFMA(j2, q.f[2], S1); S0 = FA_MFMA(k3, q.f[3], S0); S1 = FA_MFMA(j3, q.f[3], S1); }
    const LAS unsigned char* v0 = buf + 8192 + r32 * 128; const LAS unsigned char* v1 = v0 + 32 * 128; const int x0 = (r32 >> 1) & 7;
    const bf16x8 a00 = lds_vfrag(v0, hi, x0), a01 = lds_vfrag(v0, 2 + hi, x0), a02 = lds_vfrag(v0, 4 + hi, x0), a03 = lds_vfrag(v0, 6 + hi, x0);
    float ra = mx2(mx2(mx2(S0[0], S0[1]), mx2(S0[2], S0[3])), mx2(mx2(S0[4], S0[5]), mx2(S0[6], S0[7])));
    ra = mx2(ra, mx2(mx2(mx2(S0[8], S0[9]), mx2(S0[10], S0[11])), mx2(mx2(S0[12], S0[13]), mx2(S0[14], S0[15]))));
    float rb = mx2(mx2(mx2(S1[0], S1[1]), mx2(S1[2], S1[3])), mx2(mx2(S1[4], S1[5]), mx2(S1[6], S1[7])));
    rb = mx2(rb, mx2(mx2(mx2(S1[8], S1[9]), mx2(S1[10], S1[11])), mx2(mx2(S1[12], S1[13]), mx2(S1[14], S1[15]))));
    float rm = mx2(ra, rb);
    if (rowmask) rm = rowon ? rm : FA_NINF;
    rm = swap_max(rm);
    const bool big = rm > (a.seen ? FA_THR : -3.0e38f);
    if (__any(big)) { const float dl = big ? rm : 0.f; a.m += dl; const float f = __builtin_amdgcn_exp2f(-dl); a.l *= f;
#pragma unroll
        for (int r = 0; r < 16; ++r) { a.o0[r] *= f; a.o1[r] *= f; S0[r] -= dl; S1[r] -= dl; a.negm[r] = -a.m; } }
    a.seen = a.seen || (rm > -3.0e38f);
    float ps = 0.f, pt = 0.f;
#pragma unroll
    for (int r = 0; r < 16; ++r) { S0[r] = __builtin_amdgcn_exp2f(S0[r]); ps += S0[r]; S1[r] = __builtin_amdgcn_exp2f(S1[r]); pt += S1[r]; }
    ps += pt;
    v4u w0 = __builtin_bit_cast(v4u, pack8(S0, 0)), w1 = __builtin_bit_cast(v4u, pack8(S0, 1)), w2 = __builtin_bit_cast(v4u, pack8(S1, 0)), w3 = __builtin_bit_cast(v4u, pack8(S1, 1));
    if (rowmask) { const unsigned km = rowon ? 0xffffffffu : 0u; ps = rowon ? ps : 0.f;
        w0.x &= km; w0.y &= km; w0.z &= km; w0.w &= km; w1.x &= km; w1.y &= km; w1.z &= km; w1.w &= km; w2.x &= km; w2.y &= km; w2.z &= km; w2.w &= km; w3.x &= km; w3.y &= km; w3.z &= km; w3.w &= km; }
    a.l += ps;
    const bf16x8 p0 = __builtin_bit_cast(bf16x8, w0), p1 = __builtin_bit_cast(bf16x8, w1), p2 = __builtin_bit_cast(bf16x8, w2), p3 = __builtin_bit_cast(bf16x8, w3);
    const bf16x8 a10 = lds_vfrag(v1, hi, x0), a11 = lds_vfrag(v1, 2 + hi, x0), a12 = lds_vfrag(v1, 4 + hi, x0), a13 = lds_vfrag(v1, 6 + hi, x0);
    a.o0 = FA_MFMA(a00, p0, a.o0); a.o0 = FA_MFMA(a01, p1, a.o0); a.o0 = FA_MFMA(a02, p2, a.o0); a.o0 = FA_MFMA(a03, p3, a.o0);
    a.o1 = FA_MFMA(a10, p0, a.o1); a.o1 = FA_MFMA(a11, p1, a.o1); a.o1 = FA_MFMA(a12, p2, a.o1); a.o1 = FA_MFMA(a13, p3, a.o1);
}
__device__ __forceinline__ void step64m(Acc& a, const Qf& q, const LAS unsigned char* buf, int r32, int hi, bool needmask, int loA, int upA, int loB, int upB) {
    const float pinf_ = opaque_inf();
    const LAS unsigned char* kr0 = buf + r32 * 128; const LAS unsigned char* kr1 = kr0 + 32 * 128; const int kx = (r32 >> 1) & 7;
    f32x16 S0, S1;
    { const bf16x8 k0 = *(const LAS bf16x8*)(kr0 + (((0 + hi) ^ kx) << 4)), k1 = *(const LAS bf16x8*)(kr0 + (((2 + hi) ^ kx) << 4)), k2 = *(const LAS bf16x8*)(kr0 + (((4 + hi) ^ kx) << 4)), k3 = *(const LAS bf16x8*)(kr0 + (((6 + hi) ^ kx) << 4));
      const bf16x8 j0 = *(const LAS bf16x8*)(kr1 + (((0 + hi) ^ kx) << 4)), j1 = *(const LAS bf16x8*)(kr1 + (((2 + hi) ^ kx) << 4)), j2 = *(const LAS bf16x8*)(kr1 + (((4 + hi) ^ kx) << 4)), j3 = *(const LAS bf16x8*)(kr1 + (((6 + hi) ^ kx) << 4));
      S0 = FA_MFMA(k0, q.f[0], a.negm); S1 = FA_MFMA(j0, q.f[0], a.negm); S0 = FA_MFMA(k1, q.f[1], S0); S1 = FA_MFMA(j1, q.f[1], S1);
      S0 = FA_MFMA(k2, q.f[2], S0); S1 = FA_MFMA(j2, q.f[2], S1); S0 = FA_MFMA(k3, q.f[3], S0); S1 = FA_MFMA(j3, q.f[3], S1); }
    const LAS unsigned char* v0 = buf + 8192 + r32 * 128; const LAS unsigned char* v1 = v0 + 32 * 128; const int x0 = (r32 >> 1) & 7;
    const bf16x8 a00 = lds_vfrag(v0, hi, x0), a01 = lds_vfrag(v0, 2 + hi, x0), a02 = lds_vfrag(v0, 4 + hi, x0), a03 = lds_vfrag(v0, 6 + hi, x0);
    if (needmask) {
#pragma unroll
        for (int r = 0; r < 16; ++r) { const int c = crow(r, hi); S0[r] = (c >= loA && c <= upA) ? S0[r] : FA_NINF; S1[r] = (c >= loB && c <= upB) ? S1[r] : FA_NINF; }
    }
    float ra = mx2(mx2(mx2(S0[0], S0[1]), mx2(S0[2], S0[3])), mx2(mx2(S0[4], S0[5]), mx2(S0[6], S0[7])));
    ra = mx2(ra, mx2(mx2(mx2(S0[8], S0[9]), mx2(S0[10], S0[11])), mx2(mx2(S0[12], S0[13]), mx2(S0[14], S0[15]))));
    float rb = mx2(mx2(mx2(S1[0], S1[1]), mx2(S1[2], S1[3])), mx2(mx2(S1[4], S1[5]), mx2(S1[6], S1[7])));
    rb = mx2(rb, mx2(mx2(mx2(S1[8], S1[9]), mx2(S1[10], S1[11])), mx2(mx2(S1[12], S1[13]), mx2(S1[14], S1[15]))));
    float rm = mx2(ra, rb);
    rm = swap_max(rm);
    const bool big = rm > (a.seen ? FA_THR : -3.0e38f);
    if (__any(big)) { const float dl = big ? rm : 0.f; a.m += dl; const float f = __builtin_amdgcn_exp2f(-dl); a.l *= f;
#pragma unroll
        for (int r = 0; r < 16; ++r) { a.o0[r] *= f; a.o1[r] *= f; S0[r] -= dl; S1[r] -= dl; a.negm[r] = -a.m; } }
    a.seen = a.seen || (rm > -3.0e38f);
    float ps = 0.f, pt = 0.f;
#pragma unroll
    for (int r = 0; r < 16; ++r) { S0[r] = __builtin_amdgcn_exp2f(S0[r]); ps += S0[r]; S1[r] = __builtin_amdgcn_exp2f(S1[r]); pt += S1[r]; }
    ps += pt;
    v4u w0 = __builtin_bit_cast(v4u, pack8(S0, 0)), w1 = __builtin_bit_cast(v4u, pack8(S0, 1)), w2 = __builtin_bit_cast(v4u, pack8(S1, 0)), w3 = __builtin_bit_cast(v4u, pack8(S1, 1));
    a.l += ps;
    const bf16x8 p0 = __builtin_bit_cast(bf16x8, w0), p1 = __builtin_bit_cast(bf16x8, w1), p2 = __builtin_bit_cast(bf16x8, w2), p3 = __builtin_bit_cast(bf16x8, w3);
    const bf16x8 a10 = lds_vfrag(v1, hi, x0), a11 = lds_vfrag(v1, 2 + hi, x0), a12 = lds_vfrag(v1, 4 + hi, x0), a13 = lds_vfrag(v1, 6 + hi, x0);
    a.o0 = FA_MFMA(a00, p0, a.o0); a.o0 = FA_MFMA(a01, p1, a.o0); a.o0 = FA_MFMA(a02, p2, a.o0); a.o0 = FA_MFMA(a03, p3, a.o0);
    a.o1 = FA_MFMA(a10, p0, a.o1); a.o1 = FA_MFMA(a11, p1, a.o1); a.o1 = FA_MFMA(a12, p2, a.o1); a.o1 = FA_MFMA(a13, p3, a.o1);
}
__device__ __forceinline__ void park_store(LAS float* pp, const f32x16& t0, const f32x16& t1) {
#pragma unroll
    for (int r = 0; r < 16; ++r) { pp[r * 64] = t0[r]; pp[(16 + r) * 64] = t1[r]; }
}
__device__ __forceinline__ void park_add(LAS float* pp, const Acc& a, float gate) {
    const float l = swap_sum(a.l); const float sc = l > 0.f ? gate * __builtin_amdgcn_rcpf(l) : 0.f;
#pragma unroll
    for (int r = 0; r < 16; ++r) { pp[r * 64] += a.o0[r] * sc; pp[(16 + r) * 64] += a.o1[r] * sc; }
}
__device__ __forceinline__ void park_final(LAS float* pp, const Acc& a, float gate, f32x16& t0, f32x16& t1) {
    const float l = swap_sum(a.l); const float sc = l > 0.f ? gate * __builtin_amdgcn_rcpf(l) : 0.f;
#pragma unroll
    for (int r = 0; r < 16; ++r) { t0[r] = pp[r * 64] + a.o0[r] * sc; t1[r] = pp[(16 + r) * 64] + a.o1[r] * sc; }
}
__device__ __forceinline__ void store_out(bf16* dst  , const f32x16& t0, const f32x16& t1, int hi) {
#pragma unroll
    for (int rg = 0; rg < 4; ++rg) { v2u w; w.x = cvtpk(t0[4 * rg], t0[4 * rg + 1]); w.y = cvtpk(t0[4 * rg + 2], t0[4 * rg + 3]); *(GAS v2u*)(dst + 8 * rg + 4 * hi) = w;
        v2u x; x.x = cvtpk(t1[4 * rg], t1[4 * rg + 1]); x.y = cvtpk(t1[4 * rg + 2], t1[4 * rg + 3]); *(GAS v2u*)(dst + 32 + 8 * rg + 4 * hi) = x; }
}
constexpr int L_IMP = 0, L_VS = 8 * 32 * 33 * 4, L_SELM = L_VS + 64 * 33 * 4;

__device__ __forceinline__ void nsa_unit(unsigned char* ws, bf16* attout, LAS unsigned char* lds, int wave_s, int bg, int tb) {
    const int tid = fresh_tid(wave_s); asm volatile("" : "+s"(ws));
    const int lane = tid & 63, r32 = lane & 31, hi = lane >> 5, w = __builtin_amdgcn_readfirstlane(tid >> 6), rr = w & 3, th = w >> 2;
    if (w >= 4) __builtin_amdgcn_s_setprio(1);
    const int b = bg >> 1, g = bg & 1, head = 4 * g + rr, t = 64 * tb + 32 * th + r32;
    unsigned char* ar = ws + WS_ARENA + (size_t)b * ARENA_B;
    Qf q; load_rows(q, (const bf16*)(ar + A_QA) + ((size_t)head * SEQ + t) * 64 + hi * 8);
    const GAS float* gs = (const GAS float*)(ar + A_GS) + (size_t)t * 32 + head * 3;
    const float g0 = gs[0];
    f32x16 t0, t1;
    const bf16* Ks = (const bf16*)(ar + A_KS) + (size_t)g * SEQ * 64; const bf16* Vs = (const bf16*)(ar + A_VST) + (size_t)g * 64 * SEQ;
    TileRegs tr; tile_issue(tr, Ks, Vs, tid);
    LAS float* IMP = (LAS float*)(lds + L_IMP); LAS float* VS = (LAS float*)(lds + L_VS); LAS unsigned* SELM = (LAS unsigned*)(lds + L_SELM);
    {
        const int ntile = (tb >> 3) + 1;
        const int clim = t >= 31 ? (t - 31) >> 4 : -1;
        const bf16* K = (const bf16*)(ws + WS_KCB) + (size_t)bg * 128 * 64; const bf16* V = (const bf16*)(ws + WS_VCBT) + (size_t)bg * 64 * 128;
        f32x16 zero;
#pragma unroll
        for (int r = 0; r < 16; ++r) zero[r] = 0.f;
        f32x16 S[4]; float rm = FA_NINF;
        Qf kf[4]; bf16x8 vf[4][4];
#pragma unroll
        for (int ti = 0; ti < 4; ++ti) if (ti < ntile) load_rows(kf[ti], K + (size_t)(ti * 32 + r32) * 64 + hi * 8);
#pragma unroll
        for (int ti = 0; ti < 4; ++ti) if (ti < ntile) { const bf16* v0 = V + (size_t)r32 * 128 + ti * 32 + 4 * hi; const bf16* v1 = v0 + (size_t)32 * 128;
            vf[ti][0] = vfrag(v0); vf[ti][1] = vfrag(v0 + 16); vf[ti][2] = vfrag(v1); vf[ti][3] = vfrag(v1 + 16); }
        __builtin_amdgcn_sched_barrier(0);
#pragma unroll
        for (int ti = 0; ti < 4; ++ti) if (ti < ntile) { S[ti] = FA_MFMA(kf[ti].f[0], q.f[0], zero); S[ti] = FA_MFMA(kf[ti].f[1], q.f[1], S[ti]); S[ti] = FA_MFMA(kf[ti].f[2], q.f[2], S[ti]); S[ti] = FA_MFMA(kf[ti].f[3], q.f[3], S[ti]); }
#pragma unroll
        for (int ti = 0; ti < 4; ++ti) if (ti < ntile) {
#pragma unroll
            for (int r = 0; r < 16; ++r) { S[ti][r] = (32 * ti + crow(r, hi) <= clim) ? S[ti][r] : FA_NINF; rm = fmaxf(rm, S[ti][r]); } }
        rm = swap_max(rm); const float mref = rm > -3.0e38f ? rm : 0.f; float l = 0.f;
#pragma unroll
        for (int ti = 0; ti < 4; ++ti) if (ti < ntile) {
#pragma unroll
            for (int r = 0; r < 16; ++r) { S[ti][r] = __builtin_amdgcn_exp2f(S[ti][r] - mref); l += S[ti][r]; } }
        l = swap_sum(l); const float il = l > 0.f ? __builtin_amdgcn_rcpf(l) : 0.f;
#pragma unroll
        for (int r = 0; r < 16; ++r) { t0[r] = 0.f; t1[r] = 0.f; }
        LAS float* myimp = IMP + (w * 32 + r32) * 33; float carry = 0.f;
#pragma unroll
        for (int ti = 0; ti < 4; ++ti) if (ti < ntile) {
#pragma unroll
            for (int r = 0; r < 16; ++r) S[ti][r] *= il;
            float lo4[4];
#pragma unroll
            for (int rg = 0; rg < 4; ++rg) lo4[rg] = swap_other(S[ti][4 * rg + 3], hi);
#pragma unroll
            for (int rg = 0; rg < 4; ++rg) { const float gsum = (S[ti][4 * rg] + S[ti][4 * rg + 1]) + (S[ti][4 * rg + 2] + S[ti][4 * rg + 3]);
                const float prev = hi ? lo4[rg] : (rg > 0 ? lo4[rg > 0 ? rg - 1 : 0] : carry);
                myimp[2 * (4 * ti + rg) + hi] = gsum + prev; }
            carry = lo4[3];
            { const bf16x8 p0 = pack8(S[ti], 0), p1 = pack8(S[ti], 1);
              t0 = FA_MFMA(vf[ti][0], p0, t0); t0 = FA_MFMA(vf[ti][1], p1, t0); t1 = FA_MFMA(vf[ti][2], p0, t1); t1 = FA_MFMA(vf[ti][3], p1, t1); }
        }
#pragma unroll
        for (int r = 0; r < 16; ++r) { t0[r] *= g0; t1[r] *= g0; }
    }
    __syncthreads();
    {
        const int tk = tid >> 3, jg = tid & 7, tht = tk >> 5, qt = tk & 31;
#pragma unroll
        for (int i = 0; i < 4; ++i) { const int j = 4 * jg + i; float x = 0.f;
#pragma unroll
            for (int r = 0; r < 4; ++r) x += IMP[((tht * 4 + r) * 32 + qt) * 33 + j];
            VS[tk * 33 + j] = (j <= tb) ? x + ((j == 0 || j == tb || j == tb - 1) ? 1e4f : 0.f) : -1e30f; }
        if (tid < 64) SELM[tid] = 0u;
    }
    __syncthreads();
    {
        const int tk = tid >> 3, part = tid & 7; float v[32];
#pragma unroll
        for (int j = 0; j < 32; ++j) v[j] = VS[tk * 33 + j];
        unsigned bits = 0;
#pragma unroll
        for (int i = 0; i < 4; ++i) { const int j = 4 * part + i; const float vj = VS[tk * 33 + j]; int rank = 0;
#pragma unroll
            for (int k = 0; k < 32; ++k) rank += (v[k] > vj || (v[k] == vj && k < j)) ? 1 : 0;
            if (rank < 16 && j <= tb) bits |= 1u << j; }
        __hip_atomic_fetch_or((LAS unsigned*)&SELM[tk], bits, __ATOMIC_RELAXED, __HIP_MEMORY_SCOPE_WORKGROUP);
    }
    __syncthreads();
    const unsigned selm = SELM[32 * th + r32];

    LAS float* pp = (LAS float*)(lds + (w < 6 ? 81920 + w * 8192 : (w - 6) * 8192)) + lane;
    park_store(pp, t0, t1);
    Acc a; LAS unsigned char* tb0 = lds + L_TILE;
    const bf16* Kw = (const bf16*)(ar + A_KW) + (size_t)g * SEQ * 64; const bf16* Vw = (const bf16*)(ar + A_VWT) + (size_t)g * 64 * SEQ;
    const int jw0 = tb >= 8 ? tb - 8 : 0;
    {
        acc_reset(a);
        for (int j = 0; j < tb; ++j) {
            LAS unsigned char* buf = tb0 + (j & 1) * TILE_BYTES;
            tile_commit(buf, tr, tid);
            tile_issue(tr, Ks + (size_t)(64 * (j + 1)) * 64, Vs + 64 * (j + 1), tid);
            __syncthreads();
            const bool on = (selm >> j) & 1u; const unsigned long long bal = __ballot(on);
            if (bal != 0ull) step64l(a, q, buf, r32, hi, bal != ~0ull, on);
        }
        {
            LAS unsigned char* buf = tb0 + (tb & 1) * TILE_BYTES;
            tile_commit(buf, tr, tid);
            tile_issue(tr, Kw + (size_t)(64 * jw0) * 64, Vw + 64 * jw0, tid);
            __syncthreads();
            step64m(a, q, buf, r32, hi, true, 0, th ? 31 : r32, th ? 0 : 1, th ? r32 : 0);
        }
        park_add(pp, a, gs[1]);
    }

    __syncthreads();
    {
        acc_reset(a);
        const int as = 2 * tb + th, ks0 = as >= 16 ? as - 16 : 0;
        auto edge_tile = [&](int j) {
            LAS unsigned char* buf = tb0 + (j & 1) * TILE_BYTES;
            tile_commit(buf, tr, tid);
            if (j < tb) tile_issue(tr, Kw + (size_t)(64 * (j + 1)) * 64, Vw + 64 * (j + 1), tid);
            __syncthreads();
            const int ka = 2 * j, kb = 2 * j + 1;
            const bool fa_ = (as >= 16 && ka == as - 16), la_ = (ka == as), fb_ = (as >= 16 && kb == as - 16), lb_ = (kb == as);
            const bool acta = (ka >= ks0 && ka <= as), actb = (kb >= ks0 && kb <= as);
            if (acta || actb) step64m(a, q, buf, r32, hi, !(acta && actb && !fa_ && !la_ && !fb_ && !lb_),
                                      !acta ? 1 : (fa_ ? r32 + 1 : 0), !acta ? 0 : (la_ ? r32 : 31), !actb ? 1 : (fb_ ? r32 + 1 : 0), !actb ? 0 : (lb_ ? r32 : 31));
        };
        edge_tile(jw0);
        for (int j = jw0 + 1; j < tb; ++j) {
            LAS unsigned char* buf = tb0 + (j & 1) * TILE_BYTES;
            tile_commit(buf, tr, tid);
            tile_issue(tr, Kw + (size_t)(64 * (j + 1)) * 64, Vw + 64 * (j + 1), tid);
            __syncthreads();
            step64l(a, q, buf, r32, hi, false, true);
        }
        if (tb > jw0) edge_tile(tb);
        park_final(pp, a, gs[2], t0, t1);
    }
    store_out(attout + (size_t)b * OUT_BATCH_E + (size_t)t * 1024 + head * 64, t0, t1, hi);
    __builtin_amdgcn_s_setprio(0);

    __syncthreads();
}
__device__ __forceinline__ void moba_unit(unsigned char* ws, bf16* attout, LAS unsigned char* lds, int wave_s, int bh, int c8) {
    const int tid = fresh_tid(wave_s); asm volatile("" : "+s"(ws));
    const int lane = tid & 63, r32 = lane & 31, hi = lane >> 5, w = __builtin_amdgcn_readfirstlane(tid >> 6);
    if (w >= 4) __builtin_amdgcn_s_setprio(1);
    const int b = bh >> 3, h = bh & 7, t = 256 * c8 + 32 * w + r32;
    unsigned char* ar = ws + WS_ARENA + (size_t)b * ARENA_B;
    Qf q; load_rows(q, (const bf16*)(ar + A_QB) + ((size_t)h * SEQ + t) * 64 + hi * 8);
    const bf16* K = (const bf16*)(ar + A_KB) + (size_t)h * SEQ * 64; const bf16* V = (const bf16*)(ar + A_VBT) + (size_t)h * 64 * SEQ;
    TileRegs tr; tile_issue(tr, K, V, tid);
    unsigned selm = 0;
    if (c8 > 0) {
        LAS bf16* KMl = (LAS bf16*)(lds + L_TILE + 2 * TILE_BYTES);
        if (w < c8) { const int ko = lane >> 3, ch = lane & 7; const bf16* base = K + (size_t)(256 * w) * 64; float s8[8];
#pragma unroll
            for (int i = 0; i < 8; ++i) s8[i] = 0.f;
            for (int ib = 0; ib < 32; ib += 16) { v4u wv[16];
#pragma unroll
                for (int i = 0; i < 16; ++i) wv[i] = *(const GAS v4u*)(base + (size_t)(8 * (ib + i) + ko) * 64 + ch * 8);
                __builtin_amdgcn_sched_barrier(0);
#pragma unroll
                for (int i = 0; i < 16; ++i) {
                    s8[0] += __uint_as_float(wv[i].x << 16); s8[1] += __uint_as_float(wv[i].x & 0xffff0000u); s8[2] += __uint_as_float(wv[i].y << 16); s8[3] += __uint_as_float(wv[i].y & 0xffff0000u);
                    s8[4] += __uint_as_float(wv[i].z << 16); s8[5] += __uint_as_float(wv[i].z & 0xffff0000u); s8[6] += __uint_as_float(wv[i].w << 16); s8[7] += __uint_as_float(wv[i].w & 0xffff0000u); } }
#pragma unroll
            for (int i = 0; i < 8; ++i) { s8[i] += __shfl_xor(s8[i], 8); s8[i] += __shfl_xor(s8[i], 16); s8[i] += __shfl_xor(s8[i], 32); s8[i] *= (1.0f / 256.0f); }
            if (lane < 8) { v4u o; o.x = pk2(s8[0], s8[1]); o.y = pk2(s8[2], s8[3]); o.z = pk2(s8[4], s8[5]); o.w = pk2(s8[6], s8[7]); *(LAS v4u*)(KMl + w * 64 + ch * 8) = o; } }
        else if (lane < 8) { const v4u z = {0u, 0u, 0u, 0u}; *(LAS v4u*)(KMl + w * 64 + (lane & 7) * 8) = z; }
        __syncthreads();
        f32x16 zero;
#pragma unroll
        for (int r = 0; r < 16; ++r) zero[r] = 0.f;
        Qf k;
#pragma unroll
        for (int sx = 0; sx < 4; ++sx) k.f[sx] = *(const LAS bf16x8*)(KMl + (r32 & 7) * 64 + hi * 8 + 16 * sx);
        f32x16 S = FA_MFMA(k.f[0], q.f[0], zero); S = FA_MFMA(k.f[1], q.f[1], S); S = FA_MFMA(k.f[2], q.f[2], S); S = FA_MFMA(k.f[3], q.f[3], S);
        float gsc[8];
#pragma unroll
        for (int i = 0; i < 4; ++i) { auto sw = __builtin_amdgcn_permlane32_swap(__float_as_uint(S[i]), __float_as_uint(S[i]), false, false); gsc[i] = __uint_as_float(sw[0]); gsc[4 + i] = __uint_as_float(sw[1]); }
#pragma unroll
        for (int j = 0; j < 8; ++j) { int rank = 0;
#pragma unroll
            for (int i = 0; i < 8; ++i) rank += (i < c8 && (gsc[i] > gsc[j] || (gsc[i] == gsc[j] && i < j))) ? 1 : 0;
            if (j < c8 && rank < 3) selm |= 1u << j; }
    }
    Acc a; acc_reset(a); LAS unsigned char* tb0 = lds + L_TILE;
    const int nt = 4 * c8 + 4, npast = 4 * c8;
    for (int i = 0; i < npast; ++i) {
        LAS unsigned char* buf = tb0 + (i & 1) * TILE_BYTES;
        tile_commit(buf, tr, tid);
        tile_issue(tr, K + (size_t)(64 * (i + 1)) * 64, V + 64 * (i + 1), tid);
        __syncthreads();
        const bool on = (selm >> (i >> 2)) & 1u; const unsigned long long bal = __ballot(on);
        if (bal != 0ull) step64l(a, q, buf, r32, hi, bal != ~0ull, on);
    }
    for (int i = npast; i < nt; ++i) {
        LAS unsigned char* buf = tb0 + (i & 1) * TILE_BYTES;
        tile_commit(buf, tr, tid);
        if (i + 1 < nt) tile_issue(tr, K + (size_t)(64 * (i + 1)) * 64, V + 64 * (i + 1), tid);
        __syncthreads();
        const int ka = 2 * (i & 3), kb = ka + 1;
        if (ka <= w) step64m(a, q, buf, r32, hi, kb >= w, 0, ka == w ? r32 : 31, kb > w ? 1 : 0, kb > w ? 0 : (kb == w ? r32 : 31));
    }
    f32x16 t0, t1;
#pragma unroll
    for (int r = 0; r < 16; ++r) { t0[r] = 0.f; t1[r] = 0.f; }
    acc_finish(a, t0, t1, 1.0f);
    store_out(attout + (size_t)b * OUT_BATCH_E + (size_t)t * 1024 + 512 + h * 64, t0, t1, hi);
    __builtin_amdgcn_s_setprio(0);
    __syncthreads();
}
}
__device__ __forceinline__ void cmp_unit(Frame& F, const Args& A, int l, int u) {
    unsigned char* ws = F.ws; asm volatile("" : "+s"(ws)); const int tid = fresh_tid(F.wave_s), lane = tid & 63, r32 = lane & 31, hi = lane >> 5, w = __builtin_amdgcn_readfirstlane(tid >> 6), nt = w & 3, kh = w >> 2;
    LAS float* part = (LAS float*)F.lds;
    LAS float* hid = (LAS float*)(F.lds + 16896);
    LAS float* o2 = (LAS float*)(F.lds + 16896 + 16384);
    {
        const int kv = u >> 6, bg = (u >> 2) & 15, ct = u & 3, c0 = 32 * ct;
        const bf16* src = (const bf16*)(ws + WS_ARENA + (size_t)(bg >> 1) * ARENA_B + (kv ? A_VC : A_KC)) + (size_t)(bg & 1) * SEQ * 64;
        const bf16* w1t = (const bf16*)(ws + (kv ? WS_W1TV : WS_W1TK));
        fa::f32x16 acc;
#pragma unroll
        for (int r = 0; r < 16; ++r) acc[r] = 0.f;
        const bf16* ap = src + (size_t)(16 * (c0 + r32)) * 64 + 8 * hi;
        const bf16* bp = w1t + (size_t)(32 * nt + r32) * 2048 + 8 * hi;
        for (int sb = kh * 64; sb < kh * 64 + 64; sb += 16) {
            fa::bf16x8 af[16], bfr[16];
#pragma unroll
            for (int i = 0; i < 16; ++i) { const int s = sb + i;
                af[i] = *(const GAS fa::bf16x8*)(ap + (s >> 2) * 64 + 16 * (s & 3)); bfr[i] = *(const GAS fa::bf16x8*)(bp + 16 * s); }
            __builtin_amdgcn_sched_barrier(0);
#pragma unroll
            for (int i = 0; i < 16; ++i) acc = FA_MFMA(af[i], bfr[i], acc);
            __builtin_amdgcn_sched_barrier(0);
        }

        if (kh == 1) {
#pragma unroll
            for (int r = 0; r < 16; ++r) part[(nt * 32 + fa::crow(r, hi)) * 33 + r32] = acc[r];
        }
        __syncthreads();
        LAS bf16* hidb = (LAS bf16*)hid;
        if (kh == 0) { const float bias = ((const float*)(ws + WS_CBIAS))[kv * 128 + 32 * nt + r32];
#pragma unroll
            for (int r = 0; r < 16; ++r) { const int c = fa::crow(r, hi); hidb[c * 136 + 32 * nt + r32] = (bf16)f2bf(gelu_tanh(acc[r] + part[(nt * 32 + c) * 33 + r32] + bias)); }
        }
        __syncthreads();
        if (w < 2) {
            const bf16* w2t = (const bf16*)(ws + (kv ? WS_W2TV : WS_W2TK)) + (size_t)(32 * w + r32) * 128 + 8 * hi;
            fa::bf16x8 bq[8];
#pragma unroll
            for (int sx = 0; sx < 8; ++sx) bq[sx] = *(const GAS fa::bf16x8*)(w2t + 16 * sx);
            fa::f32x16 oacc;
#pragma unroll
            for (int r = 0; r < 16; ++r) oacc[r] = 0.f;
#pragma unroll
            for (int sx = 0; sx < 8; ++sx) { const fa::bf16x8 aq = *(const LAS fa::bf16x8*)(hidb + r32 * 136 + 16 * sx + 8 * hi); oacc = FA_MFMA(aq, bq[sx], oacc); }
#pragma unroll
            for (int r = 0; r < 16; ++r) o2[fa::crow(r, hi) * 64 + 32 * w + r32] = oacc[r];
        }
        __syncthreads();
        const int d = tid & 63, cq = tid >> 6;
#pragma unroll
        for (int i = 0; i < 4; ++i) { const int cl = cq + 8 * i, c = c0 + cl;
            if (kv == 0) { float r = 0.f;
                if (c < 127) { const int t = 16 * c + 31, dd = d & 31; const float cs = ((const float*)(ws + WS_ROPEC))[t * 32 + dd], sn = ((const float*)(ws + WS_ROPES))[t * 32 + dd];
                    const float x1 = o2[cl * 64 + dd], x2 = o2[cl * 64 + dd + 32]; r = d < 32 ? x1 * cs - x2 * sn : x2 * cs + x1 * sn; }
                ((bf16*)(ws + WS_KCB))[((size_t)bg * 128 + c) * 64 + d] = (bf16)f2bf(r); }
            else { const float r = c < 127 ? o2[cl * 64 + d] : 0.f; ((bf16*)(ws + WS_VCBT))[((size_t)bg * 64 + d) * 128 + c] = (bf16)f2bf(r); } }
        __syncthreads();
    }
}
__device__ __forceinline__ void phase_x(Frame& F, const Args& A, int l, bf16* attout) {
    const int vcu = (F.G % 8 == 0) ? (F.bx % 8) * (F.G / 8) + F.bx / 8 : F.bx;
    for (int mp = vcu; mp < 256; mp += F.G) { const int bh = mp >> 2, i = mp & 3;
        if (i < 2) { const int g8 = mp >> 5, j5 = mp & 31, a4 = (j5 >> 2) * 2 + (j5 & 1);
            cmp_unit(F, A, l, (a4 >> 3) * 64 + (2 * g8 + ((a4 >> 2) & 1)) * 4 + (a4 & 3)); }
        const int code = i == 0 ? 0x7 : i == 1 ? 0x06 : i == 2 ? 0x35 : 0x124, cnt = i == 0 ? 1 : i == 3 ? 3 : 2;
        for (int k = 0; k < cnt; ++k) fa::moba_unit(F.ws, attout, F.lds, F.wave_s, bh, (code >> (4 * k)) & 15); }
}
__device__ __forceinline__ void phase_y(Frame& F, bf16* attout) {
    const int vcu = (F.G % 8 == 0) ? (F.bx % 8) * (F.G / 8) + F.bx / 8 : F.bx;
    for (int np = vcu; np < 256; np += F.G) { const int bg = np >> 4, p = np & 15;
        for (int k = 0; k < 2; ++k) fa::nsa_unit(F.ws, attout, F.lds, F.wave_s, bg, k == 0 ? 31 - p : p); }
}
__global__ void __launch_bounds__(NWAVES * 64, 2) fwd_kernel(Args args) {
    extern __shared__ __attribute__((aligned(16))) unsigned char lds[];
    LAS unsigned char* ldsb = (LAS unsigned char*)lds;
    volatile LAS unsigned* MISC = (volatile LAS unsigned*)(ldsb + MISC_OFF);
    for (int u = threadIdx.x; u < (LDS_BYTES - LDSCTL_OFF) / 4; u += NWAVES * 64) ((LAS unsigned*)(ldsb + LDSCTL_OFF))[u] = 0u;
    __syncthreads();
    const int wave_s = __builtin_amdgcn_readfirstlane((int)threadIdx.x >> 6);
    XcdBarrier bar; bar.bar = (unsigned*)(args.ws + WS_CTL) + 4096; bar.x = 0; bar.st = nullptr;
    const bool multi = (args.ph_hi - args.ph_lo) > 1;
    if (multi) bar = xcd_barrier_post((unsigned*)(args.ws + WS_CTL) + 4096, MISC + 8);
    bool colocal = false, checked = !multi;
    for (int ph = args.ph_lo; ph < args.ph_hi; ++ph) {
        unsigned char* ws = args.ws; asm volatile("" : "+s"(ws));
        unsigned zero_ = 0u; asm volatile("" : "+s"(zero_));
        int tid_ = wave_s * 64 + (int)__builtin_amdgcn_mbcnt_hi(~0u, __builtin_amdgcn_mbcnt_lo(~0u, zero_)); asm volatile("" : "+v"(tid_));
        Frame F;
        F.lds = ldsb; F.ws = ws; F.ctl = (gu32*)(ws + WS_CTL);
        F.tid = tid_; F.lane = 0; F.wave = 0; F.G = gridDim.x; F.bx = blockIdx.x; F.wave_s = wave_s;
        const int l = ph / PH_PER_LAYER, k = (ph == PH_NORM) ? -1 : ph % PH_PER_LAYER;
        bf16* XB = (bf16*)(ws + WS_XB); float* rowss = (float*)(ws + WS_ROWSS);
        if (ph == PH_NORM) {
#ifndef NO_NORM
 phase_norm(F, args);
#endif
 }
        else if (k == PH_CONV) {
#ifndef NO_CONV
 phase_conv(F, args, l);
#endif
 }
        else if (k == PH_UP1 || k == PH_UP2) {
            pg8::Gemm g{XB, (const bf16*)(ws + (k == PH_UP1 ? WS_WUP1 : WS_WUP2)), MT, NUP, DM, 0}; pg8::StaticOrder S; S.init(MT, NUP, F.G, F.bx);
            pg8::EpiSwiglu E{(bf16*)(ws + WS_ARENA + A_H), rowss};

#ifndef NO_UP
 pg8::gemm_phase<pg8::EpiSwiglu, pg8::StaticOrder, true, true>(F.lds, g, S, E, F.tid);
#endif

        }
        else if (k == PH_DN1 || k == PH_DN2 || k == PH_OUT) {
            const bool isout = (k == PH_OUT);
            pg8::Gemm g{(const bf16*)(ws + WS_ARENA + (isout ? A_MRG : A_H)), (const bf16*)(ws + (isout ? WS_WOUT : (k == PH_DN1 ? WS_WDN1 : WS_WDN2))), MT, DM, isout ? DM : DFF,
                        ARENA_B - (size_t)SEQ * (isout ? DM : DFF) * 2}; pg8::StaticOrder S; S.init(MT, DM, F.G, F.bx);
            pg8::EpiResid E{XB, rowss, isout ? 1.0f : 0.5f, (LAS float*)(F.lds + 132096)};

#ifndef NO_DN
 pg8::gemm_phase<pg8::EpiResid, pg8::StaticOrder, true, true>(F.lds, g, S, E, F.tid);
#endif

        }
        else if (k == PH_WIN) {
            pg8::Gemm g{XB, (const bf16*)(ws + WS_WIN), MT, NWIN, DM, 0}; pg8::StaticOrder S; S.init(MT, NWIN, F.G, F.bx);
            pg8::EpiWin E{rowss, (const float*)(ws + WS_ROPEC), (const float*)(ws + WS_ROPES),
                pg8::WinBufs{(bf16*)(ws + WS_ARENA + A_QA), (bf16*)(ws + WS_ARENA + A_QB), (bf16*)(ws + WS_ARENA + A_KB), (bf16*)(ws + WS_ARENA + A_VBT), (bf16*)(ws + WS_ARENA + A_KC), (bf16*)(ws + WS_ARENA + A_VC), (bf16*)(ws + WS_ARENA + A_KS), (bf16*)(ws + WS_ARENA + A_VST),
                             (bf16*)(ws + WS_ARENA + A_KW), (bf16*)(ws + WS_ARENA + A_VWT), (bf16*)(ws + WS_ARENA + A_GA), (bf16*)(ws + WS_ARENA + A_GB), (float*)(ws + WS_ARENA + A_GS)}};

#ifndef NO_WIN
 pg8::gemm_phase<pg8::EpiWin, pg8::StaticOrder, true, true>(F.lds, g, S, E, F.tid);
#endif

        }
        else if (k == PH_CMP) {
#ifndef NO_CMP
 { bf16* attout = (bf16*)args.out; asm volatile("" : "+s"(attout)); phase_x(F, args, l, attout); }
#endif
 }
        else if (k == PH_ATT) {
#ifndef NO_ATT
 { bf16* attout = (bf16*)args.out; asm volatile("" : "+s"(attout)); phase_y(F, attout); }
#endif
 }
        else if (k == PH_MRG) {
            { pg8::Gemm g{(const bf16*)args.out, (const bf16*)(ws + WS_WPA), MT, DM, DM, (size_t)OUT_BATCH_E * 2 - (size_t)SEQ * DM * 2}; pg8::StaticOrder S; S.init(MT, DM, F.G, F.bx);
              pg8::EpiMergeF E{(const bf16*)(ws + WS_ARENA + A_GA), (const bf16*)(ws + WS_ARENA + A_GB), (bf16*)(ws + WS_ARENA + A_MRG)};
#ifndef NO_MRG
              pg8::gemm_phase<pg8::EpiMergeF, pg8::StaticOrder, true, true>(F.lds, g, S, E, F.tid);
#endif
            }
        }
        if (ph + 1 < args.ph_hi) {
            const bool full_seam = (k == PH_CONV) || (k == PH_DN2 && l == 0);
            const int tq = fresh_tid(wave_s);
            if (full_seam || !colocal) { xcd_barrier(bar, tq == 0); if (!checked) { colocal = colocal_check(bar, MISC + 10, fresh_tid(wave_s)); checked = true; } }
            else if (k == PH_UP1 || k == PH_UP2 || k == PH_MRG) team_barrier(bar, tq == 0, (blockIdx.x & 7u) * 8u + ((blockIdx.x >> 3) & 7u));
            else group_barrier(bar, tq == 0, blockIdx.x & 7u, gridDim.x >> 3);
        }
    }
}

extern "C" void kernel_launch(void* const* d_in, const int* in_sizes, int n_in, void* d_out, int out_size, void* d_ws, size_t ws_size, hipStream_t stream) {
    static int grid = 0;
    if (grid == 0) {
        if (n_in != 21 || in_sizes[0] != MT * DM || out_size != MT * DM || ws_size < WS_END) { fprintf(stderr, "kernel_launch: unexpected shapes (n_in %d, in0 %d, out %d, ws %zu)\n", n_in, n_in > 0 ? in_sizes[0] : -1, out_size, ws_size); grid = -1; return; }
        int dev = 0, cus = 0;
        if (hipGetDevice(&dev) != hipSuccess || hipDeviceGetAttribute(&cus, hipDeviceAttributeMultiprocessorCount, dev) != hipSuccess) { grid = -1; return; }
        if (hipFuncSetAttribute((const void*)fwd_kernel, hipFuncAttributeMaxDynamicSharedMemorySize, LDS_BYTES) != hipSuccess) { fprintf(stderr, "kernel_launch: hipFuncSetAttribute failed\n"); grid = -1; return; }
        (void)hipGetLastError();
        grid = cus;
    }
    if (grid < 0) return;
    (void)hipMemsetAsync((char*)d_ws + WS_CTL, 0, CTL_ZERO_BYTES, stream);
    Args a{};
    for (int i = 0; i < 21; ++i) a.in[i] = (const float*)d_in[i];
    a.out = (float*)d_out; a.ws = (unsigned char*)d_ws;
#ifndef MULTI_LAUNCH
    a.ph_lo = 0; a.ph_hi = PH_TOTAL;
    hipLaunchKernelGGL(fwd_kernel, dim3(grid), dim3(NWAVES * 64), LDS_BYTES, stream, a);
    return;
#endif
    for (int ph = 0; ph < PH_TOTAL; ++ph) {
        a.ph_lo = ph; a.ph_hi = ph + 1;
        hipLaunchKernelGGL(fwd_kernel, dim3(grid), dim3(NWAVES * 64), LDS_BYTES, stream, a);
    }
}
```

```cpp
#include <hip/hip_runtime.h>
#include <cstdio>
#include <cstdint>
namespace pg8 {
#define PG8_LAS __attribute__((address_space(3)))
typedef unsigned short bf16_t;
typedef short bf16x8 __attribute__((ext_vector_type(8)));
typedef float f32x4 __attribute__((ext_vector_type(4)));
typedef unsigned u32x4 __attribute__((ext_vector_type(4)));
constexpr int BM = 256, BK = 64, HALF = 128, HTB = HALF * BK * 2  , STAGE_BYTES = 8 * HTB, NXCD = 8, WGM = 8;

__host__ __device__ __forceinline__ int lds_byte(int r, int c) { const int st = (r >> 4) * 2 + (c >> 5), rr = r & 15, cc = c & 31, ob = rr * 64 + cc * 2; return st * 1024 + (ob ^ (((ob >> 9) & 1) << 5)); }
__host__ __device__ __forceinline__ void stage_rc(int b, int& R, int& C) { const int st = b / 1024, sb = b % 1024, swz = sb ^ (((sb >> 9) & 1) << 5); R = (st >> 1) * 16 + swz / 64; C = (st & 1) * 32 + (swz % 64) / 2; }
__host__ __device__ __forceinline__ int perm32(int rho) { const int n = rho >> 4, i = rho & 15; return 8 * (i >> 2) + 4 * n + (i & 3); }

struct Unit { int pm, pn; };
struct Gemm { const bf16_t* A; const bf16_t* Bt; int M, N, K; size_t abgap; };

struct StaticOrder {
    int nM, nN, nwg, G, c;
    __host__ __device__ void init(int M, int N, int G_, int c_) { nM = M / BM; nN = N / BM; nwg = nM * nN; G = G_; c = c_; }
    __host__ __device__ bool next(int i, Unit& u) const {
        const long L = (long)i * G + c; if (L >= nwg) return false;
        int wgid = (int)L; { const int q = nwg / NXCD, r = nwg % NXCD, xcd = wgid % NXCD, off = wgid / NXCD; wgid = (xcd < r ? xcd * (q + 1) : r * (q + 1) + (xcd - r) * q) + off; }
        const int nig = WGM * nN, gid = wgid / nig, fm = gid * WGM, gsz = (nM - fm) < WGM ? (nM - fm) : WGM;
        u.pm = fm + ((wgid % nig) % gsz); u.pn = (wgid % nig) / gsz; return true;
    }
    __device__ __forceinline__ void a_ready(const Unit&) const {}
    __device__ __forceinline__ void done(const Unit&) const {}
};

typedef unsigned u32x2 __attribute__((ext_vector_type(2)));
typedef float pk_f32x2 __attribute__((ext_vector_type(2)));
typedef __bf16 pk_bf16x2 __attribute__((ext_vector_type(2)));
__device__ __forceinline__ unsigned cvt_pk_bf16(float lo, float hi) { const pk_f32x2 v = {lo, hi}; const pk_bf16x2 b = __builtin_convertvector(v, pk_bf16x2); return __builtin_bit_cast(unsigned, b); }
__device__ __forceinline__ float rstd_of(const float* rowss, int row) { const f32x4 a = *(const __attribute__((address_space(1))) f32x4*)(rowss + (size_t)row * 4); return __builtin_amdgcn_rsqf(((a[0] + a[1]) + (a[2] + a[3])) * (1.0f / 1024.0f) + 1e-6f); }
__device__ __forceinline__ void rstd8(const float* rowss, int row0, float (&rs)[2][4]) {
    f32x4 a[2][4];
#pragma unroll
    for (int ai = 0; ai < 2; ++ai)
#pragma unroll
        for (int m = 0; m < 4; ++m) a[ai][m] = *(const __attribute__((address_space(1))) f32x4*)(rowss + (size_t)(row0 + ai * HALF + m * 16) * 4);
    __builtin_amdgcn_sched_barrier(0);
#pragma unroll
    for (int ai = 0; ai < 2; ++ai)
#pragma unroll
        for (int m = 0; m < 4; ++m) rs[ai][m] = __builtin_amdgcn_rsqf(((a[ai][m][0] + a[ai][m][1]) + (a[ai][m][2] + a[ai][m][3])) * (1.0f / 1024.0f) + 1e-6f);
}
__device__ __forceinline__ float sigm(float v) { return __builtin_amdgcn_rcpf(1.0f + __builtin_amdgcn_exp2f(-1.4426950408889634f * v)); }
__device__ __forceinline__ float bfl(unsigned w) { return __uint_as_float(w << 16); }
__device__ __forceinline__ float bfh(unsigned w) { return __uint_as_float(w & 0xffff0000u); }

struct EpiSwiglu {
    static constexpr bool PERM = false, AFTER_DRAIN = false, HAS_MID = false;
    bf16_t* H; const float* rowss;
    __device__ __forceinline__ void operator()(const f32x4 (&acc)[2][2][4][2], const Unit& u, int wr, int wc, int fr, int fq) const {
        const int row0 = u.pm * BM + wr * 64 + fr, col0 = u.pn * 128 + wc * 32 + 8 * fq;
        float rsa[2][4]; rstd8(rowss, row0, rsa);
#pragma unroll
        for (int ai = 0; ai < 2; ++ai)
#pragma unroll
            for (int m = 0; m < 4; ++m) { const int row = row0 + ai * HALF + m * 16; const float rs = rsa[ai][m];
                float hv[8];
#pragma unroll
                for (int n = 0; n < 2; ++n)
#pragma unroll
                    for (int i = 0; i < 4; ++i) { const float g = acc[ai][0][m][n][i] * rs, uu = acc[ai][1][m][n][i] * rs; hv[4 * n + i] = g * uu * sigm(g); }
                u32x4 w; w.x = cvt_pk_bf16(hv[0], hv[1]); w.y = cvt_pk_bf16(hv[2], hv[3]); w.z = cvt_pk_bf16(hv[4], hv[5]); w.w = cvt_pk_bf16(hv[6], hv[7]);
                *(u32x4*)(H + (size_t)(row >> 11) * (size_t)10526720 + (size_t)(row & 2047) * 2816 + col0) = w; asm volatile("" ::: "memory"); }
    }
};
struct EpiResid {
    static constexpr bool PERM = false, AFTER_DRAIN = false, HAS_MID = false;
    bf16_t* XB; float* rowss; float alpha; PG8_LAS float* ssl;
    __device__ __forceinline__ void operator()(const f32x4 (&acc)[2][2][4][2], const Unit& u, int wr, int wc, int fr, int fq) const {
        const int row0 = u.pm * BM + wr * 64 + fr, col0 = u.pn * BM + wc * 32 + 4 * fq;
        u32x2 xo[2][4][2][2];
#pragma unroll
        for (int ai = 0; ai < 2; ++ai)
#pragma unroll
            for (int m = 0; m < 4; ++m)
#pragma unroll
                for (int bj = 0; bj < 2; ++bj)
#pragma unroll
                    for (int n = 0; n < 2; ++n) xo[ai][m][bj][n] = *(const __attribute__((address_space(1))) u32x2*)(XB + (size_t)(row0 + ai * HALF + m * 16) * 1024 + col0 + bj * HALF + n * 16);
        __builtin_amdgcn_sched_barrier(0);
#pragma unroll
        for (int ai = 0; ai < 2; ++ai)
#pragma unroll
            for (int m = 0; m < 4; ++m) { const int row = row0 + ai * HALF + m * 16; const size_t off = (size_t)row * 1024 + col0; float ss = 0.f;
#pragma unroll
                for (int bj = 0; bj < 2; ++bj)
#pragma unroll
                    for (int n = 0; n < 2; ++n) { const size_t o = off + bj * HALF + n * 16; const f32x4 a = acc[ai][bj][m][n]; const u32x2 xv = xo[ai][m][bj][n];
                        const float x0 = bfl(xv.x) + a[0] * alpha, x1 = bfh(xv.x) + a[1] * alpha, x2 = bfl(xv.y) + a[2] * alpha, x3 = bfh(xv.y) + a[3] * alpha;
                        u32x2 w; w.x = cvt_pk_bf16(x0, x1); w.y = cvt_pk_bf16(x2, x3); *(__attribute__((address_space(1))) u32x2*)(XB + o) = w;
                        ss += (x0 * x0 + x1 * x1) + (x2 * x2 + x3 * x3); }
                ss += __shfl_xor(ss, 16); ss += __shfl_xor(ss, 32);
                if (fq == 0) ssl[(ai * HALF + wr * 64 + m * 16 + fr) * 4 + wc] = ss; }
        asm volatile("s_waitcnt lgkmcnt(0)" ::: "memory"); __builtin_amdgcn_s_barrier(); asm volatile("" ::: "memory");
        { const int tid = (wr * 4 + wc) * 64 + fq * 16 + fr;
          if (tid < 256) { const f32x4 p = *(const PG8_LAS f32x4*)(ssl + tid * 4); rowss[(size_t)(u.pm * BM + tid) * 4 + u.pn] = (p[0] + p[1]) + (p[2] + p[3]); } }
        asm volatile("s_waitcnt lgkmcnt(0)" ::: "memory"); __builtin_amdgcn_s_barrier(); asm volatile("" ::: "memory");
    }
};
struct EpiMergeF {
    static constexpr bool PERM = false, AFTER_DRAIN = false, HAS_MID = true; static constexpr int MID_T = 8;
    const bf16_t* GA; const bf16_t* GB; bf16_t* Mg;
    __device__ __forceinline__ void mid(f32x4 (&acc)[2][2][4][2], const Unit& u, int wr, int wc, int fr, int fq) const {
        int row0 = u.pm * BM + wr * 64 + fr, col0 = u.pn * BM + wc * 32 + 8 * fq;
        asm volatile("" : "+v"(row0), "+v"(col0));
#pragma unroll
        for (int ai = 0; ai < 2; ++ai) {
            u32x4 ga[4][2], gb[4][2];
#pragma unroll
            for (int m = 0; m < 4; ++m)
#pragma unroll
                for (int bj = 0; bj < 2; ++bj) { const int rw = row0 + ai * HALF + m * 16; const size_t o = (size_t)(rw >> 11) * (size_t)10526720 + (size_t)(rw & 2047) * 1024 + col0 + bj * HALF;
                    ga[m][bj] = *(const __attribute__((address_space(1))) u32x4*)(GA + o); gb[m][bj] = *(const __attribute__((address_space(1))) u32x4*)(GB + o); }
            __builtin_amdgcn_sched_barrier(0);
#pragma unroll
            for (int m = 0; m < 4; ++m)
#pragma unroll
                for (int bj = 0; bj < 2; ++bj) { const u32x4 a = ga[m][bj], b = gb[m][bj]; float r[8];
                    r[0] = bfl(a.x) * __builtin_amdgcn_rcpf(fmaxf(bfl(b.x), 1e-30f)); r[1] = bfh(a.x) * __builtin_amdgcn_rcpf(fmaxf(bfh(b.x), 1e-30f));
                    r[2] = bfl(a.y) * __builtin_amdgcn_rcpf(fmaxf(bfl(b.y), 1e-30f)); r[3] = bfh(a.y) * __builtin_amdgcn_rcpf(fmaxf(bfh(b.y), 1e-30f));
                    r[4] = bfl(a.z) * __builtin_amdgcn_rcpf(fmaxf(bfl(b.z), 1e-30f)); r[5] = bfh(a.z) * __builtin_amdgcn_rcpf(fmaxf(bfh(b.z), 1e-30f));
                    r[6] = bfl(a.w) * __builtin_amdgcn_rcpf(fmaxf(bfl(b.w), 1e-30f)); r[7] = bfh(a.w) * __builtin_amdgcn_rcpf(fmaxf(bfh(b.w), 1e-30f));
                    acc[ai][bj][m][0][0] *= r[0]; acc[ai][bj][m][0][1] *= r[1]; acc[ai][bj][m][0][2] *= r[2]; acc[ai][bj][m][0][3] *= r[3];
                    acc[ai][bj][m][1][0] *= r[4]; acc[ai][bj][m][1][1] *= r[5]; acc[ai][bj][m][1][2] *= r[6]; acc[ai][bj][m][1][3] *= r[7]; }
            asm volatile("" ::: "memory"); }
    }
    __device__ __forceinline__ void operator()(const f32x4 (&acc)[2][2][4][2], const Unit& u, int wr, int wc, int fr, int fq) const {
        const int row0 = u.pm * BM + wr * 64 + fr, col0 = u.pn * BM + wc * 32 + 8 * fq;
        u32x4 gb[2][4][2];
#pragma unroll
        for (int ai = 0; ai < 2; ++ai)
#pragma unroll
            for (int m = 0; m < 4; ++m)
#pragma unroll
                for (int bj = 0; bj < 2; ++bj) { const int rw = row0 + ai * HALF + m * 16; gb[ai][m][bj] = *(const __attribute__((address_space(1))) u32x4*)(GB + (size_t)(rw >> 11) * (size_t)10526720 + (size_t)(rw & 2047) * 1024 + col0 + bj * HALF); }
        __builtin_amdgcn_sched_barrier(0);
#pragma unroll
        for (int ai = 0; ai < 2; ++ai)
#pragma unroll
            for (int m = 0; m < 4; ++m) { const int row = row0 + ai * HALF + m * 16;
#pragma unroll
                for (int bj = 0; bj < 2; ++bj) { const size_t o = (size_t)(row >> 11) * (size_t)10526720 + (size_t)(row & 2047) * 1024 + col0 + bj * HALF; const u32x4 gw = gb[ai][m][bj];
                    float r[8]; const f32x4 a0 = acc[ai][bj][m][0], a1 = acc[ai][bj][m][1];
                    r[0] = fmaxf(bfl(gw.x), 1e-30f) * a0[0]; r[1] = fmaxf(bfh(gw.x), 1e-30f) * a0[1]; r[2] = fmaxf(bfl(gw.y), 1e-30f) * a0[2]; r[3] = fmaxf(bfh(gw.y), 1e-30f) * a0[3];
                    r[4] = fmaxf(bfl(gw.z), 1e-30f) * a1[0]; r[5] = fmaxf(bfh(gw.z), 1e-30f) * a1[1]; r[6] = fmaxf(bfl(gw.w), 1e-30f) * a1[2]; r[7] = fmaxf(bfh(gw.w), 1e-30f) * a1[3];
                    u32x4 w; w.x = cvt_pk_bf16(r[0], r[1]); w.y = cvt_pk_bf16(r[2], r[3]); w.z = cvt_pk_bf16(r[4], r[5]); w.w = cvt_pk_bf16(r[6], r[7]);
                    *(__attribute__((address_space(1))) u32x4*)(Mg + o) = w; } }
    }
};
constexpr float C2Q = 0.125f * 1.4426950408889634f;
enum { WT_ROPE = 0, WT_PLAIN = 1, WT_VT = 2, WT_SIG = 3, WT_GS = 4, WT_NONE = 5 };
struct WinBufs { bf16_t *QA, *QB, *KBb, *VBt, *KC, *VC, *KS, *VSt, *KW, *VWt, *GA, *GB; float* GS; };
struct EpiWin {
    static constexpr bool PERM = false, AFTER_DRAIN = false, HAS_MID = false;
    const float* rowss; const float* ropec; const float* ropes; WinBufs B;
    __device__ __forceinline__ void operator()(const f32x4 (&acc)[2][2][4][2], const Unit& u, int wr, int wc, int fr, int fq) const {
        const int row0 = u.pm * BM + wr * 64 + fr;
        float rs[2][4]; rstd8(rowss, row0, rs);
        const int hh = wc >> 1, w = wc & 1;
#pragma unroll
        for (int bj = 0; bj < 2; ++bj) {
            const int half = 2 * u.pn + bj;
            int type, nh = 8, hb = 0, cb = 0; bf16_t* dst = nullptr; float sc = 1.f;
            if (half < 4) { type = WT_ROPE; dst = B.QA; hb = 2 * half; sc = C2Q; }
            else if (half == 4) { type = WT_PLAIN; dst = B.KC; nh = 2; }
            else if (half == 5) { type = WT_PLAIN; dst = B.VC; nh = 2; }
            else if (half == 6) { type = WT_ROPE; dst = B.KS; nh = 2; }
            else if (half == 7) { type = WT_VT; dst = B.VSt; nh = 2; }
            else if (half == 8) { type = WT_ROPE; dst = B.KW; nh = 2; }
            else if (half == 9) { type = WT_VT; dst = B.VWt; nh = 2; }
            else if (half < 14) { type = WT_ROPE; dst = B.QB; hb = 2 * (half - 10); sc = C2Q; }
            else if (half < 18) { type = WT_ROPE; dst = B.KBb; hb = 2 * (half - 14); }
            else if (half < 22) { type = WT_VT; dst = B.VBt; hb = 2 * (half - 18); }
            else if (half < 30) { type = WT_SIG; dst = B.GA; cb = 128 * (half - 22); }
            else if (half < 38) { type = WT_SIG; dst = B.GB; cb = 128 * (half - 30); }
            else if (half == 38) { type = WT_GS; }
            else { type = WT_NONE; }
            const int head = hb + hh;
            if (type == WT_ROPE) {
#pragma unroll
                for (int ai = 0; ai < 2; ++ai) {
                    f32x4 cs4[4], sn4[4];
#pragma unroll
                    for (int m = 0; m < 4; ++m) { const int sp = (row0 + ai * HALF + m * 16) & 2047;
                        cs4[m] = *(const __attribute__((address_space(1))) f32x4*)(ropec + sp * 32 + 16 * w + 4 * fq); sn4[m] = *(const __attribute__((address_space(1))) f32x4*)(ropes + sp * 32 + 16 * w + 4 * fq); }
                    __builtin_amdgcn_sched_barrier(0);
#pragma unroll
                    for (int m = 0; m < 4; ++m) { const int row = row0 + ai * HALF + m * 16, b = row >> 11, s = row & 2047; const float r = rs[ai][m] * sc;
                        const f32x4 c4 = cs4[m], s4 = sn4[m];
                        const f32x4 x1 = acc[ai][bj][m][0] * r, x2 = acc[ai][bj][m][1] * r;
                        const f32x4 o1 = x1 * c4 - x2 * s4, o2 = x2 * c4 + x1 * s4;
                        bf16_t* p = dst + (size_t)b * (size_t)10526720 + ((size_t)head * 2048 + s) * 64 + 16 * w + 4 * fq;
                        u32x2 w1, w2; w1.x = cvt_pk_bf16(o1[0], o1[1]); w1.y = cvt_pk_bf16(o1[2], o1[3]); w2.x = cvt_pk_bf16(o2[0], o2[1]); w2.y = cvt_pk_bf16(o2[2], o2[3]);
                        *(u32x2*)p = w1; *(u32x2*)(p + 32) = w2; }
                    asm volatile("" ::: "memory"); }
            } else if (type == WT_PLAIN) {
#pragma unroll
                for (int ai = 0; ai < 2; ++ai)
#pragma unroll
                    for (int m = 0; m < 4; ++m) { const int row = row0 + ai * HALF + m * 16, b = row >> 11, s = row & 2047; const float r = rs[ai][m];
                        const f32x4 v0 = acc[ai][bj][m][0] * r, v1 = acc[ai][bj][m][1] * r;
                        bf16_t* p = dst + (size_t)b * (size_t)10526720 + ((size_t)head * 2048 + s) * 64 + 32 * w + 4 * fq;
                        u32x2 w1, w2; w1.x = cvt_pk_bf16(v0[0], v0[1]); w1.y = cvt_pk_bf16(v0[2], v0[3]); w2.x = cvt_pk_bf16(v1[0], v1[1]); w2.y = cvt_pk_bf16(v1[2], v1[3]);
                        *(u32x2*)p = w1; *(u32x2*)(p + 16) = w2; asm volatile("" ::: "memory"); }
            } else if (type == WT_VT) {
#pragma unroll
                for (int ai = 0; ai < 2; ++ai)
#pragma unroll
                    for (int m = 0; m < 4; ++m) { const int row = row0 + ai * HALF + m * 16, b = row >> 11, s = row & 2047; const float r = rs[ai][m];
                        bf16_t* p = dst + (size_t)b * (size_t)10526720 + ((size_t)head * 64 + 32 * w + 4 * fq) * 2048 + s;
#pragma unroll
                        for (int n = 0; n < 2; ++n) { const f32x4 v = acc[ai][bj][m][n] * r; const unsigned a = cvt_pk_bf16(v[0], v[1]), c = cvt_pk_bf16(v[2], v[3]);
                            bf16_t* q = p + (size_t)(16 * n) * 2048;
                            q[0] = (bf16_t)(a & 0xffffu); q[2048] = (bf16_t)(a >> 16); q[4096] = (bf16_t)(c & 0xffffu); q[6144] = (bf16_t)(c >> 16); } asm volatile("" ::: "memory"); }
            } else if (type == WT_SIG) {
#pragma unroll
                for (int ai = 0; ai < 2; ++ai)
#pragma unroll
                    for (int m = 0; m < 4; ++m) { const int row = row0 + ai * HALF + m * 16, b = row >> 11, s = row & 2047; const float r = rs[ai][m];
                        const f32x4 v0 = acc[ai][bj][m][0] * r, v1 = acc[ai][bj][m][1] * r;
                        u32x4 o; o.x = cvt_pk_bf16(sigm(v0[0]), sigm(v0[1])); o.y = cvt_pk_bf16(sigm(v0[2]), sigm(v0[3])); o.z = cvt_pk_bf16(sigm(v1[0]), sigm(v1[1])); o.w = cvt_pk_bf16(sigm(v1[2]), sigm(v1[3]));
                        *(u32x4*)(dst + (size_t)b * (size_t)10526720 + (size_t)s * 1024 + cb + 32 * wc + 8 * fq) = o; asm volatile("" ::: "memory"); }
            } else if (type == WT_GS) {
                if (wc == 0) {
#pragma unroll
                    for (int ai = 0; ai < 2; ++ai)
#pragma unroll
                        for (int m = 0; m < 4; ++m) { const int row = row0 + ai * HALF + m * 16; const float r = rs[ai][m];
#pragma unroll
                            for (int n = 0; n < 2; ++n) { const f32x4 v = acc[ai][bj][m][n] * r; f32x4 o; o[0] = sigm(v[0]); o[1] = sigm(v[1]); o[2] = sigm(v[2]); o[3] = sigm(v[3]);
                                *(f32x4*)(B.GS + (size_t)(row >> 11) * (size_t)5263360 + (size_t)(row & 2047) * 32 + 16 * n + 4 * fq) = o; } }
                }
            }
        }
    }
};
template <class Epi, class Sched, bool ALIGN_EPI = false, bool SP2 = false>
__device__ __forceinline__ void gemm_phase(PG8_LAS unsigned char* lds, const Gemm g, const Sched& S, const Epi& E, const int tid) {
    const int wid = __builtin_amdgcn_readfirstlane(tid >> 6), lane = tid & 63, wr = wid >> 2, wc = wid & 3, fr = lane & 15, fq = lane >> 4;
    const int K = g.K, nt = K / BK;
    unsigned voffA[2], voffB[2];
#pragma unroll
    for (int i = 0; i < 2; ++i) { int R, C; stage_rc(tid * 16 + i * 8192, R, C); const int Rb = Epi::PERM ? ((R & ~31) + perm32(R & 31)) : R;
        voffA[i] = (unsigned)(R * K + C) * 2u; voffB[i] = (unsigned)(Rb * K + C) * 2u; }
    const size_t kstep = (size_t)(BK * 2);
    const size_t hstep = (size_t)HALF * K * 2;
    const size_t tstep = 2 * hstep;
    const unsigned ldsw = (unsigned)wid * 1024u;
    const int aoff = lds_byte(wr * 64 + fr, fq * 8), boff = lds_byte(wc * 32 + fr, fq * 8);
#define PG8_SA(b, h) (((b) * 2 + (h)) * HTB)
#define PG8_SB(b, h) ((4 + (b) * 2 + (h)) * HTB)
#define PG8_STAGE(bufoff, gbase, voff) do { _Pragma("unroll") for (int _i = 0; _i < 2; ++_i) \
        __builtin_amdgcn_global_load_lds((const unsigned*)((const char*)(gbase) + (voff)[_i]), (PG8_LAS unsigned*)(lds + (bufoff) + ldsw + _i * 8192), 16, 0, 0); } while (0)
#define PG8_LDA(dst, b, h) do { _Pragma("unroll") for (int m = 0; m < 4; ++m) _Pragma("unroll") for (int k = 0; k < 2; ++k) dst[m][k] = *(const PG8_LAS bf16x8*)(lds + PG8_SA(b, h) + aoff + m * 2048 + k * 1024); } while (0)
#define PG8_LDB(dst, b, h) do { _Pragma("unroll") for (int n = 0; n < 2; ++n) _Pragma("unroll") for (int k = 0; k < 2; ++k) dst[n][k] = *(const PG8_LAS bf16x8*)(lds + PG8_SB(b, h) + boff + n * 2048 + k * 1024); } while (0)
#define PG8_MMA(ai, bj, At, Bt) do { __builtin_amdgcn_s_setprio(1); _Pragma("unroll") for (int m = 0; m < 4; ++m) _Pragma("unroll") for (int n = 0; n < 2; ++n) _Pragma("unroll") for (int k = 0; k < 2; ++k) \
        acc[ai][bj][m][n] = __builtin_amdgcn_mfma_f32_16x16x32_bf16(Bt[n][k], At[m][k], acc[ai][bj][m][n], 0, 0, 0); __builtin_amdgcn_s_setprio(0); } while (0)
#define PG8_WAIT_V(n) asm volatile("s_waitcnt vmcnt(" #n ")" ::: "memory")
#define PG8_WAIT_L(n) asm volatile("s_waitcnt lgkmcnt(" #n ")" ::: "memory")
#define PG8_BAR __builtin_amdgcn_s_barrier()
#define PG8_SCHED __builtin_amdgcn_sched_barrier(0)
    Unit cur, nxt; int ui = 0;
    if (!S.next(0, cur)) return;
    f32x4 acc[2][2][4][2];
#pragma unroll
    for (int a = 0; a < 2; ++a)
#pragma unroll
        for (int b = 0; b < 2; ++b)
#pragma unroll
            for (int m = 0; m < 4; ++m)
#pragma unroll
                for (int n = 0; n < 2; ++n) acc[a][b][m][n] = (f32x4){0.f, 0.f, 0.f, 0.f};
    bf16x8 At[4][2], B0[2][2], B1[2][2];
    const char* cA = (const char*)g.A + (size_t)cur.pm * tstep + (size_t)(cur.pm >> 3) * g.abgap; const char* cB = (const char*)g.Bt + (size_t)cur.pn * tstep;
    S.a_ready(cur);
    if constexpr (SP2) {
        PG8_STAGE(PG8_SB(0, 0), cB, voffB); PG8_STAGE(PG8_SB(0, 1), cB + hstep, voffB); PG8_STAGE(PG8_SA(0, 0), cA, voffA); PG8_STAGE(PG8_SA(0, 1), cA + hstep, voffA);
        if (wr == 1) PG8_BAR;
        PG8_WAIT_V(2); PG8_BAR;
        PG8_STAGE(PG8_SB(1, 0), cB + kstep, voffB); PG8_STAGE(PG8_SA(1, 0), cA + kstep, voffA); PG8_STAGE(PG8_SB(1, 1), cB + hstep + kstep, voffB);
        PG8_WAIT_V(6); PG8_BAR;
    } else {
        PG8_STAGE(PG8_SB(0, 0), cB, voffB); PG8_STAGE(PG8_SA(0, 0), cA, voffA); PG8_STAGE(PG8_SB(0, 1), cB + hstep, voffB); PG8_STAGE(PG8_SA(0, 1), cA + hstep, voffA);
        if (wr == 1) PG8_BAR;
        PG8_WAIT_V(4); PG8_BAR;
        PG8_STAGE(PG8_SB(1, 0), cB + kstep, voffB); PG8_STAGE(PG8_SA(1, 0), cA + kstep, voffA); PG8_STAGE(PG8_SB(1, 1), cB + hstep + kstep, voffB);
        PG8_WAIT_V(6); PG8_BAR;
    }
    for (;;) {
        const bool has_next = S.next(ui + 1, nxt);
        const char* nA = has_next ? (const char*)g.A + (size_t)nxt.pm * tstep + (size_t)(nxt.pm >> 3) * g.abgap : cA; const char* nB = has_next ? (const char*)g.Bt + (size_t)nxt.pn * tstep : cB;
        for (int t = 0; t < nt; t += 2) {
            const bool last = (t == nt - 2);
            const char* a1 = cA + (size_t)(t + 1) * kstep;
            const char* a2 = last ? nA : cA + (size_t)(t + 2) * kstep; const char* b2 = last ? nB : cB + (size_t)(t + 2) * kstep;
            const char* a3 = a2 + kstep; const char* b3 = b2 + kstep;
            if (last && has_next) S.a_ready(nxt);
            if constexpr (Epi::HAS_MID) { if (t == Epi::MID_T) { __builtin_amdgcn_sched_barrier(0); E.mid(acc, cur, wr, wc, fr, fq); __builtin_amdgcn_sched_barrier(0); } }
            if constexpr (SP2) {
            PG8_LDB(B0, 0, 0); PG8_LDB(B1, 0, 1); PG8_SCHED; PG8_LDA(At, 0, 0); PG8_STAGE(PG8_SA(1, 1), a1 + hstep, voffA);
            PG8_WAIT_V(8); PG8_WAIT_L(0); PG8_BAR; PG8_MMA(0, 0, At, B0); PG8_MMA(0, 1, At, B1); PG8_BAR; PG8_SCHED;
            PG8_LDA(At, 0, 1); PG8_STAGE(PG8_SB(0, 0), b2, voffB); PG8_STAGE(PG8_SB(0, 1), b2 + hstep, voffB); PG8_STAGE(PG8_SA(0, 0), a2, voffA);
            PG8_WAIT_V(8); PG8_WAIT_L(0); PG8_BAR; PG8_MMA(1, 0, At, B0); PG8_MMA(1, 1, At, B1); PG8_BAR; PG8_SCHED;
            PG8_LDB(B0, 1, 0); PG8_LDB(B1, 1, 1); PG8_SCHED; PG8_LDA(At, 1, 0); PG8_STAGE(PG8_SA(0, 1), a2 + hstep, voffA);
            PG8_WAIT_V(8); PG8_WAIT_L(0); PG8_BAR; PG8_MMA(0, 0, At, B0); PG8_MMA(0, 1, At, B1); PG8_BAR; PG8_SCHED;
            PG8_LDA(At, 1, 1); PG8_STAGE(PG8_SB(1, 0), b3, voffB); PG8_STAGE(PG8_SB(1, 1), b3 + hstep, voffB); PG8_STAGE(PG8_SA(1, 0), a3, voffA);
            PG8_WAIT_V(8); PG8_WAIT_L(0); PG8_BAR; PG8_MMA(1, 0, At, B0); PG8_MMA(1, 1, At, B1); PG8_BAR; PG8_SCHED;
            } else {
            PG8_LDB(B0, 0, 0); PG8_SCHED; PG8_LDA(At, 0, 0); PG8_STAGE(PG8_SA(1, 1), a1 + hstep, voffA);
            PG8_WAIT_L(8); PG8_BAR; PG8_WAIT_L(0); PG8_MMA(0, 0, At, B0); PG8_BAR; PG8_SCHED;
            PG8_LDB(B1, 0, 1); PG8_STAGE(PG8_SB(0, 0), b2, voffB);
            PG8_BAR; PG8_WAIT_L(0); PG8_MMA(0, 1, At, B1); PG8_BAR;
            PG8_LDA(At, 0, 1); PG8_STAGE(PG8_SA(0, 0), a2, voffA);
            PG8_BAR; PG8_WAIT_L(0); PG8_MMA(1, 0, At, B0); PG8_BAR; PG8_SCHED;
            PG8_STAGE(PG8_SB(0, 1), b2 + hstep, voffB);
            PG8_WAIT_V(6); PG8_BAR; PG8_MMA(1, 1, At, B1); PG8_BAR;
            PG8_LDB(B0, 1, 0); PG8_SCHED; PG8_LDA(At, 1, 0); PG8_STAGE(PG8_SA(0, 1), a2 + hstep, voffA);
            PG8_WAIT_L(8); PG8_BAR; PG8_WAIT_L(0); PG8_MMA(0, 0, At, B0); PG8_BAR; PG8_SCHED;
            PG8_LDB(B1, 1, 1); PG8_STAGE(PG8_SB(1, 0), b3, voffB);
            PG8_BAR; PG8_WAIT_L(0); PG8_MMA(0, 1, At, B1); PG8_BAR;
            PG8_LDA(At, 1, 1); PG8_STAGE(PG8_SA(1, 0), a3, voffA);
            PG8_BAR; PG8_WAIT_L(0); PG8_MMA(1, 0, At, B0); PG8_BAR; PG8_SCHED;
            PG8_STAGE(PG8_SB(1, 1), b3 + hstep, voffB);
            PG8_WAIT_V(6); PG8_BAR; PG8_MMA(1, 1, At, B1); PG8_BAR;
            }
        }
        if constexpr (ALIGN_EPI) { if (wr == 0) PG8_BAR; }
        if constexpr (!Epi::AFTER_DRAIN) { E(acc, cur, wr, wc, fr, fq); S.done(cur); }
        if (!has_next) break;
#pragma unroll
        for (int a = 0; a < 2; ++a)
#pragma unroll
            for (int b = 0; b < 2; ++b)
#pragma unroll
                for (int m = 0; m < 4; ++m)
#pragma unroll
                    for (int n = 0; n < 2; ++n) acc[a][b][m][n] = (f32x4){0.f, 0.f, 0.f, 0.f};
        cur = nxt; cA = nA; cB = nB; ++ui;
        if constexpr (ALIGN_EPI) { if (wr == 1) PG8_BAR; }
    }
    PG8_WAIT_V(0);
    if constexpr (!ALIGN_EPI) { if (wr == 0) PG8_BAR; }
    PG8_BAR;
    if constexpr (Epi::AFTER_DRAIN) { E.fused(acc, cur, wr, wc, fr, fq, lds, wid, lane); S.done(cur); }
#undef PG8_SA
#undef PG8_SB
#undef PG8_STAGE
#undef PG8_LDA
#undef PG8_LDB
#undef PG8_MMA
#undef PG8_WAIT_V
#undef PG8_WAIT_L
#undef PG8_BAR
#undef PG8_SCHED
}
}
constexpr int NB = 8, SEQ = 2048, DM = 1024, MT = NB * SEQ, DFF = 2816, INC = 4888, NWIN = 5120, NUP = 2 * DFF;
constexpr int NWAVES = 8;
typedef unsigned short bf16;
typedef float f32x4 __attribute__((ext_vector_type(4)));
typedef unsigned v4u __attribute__((ext_vector_type(4)));
typedef unsigned v2u __attribute__((ext_vector_type(2)));
#define LAS __attribute__((address_space(3)))
#define GAS __attribute__((address_space(1)))
typedef GAS unsigned gu32;
#define RLX_AGENT __ATOMIC_RELAXED, __HIP_MEMORY_SCOPE_AGENT
#define LDS_WAIT() asm volatile("s_waitcnt lgkmcnt(0)" ::: "memory")
#define VM_WAIT() asm volatile("s_waitcnt vmcnt(0)" ::: "memory")
constexpr size_t MiB = 1u << 20;
constexpr size_t WS_CTL = 0, CTL_ZERO_BYTES = 64 * 1024;
constexpr size_t WS_ROPEC = 1 * MiB, WS_ROPES = 1 * MiB + 256 * 1024;
constexpr size_t WS_ROWSS = 1 * MiB + 512 * 1024;
constexpr size_t WS_KCB = 2 * MiB + 512 * 1024, WS_VCBT = WS_KCB + 256 * 1024;
constexpr size_t WS_CBIAS = 3 * MiB + 512 * 1024;
constexpr size_t WS_W2TK = 3 * MiB + 576 * 1024, WS_W2TV = 3 * MiB + 592 * 1024;
constexpr size_t WS_W1TK = 51 * MiB, WS_W1TV = 51 * MiB + 512 * 1024;
constexpr size_t WS_WUP1 = 4 * MiB, WS_WDN1 = 15 * MiB, WS_WIN = 20 * MiB + 512 * 1024, WS_WPA = 30 * MiB + 512 * 1024  ,
                 WS_WOUT = 32 * MiB + 512 * 1024, WS_WUP2 = 34 * MiB + 512 * 1024, WS_WDN2 = 45 * MiB + 512 * 1024;
constexpr size_t WS_XB = 52 * MiB;
constexpr size_t WS_ARENA = 84 * MiB, ARENA_B = 20 * MiB + 80 * 1024  , ARENA_E = ARENA_B / 2;
constexpr size_t A_QA = 0, A_QB = 2 * MiB, A_KB = 4 * MiB, A_VBT = 6 * MiB, A_KC = 8 * MiB, A_VC = 8 * MiB + 512 * 1024, A_KS = 9 * MiB, A_VST = 9 * MiB + 512 * 1024,
                 A_KW = 10 * MiB, A_VWT = 10 * MiB + 512 * 1024, A_GA = 11 * MiB, A_GB = 15 * MiB, A_GS = 19 * MiB;
constexpr size_t A_H = 0;
constexpr size_t A_MRG = 2 * MiB;
constexpr size_t OUT_BATCH_E = 4 * MiB;
constexpr size_t WS_END = WS_ARENA + 8 * ARENA_B;
constexpr int RING_BYTES = 131072, LDSCTL_OFF = RING_BYTES, MISC_OFF = LDSCTL_OFF + 320, LDS_BYTES = 147456;

enum { PH_CONV = 0, PH_UP1, PH_DN1, PH_WIN, PH_CMP, PH_ATT, PH_MRG, PH_OUT, PH_UP2, PH_DN2, PH_PER_LAYER };
constexpr int PH_NORM = 2 * PH_PER_LAYER, PH_TOTAL = PH_NORM + 1;

struct Args { const float* in[21]; float* out; unsigned char* ws; int ph_lo, ph_hi; };
static_assert(sizeof(Args) == 21 * 8 + 8 + 8 + 8, "no padding in Args");
enum { I_X = 0, I_F1N, I_F1G, I_F1U, I_F1D, I_MIXN, I_WIN, I_CKP, I_CKW1, I_CKW2, I_CVP, I_CVW1, I_CVW2, I_WBA, I_WBB, I_WOUT, I_F2N, I_F2G, I_F2U, I_F2D, I_FINN };

struct Frame {
    LAS unsigned char* lds; gu32* ctl; unsigned char* ws;
    int tid, lane, wave, G, bx, wave_s;
};
__device__ __forceinline__ int fresh_tid(int wave_s) { unsigned z = 0u; asm volatile("" : "+s"(z)); int t = wave_s * 64 + (int)__builtin_amdgcn_mbcnt_hi(~0u, __builtin_amdgcn_mbcnt_lo(~0u, z)); asm volatile("" : "+v"(t)); return t; }
__device__ __forceinline__ void frame_refresh(Frame& F) { asm volatile("" : "+v"(F.tid)); F.lane = F.tid & 63; F.wave = __builtin_amdgcn_readfirstlane(F.tid >> 6); }
__device__ __forceinline__ float wave_sum(float v) {
#pragma unroll
    for (int o = 1; o < 64; o <<= 1) v += __shfl_xor(v, o);
    return v;
}
__device__ __forceinline__ unsigned f2bf(float f) { unsigned u = __builtin_bit_cast(unsigned, f); return (u + 0x7fffu + ((u >> 16) & 1u)) >> 16; }
__device__ __forceinline__ unsigned pk2(float lo, float hi) { return f2bf(lo) | (f2bf(hi) << 16); }
__device__ __forceinline__ float bf2f(bf16 h) { return __uint_as_float((unsigned)h << 16); }
__host__ __device__ __forceinline__ int perm32i(int rho) { const int n = rho >> 4, i = rho & 15; return 8 * (i >> 2) + 4 * n + (i & 3); }

enum { CV_UP = 0, CV_NAT = 1, CV_WIN = 2, CV_P32 = 3 };
__device__ __forceinline__ int win_src_col(int rho) {
    const int half = rho >> 7, p = rho & 127;
    const int hh = p >> 6, q = p & 63, dim = 16 * (q >> 5) + (q & 15) + 32 * ((q >> 4) & 1);
    const int rp = 64 * hh + dim, pp = (p & ~31) + perm32i(p & 31);
    if (half < 4) return 128 * half + rp;
    if (half == 4) return 536 + p;
    if (half == 5) return 664 + p;
    if (half == 6) return 792 + rp;
    if (half == 7) return 920 + p;
    if (half == 8) return 1048 + rp;
    if (half == 9) return 1176 + p;
    if (half < 14) return 1304 + 128 * (half - 10) + rp;
    if (half < 18) return 1816 + 128 * (half - 14) + rp;
    if (half < 22) return 2328 + 128 * (half - 18) + p;
    if (half < 30) return 2840 + 128 * (half - 22) + pp;
    if (half < 38) return 3864 + 128 * (half - 30) + pp;
    if (half == 38) return p < 24 ? 512 + p : -1;
    return -1;
}
struct ConvJob { const float* W0; const float* W1; const float* gain; bf16* dst; int K, Nsrc, Ndst, kind, items, dpitch, koff; };
__device__ __forceinline__ int win_block_col(int r0, int& nvalid) {
    const int half = r0 >> 7, p0 = r0 & 127; nvalid = 64;
    if (half < 4) return 128 * half + p0;
    if (half == 4) return 536 + p0;
    if (half == 5) return 664 + p0;
    if (half == 6) return 792 + p0;
    if (half == 7) return 920 + p0;
    if (half == 8) return 1048 + p0;
    if (half == 9) return 1176 + p0;
    if (half < 14) return 1304 + 128 * (half - 10) + p0;
    if (half < 18) return 1816 + 128 * (half - 14) + p0;
    if (half < 22) return 2328 + 128 * (half - 18) + p0;
    if (half < 30) return 2840 + 128 * (half - 22) + p0;
    if (half < 38) return 3864 + 128 * (half - 30) + p0;
    if (half == 38 && p0 == 0) { nvalid = 24; return 512; }
    nvalid = 0; return 0;
}
struct ConvRegs { f32x4 v[16]; f32x4 g0, g1; };
__device__ __forceinline__ int conv_swz(int k) { return ((k & 7) ^ (k >> 3)) & 7; }
__device__ __forceinline__ void conv_item(const ConvJob& J, int item, int& kb, int& rb) {
    const int nrb = J.Ndst / 64;
    if ((nrb & 3) == 0 && ((J.K / 64) & 1) == 0) { const int blk = item >> 3, q = nrb >> 2; rb = 4 * (blk % q) + (item & 3); kb = 2 * (blk / q) + ((item >> 2) & 1); }
    else { kb = item / nrb; rb = item % nrb; }
}
__device__ __forceinline__ void conv_load(const ConvJob& J, int item, int lane, ConvRegs& R) {
    int kb, rb; conv_item(J, item, kb, rb); const int k0 = 64 * kb, r0 = 64 * rb;
    const float* W = J.W0; int c0, nvalid = 64;
    if (J.kind == CV_UP) { const int pn = r0 >> 8, bj = (r0 >> 7) & 1; c0 = 128 * pn + (r0 & 127); if (bj) W = J.W1; }
    else if (J.kind == CV_WIN) c0 = win_block_col(r0, nvalid);
    else c0 = r0;
    const int kr = lane >> 4, c4 = lane & 15;
#pragma unroll
    for (int i = 0; i < 16; ++i) R.v[i] = (f32x4){0.f, 0.f, 0.f, 0.f};
    R.g0 = (f32x4){1.f, 1.f, 1.f, 1.f}; R.g1 = R.g0;
    if (J.gain) { const GAS f32x4* gp = (const GAS f32x4*)(J.gain + k0 + 8 * (lane & 7)); R.g0 = gp[0]; R.g1 = gp[1]; }
    if (4 * c4 < nvalid) {
#pragma unroll
        for (int i = 0; i < 16; ++i) R.v[i] = __builtin_nontemporal_load((const GAS f32x4*)(W + (size_t)(k0 + 4 * i + kr) * J.Nsrc + c0 + 4 * c4));
    }
}
__device__ __forceinline__ void conv_emit(const ConvJob& J, int item, LAS float* scr, int lane, const ConvRegs& R) {
    int kb, rb; conv_item(J, item, kb, rb); const int k0 = 64 * kb, r0 = 64 * rb;
    int c0 = r0, nvalid = 64;
    if (J.kind == CV_UP) c0 = 128 * (r0 >> 8) + (r0 & 127);
    else if (J.kind == CV_WIN) c0 = win_block_col(r0, nvalid);
    const int kr = lane >> 4, c4 = lane & 15;
#pragma unroll
    for (int i = 0; i < 16; ++i) { const int k = 4 * i + kr;
        *(LAS f32x4*)(scr + k * 64 + 4 * (c4 ^ conv_swz(k))) = R.v[i]; }
    LDS_WAIT(); asm volatile("" ::: "memory");
}
__device__ __forceinline__ void conv_emit_b(const ConvJob& J, int item, LAS float* scr, int lane, const ConvRegs& R) {
    int kb, rb; conv_item(J, item, kb, rb); const int k0 = 64 * kb, r0 = 64 * rb;
    int c0 = r0, nvalid = 64;
    if (J.kind == CV_UP) c0 = 128 * (r0 >> 8) + (r0 & 127);
    else if (J.kind == CV_WIN) c0 = win_block_col(r0, nvalid);
#pragma unroll
    for (int e = 0; e < 8; ++e) { const int id = lane + 64 * e, n = id >> 3, c = id & 7, rho = r0 + n; int sc;
        if (J.kind == CV_UP) { const int p = rho & 127; sc = ((p & ~31) + perm32i(p & 31)) - (r0 & 127); }
        else if (J.kind == CV_NAT) sc = n;
        else if (J.kind == CV_P32) sc = ((rho & ~31) + perm32i(rho & 31)) - r0;
        else { const int col = win_src_col(rho); sc = col >= 0 ? col - c0 : -1; }
        v4u o = {0u, 0u, 0u, 0u};
        if (sc >= 0) { float f[8];
#pragma unroll
            for (int i = 0; i < 8; ++i) { const int k = 8 * c + i; f[i] = scr[k * 64 + 4 * ((sc >> 2) ^ conv_swz(k)) + (sc & 3)] * (i < 4 ? R.g0[i & 3] : R.g1[i & 3]); }
            o.x = pk2(f[0], f[1]); o.y = pk2(f[2], f[3]); o.z = pk2(f[4], f[5]); o.w = pk2(f[6], f[7]); }
        *(GAS v4u*)(J.dst + (size_t)rho * J.dpitch + J.koff + k0 + 8 * c) = o; }
    LDS_WAIT(); asm volatile("" ::: "memory");
}
__device__ __forceinline__ unsigned topk16_mask(const float (&v)[32]) { unsigned msk = 0;
#pragma unroll
    for (int j = 0; j < 32; ++j) { int rank = 0;
#pragma unroll
        for (int i = 0; i < 32; ++i) rank += (v[i] > v[j] || (v[i] == v[j] && i < j)) ? 1 : 0;
        if (rank < 16) msk |= (1u << j); }
    return msk; }
#define XB_TMO      128
#define XB_XCNT(j)  (256  + 64 * (j))
#define XB_XSUB(j)  (1280 + 64 * (j))
#define XB_XGEN(j)  (2304 + 64 * (j))
#define XB_TOP      3328
#define XB_TOPGEN   3392
#define XCD_BAR_WORDS 3456
#define XB_LSUB(j)  (3584 + 64 * (j))
#define XB_LGEN(j)  (4608 + 64 * (j))
#define XB_XTAB     5632
#define XB_TSUB(t)  (6400 + 32 * (t))
#define XB_TGEN(t)  (6416 + 32 * (t))
#define XB_SPIN_CAP (1u << 18)

__device__ __forceinline__ unsigned xb_ld(unsigned* p)              { return __hip_atomic_load(p, __ATOMIC_RELAXED, __HIP_MEMORY_SCOPE_AGENT); }
__device__ __forceinline__ unsigned xb_add(unsigned* p, unsigned v) { return __hip_atomic_fetch_add(p, v, __ATOMIC_RELAXED, __HIP_MEMORY_SCOPE_AGENT); }
__device__ __forceinline__ unsigned xb_xcc_id() { return (unsigned)__builtin_amdgcn_s_getreg((3 << 11) | 20) & 0xFu; }
#define XB_SPIN(cond, bar) do { unsigned _sp = 0; while (cond) { __builtin_amdgcn_s_sleep(1); \
    if ((++_sp & 255u) == 0u) { if (xb_ld(&(bar)[XB_TMO])) break; if (_sp > XB_SPIN_CAP) { atomicAdd(&(bar)[XB_TMO], 1u); break; } } } } while (0)

struct XcdBarrier {
    unsigned* bar; unsigned x;
    volatile LAS unsigned* st;
};

__device__ __forceinline__ XcdBarrier xcd_barrier_post(unsigned* bar, volatile LAS unsigned* st) {
    XcdBarrier b; b.bar = bar; b.x = xb_xcc_id(); b.st = st;
    if (threadIdx.x == 0) { (void)xb_add(&bar[XB_XCNT(b.x)], 1u); __hip_atomic_store(&bar[XB_XTAB + blockIdx.x], b.x + 1u, __ATOMIC_RELAXED, __HIP_MEMORY_SCOPE_AGENT); }
    return b;
}
__device__ __forceinline__ void xcd_barrier_complete(unsigned* bar, unsigned x, unsigned& nloc, unsigned& nx) {
    const unsigned G = gridDim.x * gridDim.y * gridDim.z;
    unsigned sum, cnt, mine, sp = 0u;
    for (;;) {
        sum = 0u; cnt = 0u; mine = 0u;
#pragma unroll
        for (unsigned j = 0; j < 16; ++j) { const unsigned c = xb_ld(&bar[XB_XCNT(j)]); sum += c; cnt += (c > 0u) ? 1u : 0u; mine = (j == x) ? c : mine; }
        if (sum == G) break;
        __builtin_amdgcn_s_sleep(1);
        if ((++sp & 255u) == 0u) { if (xb_ld(&bar[XB_TMO])) break; if (sp > XB_SPIN_CAP) { atomicAdd(&bar[XB_TMO], 1u); break; } }
    }
    nloc = mine > 0u ? mine : 1u; nx = cnt > 0u ? cnt : 1u;
}

__device__ __forceinline__ void xcd_barrier(const XcdBarrier& b, const bool leader, const bool release_l2 = true) {
    asm volatile("s_waitcnt vmcnt(0)" ::: "memory");
    __syncthreads();
    if (leader) {
        unsigned* bar = b.bar;
        __builtin_amdgcn_s_waitcnt(0);
        unsigned nloc = b.st[0], nx = b.st[1];
        if (nloc == 0u) { xcd_barrier_complete(bar, b.x, nloc, nx); b.st[0] = nloc; b.st[1] = nx; }
        const unsigned old = xb_add(&bar[XB_XSUB(b.x)], 1u);
        const unsigned gen = old / nloc;
        if (old + 1u == (gen + 1u) * nloc) {
            if (release_l2) __builtin_amdgcn_fence(__ATOMIC_RELEASE, "agent");
            asm volatile("s_waitcnt vmcnt(0)" ::: "memory");
            const unsigned og = xb_add(&bar[XB_TOP], 1u);
            const unsigned tg = og / nx;
            if (og + 1u == (tg + 1u) * nx) xb_add(&bar[XB_TOPGEN], 1u);
            else XB_SPIN(xb_ld(&bar[XB_TOPGEN]) == tg, bar);
            __builtin_amdgcn_fence(__ATOMIC_ACQUIRE, "agent");
            xb_add(&bar[XB_XGEN(b.x)], 1u);
            asm volatile("s_waitcnt vmcnt(0)" ::: "memory");
        } else {
            XB_SPIN(xb_ld(&bar[XB_XGEN(b.x)]) == gen, bar);
            __builtin_amdgcn_fence(__ATOMIC_ACQUIRE, "agent");
            asm volatile("s_waitcnt vmcnt(0)" ::: "memory");
        }
    }
    __syncthreads();
}

__device__ __forceinline__ void group_barrier(const XcdBarrier& b, const bool leader, const unsigned grp, const unsigned nloc) {
    asm volatile("s_waitcnt vmcnt(0)" ::: "memory");
    __syncthreads();
    if (leader) {
        unsigned* bar = b.bar;
        __builtin_amdgcn_s_waitcnt(0);
        asm volatile("buffer_inv sc1" ::: "memory");
        const unsigned old = xb_add(&bar[XB_LSUB(grp)], 1u);
        const unsigned gen = old / nloc;
        if (old + 1u == (gen + 1u) * nloc) xb_add(&bar[XB_LGEN(grp)], 1u);
        else XB_SPIN(xb_ld(&bar[XB_LGEN(grp)]) == gen, bar);
        asm volatile("s_waitcnt vmcnt(0)" ::: "memory");
    }
    __syncthreads();
}
__device__ __forceinline__ void team_barrier(const XcdBarrier& b, const bool leader, const unsigned team) {
    asm volatile("s_waitcnt vmcnt(0)" ::: "memory");
    __syncthreads();
    if (leader) {
        unsigned* bar = b.bar;
        __builtin_amdgcn_s_waitcnt(0);
        asm volatile("buffer_inv sc1" ::: "memory");
        const unsigned old = xb_add(&bar[XB_TSUB(team)], 1u);
        const unsigned gen = old >> 2;
        if ((old & 3u) == 3u) xb_add(&bar[XB_TGEN(team)], 1u);
        else XB_SPIN(xb_ld(&bar[XB_TGEN(team)]) == gen, bar);
        asm volatile("s_waitcnt vmcnt(0)" ::: "memory");
    }
    __syncthreads();
}
__device__ __forceinline__ bool colocal_check(const XcdBarrier& b, volatile LAS unsigned* flag, int tid) {
    if (tid < 64) {
        bool ok = (gridDim.x == 256u);
        if (ok) {
#pragma unroll
            for (int r = 0; r < 4; ++r) { const unsigned t = (unsigned)tid + 64u * r; const unsigned v = xb_ld(&b.bar[XB_XTAB + t]), rep = xb_ld(&b.bar[XB_XTAB + (t & 7u)]); ok = ok && (v != 0u) && (v == rep); }
            if (tid < 8) { const unsigned mine = xb_ld(&b.bar[XB_XTAB + tid]);
#pragma unroll
                for (int u = 0; u < 8; ++u) { const unsigned o = xb_ld(&b.bar[XB_XTAB + u]); if (u != tid && o == mine) ok = false; } }
        }
        const bool all = (__ballot(ok) == ~0ull);
        if (tid == 0) flag[0] = all ? 1u : 2u;
    }
    __syncthreads();
    return flag[0] == 1u;
}
__device__ __forceinline__ void phase_conv(Frame& F, const Args& A, int l) {
    frame_refresh(F);
    LAS float* scr = (LAS float*)(F.lds + F.wave * 16384);
    const int gw = F.bx * NWAVES + F.wave, NGW = F.G * NWAVES;
    unsigned char* ws = F.ws;
    const size_t LU = (size_t)DM * DFF, LW = (size_t)DM * INC, LB = (size_t)512 * DM, LO = (size_t)DM * DM;
    auto job = [&](int j) -> ConvJob {
        switch (j) {
        case 0: return ConvJob{A.in[I_F1G] + l * LU, A.in[I_F1U] + l * LU, A.in[I_F1N] + l * DM, (bf16*)(ws + WS_WUP1), DM, DFF, NUP, CV_UP, (DM / 64) * (NUP / 64), DM, 0};
        case 1: return ConvJob{A.in[I_F1D] + l * LU, nullptr, nullptr, (bf16*)(ws + WS_WDN1), DFF, DM, DM, CV_NAT, (DFF / 64) * (DM / 64), DFF, 0};
        case 2: return ConvJob{A.in[I_WIN] + l * LW, nullptr, A.in[I_MIXN] + l * DM, (bf16*)(ws + WS_WIN), DM, INC, NWIN, CV_WIN, (DM / 64) * (NWIN / 64), DM, 0};
        case 3: return ConvJob{A.in[I_WBA] + l * LB, nullptr, nullptr, (bf16*)(ws + WS_WPA), 512, DM, DM, CV_P32, (512 / 64) * (DM / 64), 1024, 0};
        case 4: return ConvJob{A.in[I_WBB] + l * LB, nullptr, nullptr, (bf16*)(ws + WS_WPA), 512, DM, DM, CV_P32, (512 / 64) * (DM / 64), 1024, 512};
        case 5: return ConvJob{A.in[I_WOUT] + l * LO, nullptr, nullptr, (bf16*)(ws + WS_WOUT), DM, DM, DM, CV_NAT, (DM / 64) * (DM / 64), DM, 0};
        case 6: return ConvJob{A.in[I_F2G] + l * LU, A.in[I_F2U] + l * LU, A.in[I_F2N] + l * DM, (bf16*)(ws + WS_WUP2), DM, DFF, NUP, CV_UP, (DM / 64) * (NUP / 64), DM, 0};
        case 7: return ConvJob{A.in[I_F2D] + l * LU, nullptr, nullptr, (bf16*)(ws + WS_WDN2), DFF, DM, DM, CV_NAT, (DFF / 64) * (DM / 64), DFF, 0};
        case 8: return ConvJob{A.in[I_CKW1] + (size_t)l * 2048 * 128, nullptr, nullptr, (bf16*)(ws + WS_W1TK), 2048, 128, 128, CV_NAT, (2048 / 64) * (128 / 64), 2048, 0};
        case 9: return ConvJob{A.in[I_CVW1] + (size_t)l * 2048 * 128, nullptr, nullptr, (bf16*)(ws + WS_W1TV), 2048, 128, 128, CV_NAT, (2048 / 64) * (128 / 64), 2048, 0};
        case 10: return ConvJob{A.in[I_CKW2] + (size_t)l * 128 * 64, nullptr, nullptr, (bf16*)(ws + WS_W2TK), 128, 64, 64, CV_NAT, 2, 128, 0};
        default: return ConvJob{A.in[I_CVW2] + (size_t)l * 128 * 64, nullptr, nullptr, (bf16*)(ws + WS_W2TV), 128, 64, 64, CV_NAT, 2, 128, 0};
        }
    };
    constexpr int NI[12] = {(DM / 64) * (NUP / 64), (DFF / 64) * (DM / 64), (DM / 64) * (NWIN / 64), (512 / 64) * (DM / 64), (512 / 64) * (DM / 64), (DM / 64) * (DM / 64), (DM / 64) * (NUP / 64), (DFF / 64) * (DM / 64), 64, 64, 2, 2};
    int total = 0;
#pragma unroll
    for (int j = 0; j < 12; ++j) total += NI[j];
    auto locate = [&](int it, int& jj, int& r) { r = it; jj = 11;
#pragma unroll
        for (int j = 0; j < 12; ++j) { if (jj == 11 && j < 11 && r < NI[j]) jj = j; else if (jj == 11 && j < 11) r -= NI[j]; } };
    int it = gw; bool have = it < total; ConvRegs cur; int jc = 0, rc = 0;
    if (have) { locate(it, jc, rc); const ConvJob Jc = job(jc); conv_load(Jc, rc, F.lane, cur); }
    while (have) {
        const int nit = it + NGW; const bool hn = nit < total; ConvRegs nxt; int jn = 0, rn = 0;
        { const ConvJob Jc = job(jc); conv_emit(Jc, rc, scr, F.lane, cur); }
        __builtin_amdgcn_sched_barrier(0);
        if (hn) { locate(nit, jn, rn); const ConvJob Jn = job(jn); conv_load(Jn, rn, F.lane, nxt); }
        __builtin_amdgcn_sched_barrier(0);
        { const ConvJob Jc = job(jc); conv_emit_b(Jc, rc, scr, F.lane, cur); }
        it = nit; have = hn; jc = jn; rc = rn;
        if (hn) cur = nxt;
    }
    if (F.wave == 0) for (int o = F.bx; o < 256; o += F.G) {
        const int kv = o >> 7, n = o & 127; const float* w1 = A.in[kv ? I_CVW1 : I_CKW1] + (size_t)l * 2048 * 128; const float* pos = A.in[kv ? I_CVP : I_CKP] + (size_t)l * 2048; float sacc = 0.f;
        {
            float pv[32], wv[32];
#pragma unroll
            for (int i = 0; i < 32; ++i) { const int k = F.lane + 64 * i; pv[i] = ((const GAS float*)pos)[k]; wv[i] = ((const GAS float*)w1)[(size_t)k * 128 + n]; }
            __builtin_amdgcn_sched_barrier(0);
#pragma unroll
            for (int i = 0; i < 32; ++i) sacc += pv[i] * wv[i];
        }
        sacc = wave_sum(sacc); if (F.lane == 0) ((float*)(ws + WS_CBIAS))[o] = sacc;
    }
    if (l == 0) {
        const float* x = A.in[I_X]; bf16* XB = (bf16*)(ws + WS_XB); float* rowss = (float*)(ws + WS_ROWSS);
        for (int m0 = 4 * gw; m0 < MT; m0 += 8 * NGW) {
            f32x4 v[2][4][4];
#pragma unroll
            for (int h = 0; h < 2; ++h) { const int mh = m0 + h * 4 * NGW;
                if (mh < MT) {
#pragma unroll
                    for (int rr = 0; rr < 4; ++rr) { const GAS f32x4* xr = (const GAS f32x4*)(x + (size_t)(mh + rr) * DM) + F.lane;
#pragma unroll
                        for (int j = 0; j < 4; ++j) v[h][rr][j] = __builtin_nontemporal_load(xr + 64 * j); } } }
            __builtin_amdgcn_sched_barrier(0);
#pragma unroll
            for (int h = 0; h < 2; ++h) { const int mh = m0 + h * 4 * NGW;
                if (mh < MT) {
#pragma unroll
                    for (int rr = 0; rr < 4; ++rr) { const int m = mh + rr; float s = 0.f;
#pragma unroll
                        for (int j = 0; j < 4; ++j) s += (v[h][rr][j][0] * v[h][rr][j][0] + v[h][rr][j][1] * v[h][rr][j][1]) + (v[h][rr][j][2] * v[h][rr][j][2] + v[h][rr][j][3] * v[h][rr][j][3]);
                        s = wave_sum(s);
                        GAS v2u* o8 = (GAS v2u*)(XB + (size_t)m * DM) + F.lane;
#pragma unroll
                        for (int j = 0; j < 4; ++j) { v2u w; w.x = pk2(v[h][rr][j][0], v[h][rr][j][1]); w.y = pk2(v[h][rr][j][2], v[h][rr][j][3]); o8[64 * j] = w; }
                        if (F.lane < 4) rowss[(size_t)m * 4 + F.lane] = F.lane == 0 ? s : 0.f; } } }
        }
        float* rc = (float*)(ws + WS_ROPEC); float* rsn = (float*)(ws + WS_ROPES);
        for (int e = F.bx * 512 + F.tid; e < SEQ * 32; e += F.G * 512) { const int t = e >> 5, d = e & 31;
            const float inv = __builtin_amdgcn_exp2f(-(float)d * 0.41524101186092029f);
            const float ang = (float)t * inv;
            const float rev = ang * 0.15915494309189535f; const float fr = rev - __builtin_rintf(rev);
            rc[e] = __builtin_amdgcn_cosf(fr); rsn[e] = __builtin_amdgcn_sinf(fr); }
    }
}
__device__ __forceinline__ float gelu_tanh(float v) { const float u = 0.7978845608028654f * (v + 0.044715f * v * v * v); const float e = __builtin_amdgcn_exp2f(-2.8853900817779268f * u); return v * __builtin_amdgcn_rcpf(1.0f + e); }
__device__ __forceinline__ void phase_norm(Frame& F, const Args& A) {
    frame_refresh(F);
    const int vcu = (F.G % 8 == 0) ? (F.bx % 8) * (F.G / 8) + F.bx / 8 : F.bx; const float* g = A.in[I_FINN]; const bf16* XB = (const bf16*)(F.ws + WS_XB); const float* rowss = (const float*)(F.ws + WS_ROWSS);
    f32x4 gg[4];
#pragma unroll
    for (int j = 0; j < 4; ++j) gg[j] = *((const GAS f32x4*)g + F.lane + 64 * j);
    for (int v = vcu; v < 256; v += F.G) {
        v2u w[8][4]; f32x4 ss[8];
#pragma unroll
        for (int r = 0; r < 8; ++r) { const int m = 2048 * (v >> 5) + 8 * (v & 31) + F.wave + 256 * r; const GAS v2u* xb = (const GAS v2u*)(XB + (size_t)m * DM) + F.lane;
#pragma unroll
            for (int j = 0; j < 4; ++j) w[r][j] = xb[64 * j];
            ss[r] = *(const GAS f32x4*)(rowss + (size_t)m * 4); }
        __builtin_amdgcn_sched_barrier(0);
#pragma unroll
        for (int r = 0; r < 8; ++r) { const int m = 2048 * (v >> 5) + 8 * (v & 31) + F.wave + 256 * r; GAS f32x4* xr = (GAS f32x4*)(A.out + (size_t)m * DM) + F.lane;
            const float rs = __builtin_amdgcn_rsqf(((ss[r][0] + ss[r][1]) + (ss[r][2] + ss[r][3])) * (1.0f / 1024.0f) + 1e-6f);
#pragma unroll
            for (int j = 0; j < 4; ++j) { f32x4 x; x[0] = __uint_as_float(w[r][j].x << 16); x[1] = __uint_as_float(w[r][j].x & 0xffff0000u); x[2] = __uint_as_float(w[r][j].y << 16); x[3] = __uint_as_float(w[r][j].y & 0xffff0000u);
                xr[64 * j] = x * rs * gg[j]; } }
    }
}
namespace fa {
typedef short bf16x8 __attribute__((ext_vector_type(8)));
typedef short s16x4 __attribute__((ext_vector_type(4)));
typedef float f32x16 __attribute__((ext_vector_type(16)));
typedef float f32x2_t __attribute__((ext_vector_type(2))); typedef __bf16 bf16x2_t __attribute__((ext_vector_type(2)));
#define FA_MFMA(a, b, c) __builtin_amdgcn_mfma_f32_32x32x16_bf16((a), (b), (c), 0, 0, 0)
constexpr float FA_THR = 6.0f, FA_NINF = -INFINITY;
__device__ __forceinline__ int crow(int r, int h) { return (r & 3) + 8 * (r >> 2) + 4 * h; }
__device__ __forceinline__ float opaque_inf() { float v = __builtin_inff(); asm volatile("" : "+s"(v)); return v; }
#define mx2(a, b) __builtin_amdgcn_fmed3f((a), (b), pinf_)
__device__ __forceinline__ unsigned cvtpk(float lo, float hi) { f32x2_t v = {lo, hi}; bf16x2_t b = __builtin_convertvector(v, bf16x2_t); return __builtin_bit_cast(unsigned, b); }
__device__ __forceinline__ float swap_max(float x) { auto rr = __builtin_amdgcn_permlane32_swap(__float_as_uint(x), __float_as_uint(x), false, false); return fmaxf(__uint_as_float(rr[0]), __uint_as_float(rr[1])); }
__device__ __forceinline__ float swap_sum(float x) { auto rr = __builtin_amdgcn_permlane32_swap(__float_as_uint(x), __float_as_uint(x), false, false); return __uint_as_float(rr[0]) + __uint_as_float(rr[1]); }
__device__ __forceinline__ float swap_other(float x, int hi) { auto rr = __builtin_amdgcn_permlane32_swap(__float_as_uint(x), __float_as_uint(x), false, false); return hi ? __uint_as_float(rr[0]) : __uint_as_float(rr[1]); }
__device__ __forceinline__ bf16x8 pack8(const f32x16& p, int s) { v4u w; w.x = cvtpk(p[8 * s], p[8 * s + 1]); w.y = cvtpk(p[8 * s + 2], p[8 * s + 3]); w.z = cvtpk(p[8 * s + 4], p[8 * s + 5]); w.w = cvtpk(p[8 * s + 6], p[8 * s + 7]); return __builtin_bit_cast(bf16x8, w); }
__device__ __forceinline__ bf16x8 vfrag(const bf16* p) { const s16x4 a = *(const GAS s16x4*)p, b = *(const GAS s16x4*)(p + 8); return (bf16x8){a[0], a[1], a[2], a[3], b[0], b[1], b[2], b[3]}; }
struct Qf { bf16x8 f[4]; };
__device__ __forceinline__ void load_rows(Qf& q, const bf16* rowp  ) {
#pragma unroll
    for (int s = 0; s < 4; ++s) q.f[s] = *(const GAS bf16x8*)(rowp + 16 * s);
}
__device__ __forceinline__ f32x16 qk_tile(const bf16* kbase, const Qf& q, const f32x16& c0, int r32, int hi) {
    Qf k; load_rows(k, kbase + r32 * 64 + hi * 8);
    f32x16 S = FA_MFMA(k.f[0], q.f[0], c0); S = FA_MFMA(k.f[1], q.f[1], S); S = FA_MFMA(k.f[2], q.f[2], S); S = FA_MFMA(k.f[3], q.f[3], S); return S;
}
__device__ __forceinline__ void pv_tile(f32x16& o0, f32x16& o1, const bf16* vbase, int vs, const f32x16& P, int r32, int hi) {
    const bf16* v0 = vbase + (size_t)r32 * vs + 4 * hi; const bf16* v1 = v0 + (size_t)32 * vs;
    const bf16x8 a00 = vfrag(v0), a01 = vfrag(v0 + 16), a10 = vfrag(v1), a11 = vfrag(v1 + 16);
    const bf16x8 p0 = pack8(P, 0), p1 = pack8(P, 1);
    o0 = FA_MFMA(a00, p0, o0); o0 = FA_MFMA(a01, p1, o0); o1 = FA_MFMA(a10, p0, o1); o1 = FA_MFMA(a11, p1, o1);
}
struct Acc { f32x16 o0, o1, negm; float m, l; bool seen; };
__device__ __forceinline__ void acc_reset(Acc& a) {
#pragma unroll
    for (int r = 0; r < 16; ++r) { a.o0[r] = 0.f; a.o1[r] = 0.f; a.negm[r] = 0.f; }
    a.m = 0.f; a.l = 0.f; a.seen = false;
}
__device__ __forceinline__ void step32(Acc& a, const Qf& q, const bf16* kbase, const bf16* vbase, int vs, int r32, int hi, bool needmask, int lo, int up, bool rowon) {
    f32x16 S = qk_tile(kbase, q, a.negm, r32, hi);
    if (needmask) {
#pragma unroll
        for (int r = 0; r < 16; ++r) { const int c = crow(r, hi); S[r] = (rowon && c >= lo && c <= up) ? S[r] : FA_NINF; }
    }
    float rm = fmaxf(fmaxf(fmaxf(S[0], S[1]), fmaxf(S[2], S[3])), fmaxf(fmaxf(S[4], S[5]), fmaxf(S[6], S[7])));
    rm = fmaxf(rm, fmaxf(fmaxf(fmaxf(S[8], S[9]), fmaxf(S[10], S[11])), fmaxf(fmaxf(S[12], S[13]), fmaxf(S[14], S[15]))));
    rm = swap_max(rm);
    const bool big = rm > (a.seen ? FA_THR : -3.0e38f);
    if (__any(big)) { const float dl = big ? rm : 0.f; a.m += dl; const float f = __builtin_amdgcn_exp2f(-dl); a.l *= f;
#pragma unroll
        for (int r = 0; r < 16; ++r) { a.o0[r] *= f; a.o1[r] *= f; S[r] -= dl; a.negm[r] = -a.m; } }
    a.seen = a.seen || (rm > -3.0e38f);
    float ps = 0.f;
#pragma unroll
    for (int r = 0; r < 16; ++r) { S[r] = __builtin_amdgcn_exp2f(S[r]); ps += S[r]; }
    a.l += ps;
    pv_tile(a.o0, a.o1, vbase, vs, S, r32, hi);
}
__device__ __forceinline__ void acc_finish(const Acc& a, f32x16& t0, f32x16& t1, float gate) {
    const float l = swap_sum(a.l); const float sc = l > 0.f ? gate * __builtin_amdgcn_rcpf(l) : 0.f;
#pragma unroll
    for (int r = 0; r < 16; ++r) { t0[r] += a.o0[r] * sc; t1[r] += a.o1[r] * sc; }
}
constexpr int L_TILE = 49152, TILE_BYTES = 16384;
struct TileRegs { v4u k, v; };
__device__ __forceinline__ void tile_issue(TileRegs& t, const bf16* kp  , const bf16* vp  , int tid) {
    t.k = *(const GAS v4u*)(kp + tid * 8); t.v = *(const GAS v4u*)(vp + (size_t)(tid >> 3) * SEQ + (tid & 7) * 8);
}
__device__ __forceinline__ void tile_commit(LAS unsigned char* buf, const TileRegs& t, int tid) {
    const int row = tid >> 3, pc = tid & 7;
    *(LAS v4u*)(buf + row * 128 + ((pc ^ ((row >> 1) & 7)) << 4)) = t.k;
    const int x = (row >> 1) & 7, g = pc >> 1, od = pc & 1; v2u lo, hi2; lo.x = t.v.x; lo.y = t.v.y; hi2.x = t.v.z; hi2.y = t.v.w;
    LAS unsigned char* vr = buf + 8192 + row * 128;
    *(LAS v2u*)(vr + (((2 * g) ^ x) << 4) + 8 * od) = lo; *(LAS v2u*)(vr + (((2 * g + 1) ^ x) << 4) + 8 * od) = hi2;
}
__device__ __forceinline__ bf16x8 lds_vfrag(const LAS unsigned char* vrow  , int c16, int x) { return *(const LAS bf16x8*)(vrow + ((c16 ^ x) << 4)); }
__device__ __forceinline__ void step32l(Acc& a, const Qf& q, const LAS unsigned char* buf, int kt, int r32, int hi, bool needmask, int lo, int up, bool rowon) {
    const float pinf_ = opaque_inf();
    const int key = 32 * kt + r32; const LAS unsigned char* kr = buf + key * 128; const int kx = (key >> 1) & 7;
    const bf16x8 k0 = *(const LAS bf16x8*)(kr + (((0 + hi) ^ kx) << 4)), k1 = *(const LAS bf16x8*)(kr + (((2 + hi) ^ kx) << 4)), k2 = *(const LAS bf16x8*)(kr + (((4 + hi) ^ kx) << 4)), k3 = *(const LAS bf16x8*)(kr + (((6 + hi) ^ kx) << 4));
    f32x16 S = FA_MFMA(k0, q.f[0], a.negm); S = FA_MFMA(k1, q.f[1], S); S = FA_MFMA(k2, q.f[2], S); S = FA_MFMA(k3, q.f[3], S);
    const LAS unsigned char* v0 = buf + 8192 + r32 * 128; const LAS unsigned char* v1 = v0 + 32 * 128; const int x0 = (r32 >> 1) & 7;
    const bf16x8 a00 = lds_vfrag(v0, 4 * kt + hi, x0), a01 = lds_vfrag(v0, 4 * kt + 2 + hi, x0), a10 = lds_vfrag(v1, 4 * kt + hi, x0), a11 = lds_vfrag(v1, 4 * kt + 2 + hi, x0);
    if (needmask) {
#pragma unroll
        for (int r = 0; r < 16; ++r) { const int c = crow(r, hi); S[r] = (rowon && c >= lo && c <= up) ? S[r] : FA_NINF; }
    }
    float rm = mx2(mx2(mx2(S[0], S[1]), mx2(S[2], S[3])), mx2(mx2(S[4], S[5]), mx2(S[6], S[7])));
    rm = mx2(rm, mx2(mx2(mx2(S[8], S[9]), mx2(S[10], S[11])), mx2(mx2(S[12], S[13]), mx2(S[14], S[15]))));
    rm = swap_max(rm);
    const bool big = rm > (a.seen ? FA_THR : -3.0e38f);
    if (__any(big)) { const float dl = big ? rm : 0.f; a.m += dl; const float f = __builtin_amdgcn_exp2f(-dl); a.l *= f;
#pragma unroll
        for (int r = 0; r < 16; ++r) { a.o0[r] *= f; a.o1[r] *= f; S[r] -= dl; a.negm[r] = -a.m; } }
    a.seen = a.seen || (rm > -3.0e38f);
    float ps = 0.f;
#pragma unroll
    for (int r = 0; r < 16; ++r) { S[r] = __builtin_amdgcn_exp2f(S[r]); ps += S[r]; }
    a.l += ps;
    const bf16x8 p0 = pack8(S, 0), p1 = pack8(S, 1);
    a.o0 = FA_MFMA(a00, p0, a.o0); a.o0 = FA_MFMA(a01, p1, a.o0); a.o1 = FA_MFMA(a10, p0, a.o1); a.o1 = FA_MFMA(a11, p1, a.o1);
}
__device__ __forceinline__ void step64l(Acc& a, const Qf& q, const LAS unsigned char* buf, int r32, int hi, bool rowmask, bool rowon) {
    const float pinf_ = opaque_inf();
    const LAS unsigned char* kr0 = buf + r32 * 128; const LAS unsigned char* kr1 = kr0 + 32 * 128; const int kx = (r32 >> 1) & 7;
    f32x16 S0, S1;
    { const bf16x8 k0 = *(const LAS bf16x8*)(kr0 + (((0 + hi) ^ kx) << 4)), k1 = *(const LAS bf16x8*)(kr0 + (((2 + hi) ^ kx) << 4)), k2 = *(const LAS bf16x8*)(kr0 + (((4 + hi) ^ kx) << 4)), k3 = *(const LAS bf16x8*)(kr0 + (((6 + hi) ^ kx) << 4));
      const bf16x8 j0 = *(const LAS bf16x8*)(kr1 + (((0 + hi) ^ kx) << 4)), j1 = *(const LAS bf16x8*)(kr1 + (((2 + hi) ^ kx) << 4)), j2 = *(const LAS bf16x8*)(kr1 + (((4 + hi) ^ kx) << 4)), j3 = *(const LAS bf16x8*)(kr1 + (((6 + hi) ^ kx) << 4));
      S0 = FA_MFMA(k0, q.f[0], a.negm); S1 = FA_MFMA(j0, q.f[0], a.negm); S0 = FA_MFMA(k1, q.f[1], S0); S1 = FA_MFMA(j1, q.f[1], S1);
      S0 = FA_MFMA(k2, q.f[2], S0); S1 = FA_MFMA(j2, q.f[2], S1); S0 = FA_MFMA(k3, q.f[3], S0); S1 = FA_MFMA(j3, q.f[3], S1); }
    const LAS unsigned char* v0 = buf + 8192 + r32 * 128; const LAS unsigned char* v1 = v0 + 32 * 128; const int x0 = (r32 >> 1) & 7;
    const bf16x8 a00 = lds_vfrag(v0, hi, x0), a01 = lds_vfrag(v0, 2 + hi, x0), a02 = lds_vfrag(v0, 4 + hi, x0), a03 = lds_vfrag(v0, 6 + hi, x0);
    float ra = mx2(mx2(mx2(S0[0], S0[1]), mx2(S0[2], S0[3])), mx2(mx2(S0[4], S0[5]), mx2(S0[6], S0[7])));
    ra = mx2(ra, mx2(mx2(mx2(S0[8], S0[9]), mx2(S0[10], S0[11])), mx2(mx2(S0[12], S0[13]), mx2(S0[14], S0[15]))));
    float rb = mx2(mx2(mx2(S1[0], S1[1]), mx2(S1[2], S1[3])), mx2(mx2(S1[4], S1[5]), mx2(S1[6], S1[7])));
    rb = mx2(rb, mx2(mx2(mx2(S1[8], S1[9]), mx2(S1[10], S1[11])), mx2(mx2(S1[12], S1[13]), mx2(S1[14], S1[15]))));
    float rm = mx2(ra, rb);
    if (rowmask) rm = rowon ? rm : FA_NINF;
    rm = swap_max(rm);
    const bool big = rm > (a.seen ? FA_THR : -3.0e38f);
    if (__any(big)) { const float dl = big ? rm : 0.f; a.m += dl; const float f = __builtin_amdgcn_exp2f(-dl); a.l *= f;
#pragma unroll
        for (int r = 0; r < 16; ++r) { a.o0[r] *= f; a.o1[r] *= f; S0[r] -= dl; S1[r] -= dl; a.negm[r] = -a.m; } }
    a.seen = a.seen || (rm > -3.0e38f);
    float ps = 0.f, pt = 0.f;
#pragma unroll
    for (int r = 0; r < 16; ++r) { S0[r] = __builtin_amdgcn_exp2f(S0[r]); ps += S0[r]; S1[r] = __builtin_amdgcn_exp2f(S1[r]); pt += S1[r]; }
    ps += pt;
    v4u w0 = __builtin_bit_cast(v4u, pack8(S0, 0)), w1 = __builtin_bit_cast(v4u, pack8(S0, 1)), w2 = __builtin_bit_cast(v4u, pack8(S1, 0)), w3 = __builtin_bit_cast(v4u, pack8(S1, 1));
    if (rowmask) { const unsigned km = rowon ? 0xffffffffu : 0u; ps = rowon ? ps : 0.f;
        w0.x &= km; w0.y &= km; w0.z &= km; w0.w &= km; w1.x &= km; w1.y &= km; w1.z &= km; w1.w &= km; w2.x &= km; w2.y &= km; w2.z &= km; w2.w &= km; w3.x &= km; w3.y &= km; w3.z &= km; w3.w &= km; }
    a.l += ps;
    const bf16x8 p0 = __builtin_bit_cast(bf16x8, w0), p1 = __builtin_bit_cast(bf16x8, w1), p2 = __builtin_bit_cast(bf16x8, w2), p3 = __builtin_bit_cast(bf16x8, w3);
    const bf16x8 a10 = lds_vfrag(v1, hi, x0), a11 = lds_vfrag(v1, 2 + hi, x0), a12 = lds_vfrag(v1, 4 + hi, x0), a13 = lds_vfrag(v1, 6 + hi, x0);
    a.o0 = FA_MFMA(a00, p0, a.o0); a.o0 = FA_MFMA(a01, p1, a.o0); a.o0 = FA_MFMA(a02, p2, a.o0); a.o0 = FA_MFMA(a03, p3, a.o0);
    a.o1 = FA_MFMA(a10, p0, a.o1); a.o1 = FA_MFMA(a11, p1, a.o1); a.o1 = FA_MFMA(a12, p2, a.o1); a.o1 = FA_MFMA(a13, p3, a.o1);
}
__device__ __forceinline__ void step64m(Acc& a, const Qf& q, const LAS unsigned char* buf, int r32, int hi, bool needmask, int loA, int upA, int loB, int upB) {
    const float pinf_ = opaque_inf();
    const LAS unsigned char* kr0 = buf + r32 * 128; const LAS unsigned char* kr1 = kr0 + 32 * 128; const int kx = (r32 >> 1) & 7;
    f32x16 S0, S1;
    { const bf16x8 k0 = *(const LAS bf16x8*)(kr0 + (((0 + hi) ^ kx) << 4)), k1 = *(const LAS bf16x8*)(kr0 + (((2 + hi) ^ kx) << 4)), k2 = *(const LAS bf16x8*)(kr0 + (((4 + hi) ^ kx) << 4)), k3 = *(const LAS bf16x8*)(kr0 + (((6 + hi) ^ kx) << 4));
      const bf16x8 j0 = *(const LAS bf16x8*)(kr1 + (((0 + hi) ^ kx) << 4)), j1 = *(const LAS bf16x8*)(kr1 + (((2 + hi) ^ kx) << 4)), j2 = *(const LAS bf16x8*)(kr1 + (((4 + hi) ^ kx) << 4)), j3 = *(const LAS bf16x8*)(kr1 + (((6 + hi) ^ kx) << 4));
      S0 = FA_MFMA(k0, q.f[0], a.negm); S1 = FA_MFMA(j0, q.f[0], a.negm); S0 = FA_MFMA(k1, q.f[1], S0); S1 = FA_MFMA(j1, q.f[1], S1);
      S0 = FA_MFMA(k2, q.f[2], S0); S1 = FA_MFMA(j2, q.f[2], S1); S0 = FA_MFMA(k3, q.f[3], S0); S1 = FA_MFMA(j3, q.f[3], S1); }
    const LAS unsigned char* v0 = buf + 8192 + r32 * 128; const LAS unsigned char* v1 = v0 + 32 * 128; const int x0 = (r32 >> 1) & 7;
    const bf16x8 a00 = lds_vfrag(v0, hi, x0), a01 = lds_vfrag(v0, 2 + hi, x0), a02 = lds_vfrag(v0, 4 + hi, x0), a03 = lds_vfrag(v0, 6 + hi, x0);
    if (needmask) {
#pragma unroll
        for (int r = 0; r < 16; ++r) { const int c = crow(r, hi); S0[r] = (c >= loA && c <= upA) ? S0[r] : FA_NINF; S1[r] = (c >= loB && c <= upB) ? S1[r] : FA_NINF; }
    }
    float ra = mx2(mx2(mx2(S0[0], S0[1]), mx2(S0[2], S0[3])), mx2(mx2(S0[4], S0[5]), mx2(S0[6], S0[7])));
    ra = mx2(ra, mx2(mx2(mx2(S0[8], S0[9]), mx2(S0[10], S0[11])), mx2(mx2(S0[12], S0[13]), mx2(S0[14], S0[15]))));
    float rb = mx2(mx2(mx2(S1[0], S1[1]), mx2(S1[2], S1[3])), mx2(mx2(S1[4], S1[5]), mx2(S1[6], S1[7])));
    rb = mx2(rb, mx2(mx2(mx2(S1[8], S1[9]), mx2(S1[10], S1[11])), mx2(mx2(S1[12], S1[13]), mx2(S1[14], S1[15]))));
    float rm = mx2(ra, rb);
    rm = swap_max(rm);
    const bool big = rm > (a.seen ? FA_THR : -3.0e38f);
    if (__any(big)) { const float dl = big ? rm : 0.f; a.m += dl; const float f = __builtin_amdgcn_exp2f(-dl); a.l *= f;
#pragma unroll
        for (int r = 0; r < 16; ++r) { a.o0[r] *= f; a.o1[r] *= f; S0[r] -= dl; S1[r] -= dl; a.negm[r] = -a.m; } }
    a.seen = a.seen || (rm > -3.0e38f);
    float ps = 0.f, pt = 0.f;
#pragma unroll
    for (int r = 0; r < 16; ++r) { S0[r] = __builtin_amdgcn_exp2f(S0[r]); ps += S0[r]; S1[r] = __builtin_amdgcn_exp2f(S1[r]); pt += S1[r]; }
    ps += pt;
    v4u w0 = __builtin_bit_cast(v4u, pack8(S0, 0)), w1 = __builtin_bit_cast(v4u, pack8(S0, 1)), w2 = __builtin_bit_cast(v4u, pack8(S1, 0)), w3 = __builtin_bit_cast(v4u, pack8(S1, 1));
    a.l += ps;
    const bf16x8 p0 = __builtin_bit_cast(bf16x8, w0), p1 = __builtin_bit_cast(bf16x8, w1), p2 = __builtin_bit_cast(bf16x8, w2), p3 = __builtin_bit_cast(bf16x8, w3);
    const bf16x8 a10 = lds_vfrag(v1, hi, x0), a11 = lds_vfrag(v1, 2 + hi, x0), a12 = lds_vfrag(v1, 4 + hi, x0), a13 = lds_vfrag(v1, 6 + hi, x0);
    a.o0 = FA_MFMA(a00, p0, a.o0); a.o0 = FA_MFMA(a01, p1, a.o0); a.o0 = FA_MFMA(a02, p2, a.o0); a.o0 = FA_MFMA(a03, p3, a.o0);
    a.o1 = FA_MFMA(a10, p0, a.o1); a.o1 = FA_MFMA(a11, p1, a.o1); a.o1 = FA_MFMA(a12, p2, a.o1); a.o1 = FA_MFMA(a13, p3, a.o1);
}
__device__ __forceinline__ void park_store(LAS float* pp, const f32x16& t0, const f32x16& t1) {
#pragma unroll
    for (int r = 0; r < 16; ++r) { pp[r * 64] = t0[r]; pp[(16 + r) * 64] = t1[r]; }
}
__device__ __forceinline__ void park_add(LAS float* pp, const Acc& a, float gate) {
    const float l = swap_sum(a.l); const float sc = l > 0.f ? gate * __builtin_amdgcn_rcpf(l) : 0.f;
#pragma unroll
    for (int r = 0; r < 16; ++r) { pp[r * 64] += a.o0[r] * sc; pp[(16 + r) * 64] += a.o1[r] * sc; }
}
__device__ __forceinline__ void park_final(LAS float* pp, const Acc& a, float gate, f32x16& t0, f32x16& t1) {
    const float l = swap_sum(a.l); const float sc = l > 0.f ? gate * __builtin_amdgcn_rcpf(l) : 0.f;
#pragma unroll
    for (int r = 0; r < 16; ++r) { t0[r] = pp[r * 64] + a.o0[r] * sc; t1[r] = pp[(16 + r) * 64] + a.o1[r] * sc; }
}
__device__ __forceinline__ void store_out(bf16* dst  , const f32x16& t0, const f32x16& t1, int hi) {
#pragma unroll
    for (int rg = 0; rg < 4; ++rg) { v2u w; w.x = cvtpk(t0[4 * rg], t0[4 * rg + 1]); w.y = cvtpk(t0[4 * rg + 2], t0[4 * rg + 3]); *(GAS v2u*)(dst + 8 * rg + 4 * hi) = w;
        v2u x; x.x = cvtpk(t1[4 * rg], t1[4 * rg + 1]); x.y = cvtpk(t1[4 * rg + 2], t1[4 * rg + 3]); *(GAS v2u*)(dst + 32 + 8 * rg + 4 * hi) = x; }
}
constexpr int L_IMP = 0, L_VS = 8 * 32 * 33 * 4, L_SELM = L_VS + 64 * 33 * 4;

__device__ __forceinline__ void nsa_unit(unsigned char* ws, bf16* attout, LAS unsigned char* lds, int wave_s, int bg, int tb) {
    const int tid = fresh_tid(wave_s); asm volatile("" : "+s"(ws));
    const int lane = tid & 63, r32 = lane & 31, hi = lane >> 5, w = __builtin_amdgcn_readfirstlane(tid >> 6), rr = w & 3, th = w >> 2;
    if (w >= 4) __builtin_amdgcn_s_setprio(1);
    const int b = bg >> 1, g = bg & 1, head = 4 * g + rr, t = 64 * tb + 32 * th + r32;
    unsigned char* ar = ws + WS_ARENA + (size_t)b * ARENA_B;
    Qf q; load_rows(q, (const bf16*)(ar + A_QA) + ((size_t)head * SEQ + t) * 64 + hi * 8);
    const GAS float* gs = (const GAS float*)(ar + A_GS) + (size_t)t * 32 + head * 3;
    const float g0 = gs[0];
    f32x16 t0, t1;
    const bf16* Ks = (const bf16*)(ar + A_KS) + (size_t)g * SEQ * 64; const bf16* Vs = (const bf16*)(ar + A_VST) + (size_t)g * 64 * SEQ;
    TileRegs tr; tile_issue(tr, Ks, Vs, tid);
    LAS float* IMP = (LAS float*)(lds + L_IMP); LAS float* VS = (LAS float*)(lds + L_VS); LAS unsigned* SELM = (LAS unsigned*)(lds + L_SELM);
    {
        const int ntile = (tb >> 3) + 1;
        const int clim = t >= 31 ? (t - 31) >> 4 : -1;
        const bf16* K = (const bf16*)(ws + WS_KCB) + (size_t)bg * 128 * 64; const bf16* V = (const bf16*)(ws + WS_VCBT) + (size_t)bg * 64 * 128;
        f32x16 zero;
#pragma unroll
        for (int r = 0; r < 16; ++r) zero[r] = 0.f;
        f32x16 S[4]; float rm = FA_NINF;
        Qf kf[4]; bf16x8 vf[4][4];
#pragma unroll
        for (int ti = 0; ti < 4; ++ti) if (ti < ntile) load_rows(kf[ti], K + (size_t)(ti * 32 + r32) * 64 + hi * 8);
#pragma unroll
        for (int ti = 0; ti < 4; ++ti) if (ti < ntile) { const bf16* v0 = V + (size_t)r32 * 128 + ti * 32 + 4 * hi; const bf16* v1 = v0 + (size_t)32 * 128;
            vf[ti][0] = vfrag(v0); vf[ti][1] = vfrag(v0 + 16); vf[ti][2] = vfrag(v1); vf[ti][3] = vfrag(v1 + 16); }
        __builtin_amdgcn_sched_barrier(0);
#pragma unroll
        for (int ti = 0; ti < 4; ++ti) if (ti < ntile) { S[ti] = FA_MFMA(kf[ti].f[0], q.f[0], zero); S[ti] = FA_MFMA(kf[ti].f[1], q.f[1], S[ti]); S[ti] = FA_MFMA(kf[ti].f[2], q.f[2], S[ti]); S[ti] = FA_MFMA(kf[ti].f[3], q.f[3], S[ti]); }
#pragma unroll
        for (int ti = 0; ti < 4; ++ti) if (ti < ntile) {
#pragma unroll
            for (int r = 0; r < 16; ++r) { S[ti][r] = (32 * ti + crow(r, hi) <= clim) ? S[ti][r] : FA_NINF; rm = fmaxf(rm, S[ti][r]); } }
        rm = swap_max(rm); const float mref = rm > -3.0e38f ? rm : 0.f; float l = 0.f;
#pragma unroll
        for (int ti = 0; ti < 4; ++ti) if (ti < ntile) {
#pragma unroll
            for (int r = 0; r < 16; ++r) { S[ti][r] = __builtin_amdgcn_exp2f(S[ti][r] - mref); l += S[ti][r]; } }
        l = swap_sum(l); const float il = l > 0.f ? __builtin_amdgcn_rcpf(l) : 0.f;
#pragma unroll
        for (int r = 0; r < 16; ++r) { t0[r] = 0.f; t1[r] = 0.f; }
        LAS float* myimp = IMP + (w * 32 + r32) * 33; float carry = 0.f;
#pragma unroll
        for (int ti = 0; ti < 4; ++ti) if (ti < ntile) {
#pragma unroll
            for (int r = 0; r < 16; ++r) S[ti][r] *= il;
            float lo4[4];
#pragma unroll
            for (int rg = 0; rg < 4; ++rg) lo4[rg] = swap_other(S[ti][4 * rg + 3], hi);
#pragma unroll
            for (int rg = 0; rg < 4; ++rg) { const float gsum = (S[ti][4 * rg] + S[ti][4 * rg + 1]) + (S[ti][4 * rg + 2] + S[ti][4 * rg + 3]);
                const float prev = hi ? lo4[rg] : (rg > 0 ? lo4[rg > 0 ? rg - 1 : 0] : carry);
                myimp[2 * (4 * ti + rg) + hi] = gsum + prev; }
            carry = lo4[3];
            { const bf16x8 p0 = pack8(S[ti], 0), p1 = pack8(S[ti], 1);
              t0 = FA_MFMA(vf[ti][0], p0, t0); t0 = FA_MFMA(vf[ti][1], p1, t0); t1 = FA_MFMA(vf[ti][2], p0, t1); t1 = FA_MFMA(vf[ti][3], p1, t1); }
        }
#pragma unroll
        for (int r = 0; r < 16; ++r) { t0[r] *= g0; t1[r] *= g0; }
    }
    __syncthreads();
    {
        const int tk = tid >> 3, jg = tid & 7, tht = tk >> 5, qt = tk & 31;
#pragma unroll
        for (int i = 0; i < 4; ++i) { const int j = 4 * jg + i; float x = 0.f;
#pragma unroll
            for (int r = 0; r < 4; ++r) x += IMP[((tht * 4 + r) * 32 + qt) * 33 + j];
            VS[tk * 33 + j] = (j <= tb) ? x + ((j == 0 || j == tb || j == tb - 1) ? 1e4f : 0.f) : -1e30f; }
        if (tid < 64) SELM[tid] = 0u;
    }
    __syncthreads();
    {
        const int tk = tid >> 3, part = tid & 7; float v[32];
#pragma unroll
        for (int j = 0; j < 32; ++j) v[j] = VS[tk * 33 + j];
        unsigned bits = 0;
#pragma unroll
        for (int i = 0; i < 4; ++i) { const int j = 4 * part + i; const float vj = VS[tk * 33 + j]; int rank = 0;
#pragma unroll
            for (int k = 0; k < 32; ++k) rank += (v[k] > vj || (v[k] == vj && k < j)) ? 1 : 0;
            if (rank < 16 && j <= tb) bits |= 1u << j; }
        __hip_atomic_fetch_or((LAS unsigned*)&SELM[tk], bits, __ATOMIC_RELAXED, __HIP_MEMORY_SCOPE_WORKGROUP);
    }
    __syncthreads();
    const unsigned selm = SELM[32 * th + r32];

    LAS float* pp = (LAS float*)(lds + (w < 6 ? 81920 + w * 8192 : (w - 6) * 8192)) + lane;
    park_store(pp, t0, t1);
    Acc a; LAS unsigned char* tb0 = lds + L_TILE;
    const bf16* Kw = (const bf16*)(ar + A_KW) + (size_t)g * SEQ * 64; const bf16* Vw = (const bf16*)(ar + A_VWT) + (size_t)g * 64 * SEQ;
    const int jw0 = tb >= 8 ? tb - 8 : 0;
    {
        acc_reset(a);
        for (int j = 0; j < tb; ++j) {
            LAS unsigned char* buf = tb0 + (j & 1) * TILE_BYTES;
            tile_commit(buf, tr, tid);
            tile_issue(tr, Ks + (size_t)(64 * (j + 1)) * 64, Vs + 64 * (j + 1), tid);
            __syncthreads();
            const bool on = (selm >> j) & 1u; const unsigned long long bal = __ballot(on);
            if (bal != 0ull) step64l(a, q, buf, r32, hi, bal != ~0ull, on);
        }
        {
            LAS unsigned char* buf = tb0 + (tb & 1) * TILE_BYTES;
            tile_commit(buf, tr, tid);
            tile_issue(tr, Kw + (size_t)(64 * jw0) * 64, Vw + 64 * jw0, tid);
            __syncthreads();
            step64m(a, q, buf, r32, hi, true, 0, th ? 31 : r32, th ? 0 : 1, th ? r32 : 0);
        }
        park_add(pp, a, gs[1]);
    }

    __syncthreads();
    {
        acc_reset(a);
        const int as = 2 * tb + th, ks0 = as >= 16 ? as - 16 : 0;
        auto edge_tile = [&](int j) {
            LAS unsigned char* buf = tb0 + (j & 1) * TILE_BYTES;
            tile_commit(buf, tr, tid);
            if (j < tb) tile_issue(tr, Kw + (size_t)(64 * (j + 1)) * 64, Vw + 64 * (j + 1), tid);
            __syncthreads();
            const int ka = 2 * j, kb = 2 * j + 1;
            const bool fa_ = (as >= 16 && ka == as - 16), la_ = (ka == as), fb_ = (as >= 16 && kb == as - 16), lb_ = (kb == as);
            const bool acta = (ka >= ks0 && ka <= as), actb = (kb >= ks0 && kb <= as);
            if (acta || actb) step64m(a, q, buf, r32, hi, !(acta && actb && !fa_ && !la_ && !fb_ && !lb_),
                                      !acta ? 1 : (fa_ ? r32 + 1 : 0), !acta ? 0 : (la_ ? r32 : 31), !actb ? 1 : (fb_ ? r32 + 1 : 0), !actb ? 0 : (lb_ ? r32 : 31));
        };
        edge_tile(jw0);
        for (int j = jw0 + 1; j < tb; ++j) {
            LAS unsigned char* buf = tb0 + (j & 1) * TILE_BYTES;
            tile_commit(buf, tr, tid);
            tile_issue(tr, Kw + (size_t)(64 * (j + 1)) * 64, Vw + 64 * (j + 1), tid);
            __syncthreads();
            step64l(a, q, buf, r32, hi, false, true);
        }
        if (tb > jw0) edge_tile(tb);
        park_final(pp, a, gs[2], t0, t1);
    }
    store_out(attout + (size_t)b * OUT_BATCH_E + (size_t)t * 1024 + head * 64, t0, t1, hi);
    __builtin_amdgcn_s_setprio(0);

    __syncthreads();
}
__device__ __forceinline__ void moba_unit(unsigned char* ws, bf16* attout, LAS unsigned char* lds, int wave_s, int bh, int c8) {
    const int tid = fresh_tid(wave_s); asm volatile("" : "+s"(ws));
    const int lane = tid & 63, r32 = lane & 31, hi = lane >> 5, w = __builtin_amdgcn_readfirstlane(tid >> 6);
    if (w >= 4) __builtin_amdgcn_s_setprio(1);
    const int b = bh >> 3, h = bh & 7, t = 256 * c8 + 32 * w + r32;
    unsigned char* ar = ws + WS_ARENA + (size_t)b * ARENA_B;
    Qf q; load_rows(q, (const bf16*)(ar + A_QB) + ((size_t)h * SEQ + t) * 64 + hi * 8);
    const bf16* K = (const bf16*)(ar + A_KB) + (size_t)h * SEQ * 64; const bf16* V = (const bf16*)(ar + A_VBT) + (size_t)h * 64 * SEQ;
    TileRegs tr; tile_issue(tr, K, V, tid);
    unsigned selm = 0;
    if (c8 > 0) {
        LAS bf16* KMl = (LAS bf16*)(lds + L_TILE + 2 * TILE_BYTES);
        if (w < c8) { const int ko = lane >> 3, ch = lane & 7; const bf16* base = K + (size_t)(256 * w) * 64; float s8[8];
#pragma unroll
            for (int i = 0; i < 8; ++i) s8[i] = 0.f;
            for (int ib = 0; ib < 32; ib += 16) { v4u wv[16];
#pragma unroll
                for (int i = 0; i < 16; ++i) wv[i] = *(const GAS v4u*)(base + (size_t)(8 * (ib + i) + ko) * 64 + ch * 8);
                __builtin_amdgcn_sched_barrier(0);
#pragma unroll
                for (int i = 0; i < 16; ++i) {
                    s8[0] += __uint_as_float(wv[i].x << 16); s8[1] += __uint_as_float(wv[i].x & 0xffff0000u); s8[2] += __uint_as_float(wv[i].y << 16); s8[3] += __uint_as_float(wv[i].y & 0xffff0000u);
                    s8[4] += __uint_as_float(wv[i].z << 16); s8[5] += __uint_as_float(wv[i].z & 0xffff0000u); s8[6] += __uint_as_float(wv[i].w << 16); s8[7] += __uint_as_float(wv[i].w & 0xffff0000u); } }
#pragma unroll
            for (int i = 0; i < 8; ++i) { s8[i] += __shfl_xor(s8[i], 8); s8[i] += __shfl_xor(s8[i], 16); s8[i] += __shfl_xor(s8[i], 32); s8[i] *= (1.0f / 256.0f); }
            if (lane < 8) { v4u o; o.x = pk2(s8[0], s8[1]); o.y = pk2(s8[2], s8[3]); o.z = pk2(s8[4], s8[5]); o.w = pk2(s8[6], s8[7]); *(LAS v4u*)(KMl + w * 64 + ch * 8) = o; } }
        else if (lane < 8) { const v4u z = {0u, 0u, 0u, 0u}; *(LAS v4u*)(KMl + w * 64 + (lane & 7) * 8) = z; }
        __syncthreads();
        f32x16 zero;
#pragma unroll
        for (int r = 0; r < 16; ++r) zero[r] = 0.f;
        Qf k;
#pragma unroll
        for (int sx = 0; sx < 4; ++sx) k.f[sx] = *(const LAS bf16x8*)(KMl + (r32 & 7) * 64 + hi * 8 + 16 * sx);
        f32x16 S = FA_MFMA(k.f[0], q.f[0], zero); S = FA_MFMA(k.f[1], q.f[1], S); S = FA_MFMA(k.f[2], q.f[2], S); S = FA_MFMA(k.f[3], q.f[3], S);
        float gsc[8];
#pragma unroll
        for (int i = 0; i < 4; ++i) { auto sw = __builtin_amdgcn_permlane32_swap(__float_as_uint(S[i]), __float_as_uint(S[i]), false, false); gsc[i] = __uint_as_float(sw[0]); gsc[4 + i] = __uint_as_float(sw[1]); }
#pragma unroll
        for (int j = 0; j < 8; ++j) { int rank = 0;
#pragma unroll
            for (int i = 0; i < 8; ++i) rank += (i < c8 && (gsc[i] > gsc[j] || (gsc[i] == gsc[j] && i < j))) ? 1 : 0;
            if (j < c8 && rank < 3) selm |= 1u << j; }
    }
    Acc a; acc_reset(a); LAS unsigned char* tb0 = lds + L_TILE;
    const int nt = 4 * c8 + 4, npast = 4 * c8;
    for (int i = 0; i < npast; ++i) {
        LAS unsigned char* buf = tb0 + (i & 1) * TILE_BYTES;
        tile_commit(buf, tr, tid);
        tile_issue(tr, K + (size_t)(64 * (i + 1)) * 64, V + 64 * (i + 1), tid);
        __syncthreads();
        const bool on = (selm >> (i >> 2)) & 1u; const unsigned long long bal = __ballot(on);
        if (bal != 0ull) step64l(a, q, buf, r32, hi, bal != ~0ull, on);
    }
    for (int i = npast; i < nt; ++i) {
        LAS unsigned char* buf = tb0 + (i & 1) * TILE_BYTES;
        tile_commit(buf, tr, tid);
        if (i + 1 < nt) tile_issue(tr, K + (size_t)(64 * (i + 1)) * 64, V + 64 * (i + 1), tid);
        __syncthreads();
        const int ka = 2 * (i & 3), kb = ka + 1;
        if (ka <= w) step64m(a, q, buf, r32, hi, kb >= w, 0, ka == w ? r32 : 31, kb > w ? 1 : 0, kb > w ? 0 : (kb == w ? r32 : 31));
    }
    f32x16 t0, t1;
#pragma unroll
    for (int r = 0; r < 16; ++r) { t0[r] = 0.f; t1[r] = 0.f; }
    acc_finish(a, t0, t1, 1.0f);
    store_out(attout + (size_t)b * OUT_BATCH_E + (size_t)t * 1024 + 512 + h * 64, t0, t1, hi);
    __builtin_amdgcn_s_setprio(0);
    __syncthreads();
}
}
__device__ __forceinline__ void cmp_unit(Frame& F, const Args& A, int l, int u) {
    unsigned char* ws = F.ws; asm volatile("" : "+s"(ws)); const int tid = fresh_tid(F.wave_s), lane = tid & 63, r32 = lane & 31, hi = lane >> 5, w = __builtin_amdgcn_readfirstlane(tid >> 6), nt = w & 3, kh = w >> 2;
    LAS float* part = (LAS float*)F.lds;
    LAS float* hid = (LAS float*)(F.lds + 16896);
    LAS float* o2 = (LAS float*)(F.lds + 16896 + 16384);
    {
        const int kv = u >> 6, bg = (u >> 2) & 15, ct = u & 3, c0 = 32 * ct;
        const bf16* src = (const bf16*)(ws + WS_ARENA + (size_t)(bg >> 1) * ARENA_B + (kv ? A_VC : A_KC)) + (size_t)(bg & 1) * SEQ * 64;
        const bf16* w1t = (const bf16*)(ws + (kv ? WS_W1TV : WS_W1TK));
        fa::f32x16 acc;
#pragma unroll
        for (int r = 0; r < 16; ++r) acc[r] = 0.f;
        const bf16* ap = src + (size_t)(16 * (c0 + r32)) * 64 + 8 * hi;
        const bf16* bp = w1t + (size_t)(32 * nt + r32) * 2048 + 8 * hi;
        for (int sb = kh * 64; sb < kh * 64 + 64; sb += 16) {
            fa::bf16x8 af[16], bfr[16];
#pragma unroll
            for (int i = 0; i < 16; ++i) { const int s = sb + i;
                af[i] = *(const GAS fa::bf16x8*)(ap + (s >> 2) * 64 + 16 * (s & 3)); bfr[i] = *(const GAS fa::bf16x8*)(bp + 16 * s); }
            __builtin_amdgcn_sched_barrier(0);
#pragma unroll
            for (int i = 0; i < 16; ++i) acc = FA_MFMA(af[i], bfr[i], acc);
            __builtin_amdgcn_sched_barrier(0);
        }

        if (kh == 1) {
#pragma unroll
            for (int r = 0; r < 16; ++r) part[(nt * 32 + fa::crow(r, hi)) * 33 + r32] = acc[r];
        }
        __syncthreads();
        LAS bf16* hidb = (LAS bf16*)hid;
        if (kh == 0) { const float bias = ((const float*)(ws + WS_CBIAS))[kv * 128 + 32 * nt + r32];
#pragma unroll
            for (int r = 0; r < 16; ++r) { const int c = fa::crow(r, hi); hidb[c * 136 + 32 * nt + r32] = (bf16)f2bf(gelu_tanh(acc[r] + part[(nt * 32 + c) * 33 + r32] + bias)); }
        }
        __syncthreads();
        if (w < 2) {
            const bf16* w2t = (const bf16*)(ws + (kv ? WS_W2TV : WS_W2TK)) + (size_t)(32 * w + r32) * 128 + 8 * hi;
            fa::bf16x8 bq[8];
#pragma unroll
            for (int sx = 0; sx < 8; ++sx) bq[sx] = *(const GAS fa::bf16x8*)(w2t + 16 * sx);
            fa::f32x16 oacc;
#pragma unroll
            for (int r = 0; r < 16; ++r) oacc[r] = 0.f;
#pragma unroll
            for (int sx = 0; sx < 8; ++sx) { const fa::bf16x8 aq = *(const LAS fa::bf16x8*)(hidb + r32 * 136 + 16 * sx + 8 * hi); oacc = FA_MFMA(aq, bq[sx], oacc); }
#pragma unroll
            for (int r = 0; r < 16; ++r) o2[fa::crow(r, hi) * 64 + 32 * w + r32] = oacc[r];
        }
        __syncthreads();
        const int d = tid & 63, cq = tid >> 6;
#pragma unroll
        for (int i = 0; i < 4; ++i) { const int cl = cq + 8 * i, c = c0 + cl;
            if (kv == 0) { float r = 0.f;
                if (c < 127) { const int t = 16 * c + 31, dd = d & 31; const float cs = ((const float*)(ws + WS_ROPEC))[t * 32 + dd], sn = ((const float*)(ws + WS_ROPES))[t * 32 + dd];
                    const float x1 = o2[cl * 64 + dd], x2 = o2[cl * 64 + dd + 32]; r = d < 32 ? x1 * cs - x2 * sn : x2 * cs + x1 * sn; }
                ((bf16*)(ws + WS_KCB))[((size_t)bg * 128 + c) * 64 + d] = (bf16)f2bf(r); }
            else { const float r = c < 127 ? o2[cl * 64 + d] : 0.f; ((bf16*)(ws + WS_VCBT))[((size_t)bg * 64 + d) * 128 + c] = (bf16)f2bf(r); } }
        __syncthreads();
    }
}
__device__ __forceinline__ void phase_x(Frame& F, const Args& A, int l, bf16* attout) {
    const int vcu = (F.G % 8 == 0) ? (F.bx % 8) * (F.G / 8) + F.bx / 8 : F.bx;
    for (int mp = vcu; mp < 256; mp += F.G) { const int bh = mp >> 2, i = mp & 3;
        if (i < 2) { const int g8 = mp >> 5, j5 = mp & 31, a4 = (j5 >> 2) * 2 + (j5 & 1);
            cmp_unit(F, A, l, (a4 >> 3) * 64 + (2 * g8 + ((a4 >> 2) & 1)) * 4 + (a4 & 3)); }
        const int code = i == 0 ? 0x7 : i == 1 ? 0x06 : i == 2 ? 0x35 : 0x124, cnt = i == 0 ? 1 : i == 3 ? 3 : 2;
        for (int k = 0; k < cnt; ++k) fa::moba_unit(F.ws, attout, F.lds, F.wave_s, bh, (code >> (4 * k)) & 15); }
}
__device__ __forceinline__ void phase_y(Frame& F, bf16* attout) {
    const int vcu = (F.G % 8 == 0) ? (F.bx % 8) * (F.G / 8) + F.bx / 8 : F.bx;
    for (int np = vcu; np < 256; np += F.G) { const int bg = np >> 4, p = np & 15;
        for (int k = 0; k < 2; ++k) fa::nsa_unit(F.ws, attout, F.lds, F.wave_s, bg, k == 0 ? 31 - p : p); }
}
__global__ void __launch_bounds__(NWAVES * 64, 2) fwd_kernel(Args args) {
    extern __shared__ __attribute__((aligned(16))) unsigned char lds[];
    LAS unsigned char* ldsb = (LAS unsigned char*)lds;
    volatile LAS unsigned* MISC = (volatile LAS unsigned*)(ldsb + MISC_OFF);
    for (int u = threadIdx.x; u < (LDS_BYTES - LDSCTL_OFF) / 4; u += NWAVES * 64) ((LAS unsigned*)(ldsb + LDSCTL_OFF))[u] = 0u;
    __syncthreads();
    const int wave_s = __builtin_amdgcn_readfirstlane((int)threadIdx.x >> 6);
    XcdBarrier bar; bar.bar = (unsigned*)(args.ws + WS_CTL) + 4096; bar.x = 0; bar.st = nullptr;
    const bool multi = (args.ph_hi - args.ph_lo) > 1;
    if (multi) bar = xcd_barrier_post((unsigned*)(args.ws + WS_CTL) + 4096, MISC + 8);
    bool colocal = false, checked = !multi;
    for (int ph = args.ph_lo; ph < args.ph_hi; ++ph) {
        unsigned char* ws = args.ws; asm volatile("" : "+s"(ws));
        unsigned zero_ = 0u; asm volatile("" : "+s"(zero_));
        int tid_ = wave_s * 64 + (int)__builtin_amdgcn_mbcnt_hi(~0u, __builtin_amdgcn_mbcnt_lo(~0u, zero_)); asm volatile("" : "+v"(tid_));
        Frame F;
        F.lds = ldsb; F.ws = ws; F.ctl = (gu32*)(ws + WS_CTL);
        F.tid = tid_; F.lane = 0; F.wave = 0; F.G = gridDim.x; F.bx = blockIdx.x; F.wave_s = wave_s;
        const int l = ph / PH_PER_LAYER, k = (ph == PH_NORM) ? -1 : ph % PH_PER_LAYER;
        bf16* XB = (bf16*)(ws + WS_XB); float* rowss = (float*)(ws + WS_ROWSS);
        if (ph == PH_NORM) {
#ifndef NO_NORM
 phase_norm(F, args);
#endif
 }
        else if (k == PH_CONV) {
#ifndef NO_CONV
 phase_conv(F, args, l);
#endif
 }
        else if (k == PH_UP1 || k == PH_UP2) {
            pg8::Gemm g{XB, (const bf16*)(ws + (k == PH_UP1 ? WS_WUP1 : WS_WUP2)), MT, NUP, DM, 0}; pg8::StaticOrder S; S.init(MT, NUP, F.G, F.bx);
            pg8::EpiSwiglu E{(bf16*)(ws + WS_ARENA + A_H), rowss};

#ifndef NO_UP
 pg8::gemm_phase<pg8::EpiSwiglu, pg8::StaticOrder, true, true>(F.lds, g, S, E, F.tid);
#endif

        }
        else if (k == PH_DN1 || k == PH_DN2 || k == PH_OUT) {
            const bool isout = (k == PH_OUT);
            pg8::Gemm g{(const bf16*)(ws + WS_ARENA + (isout ? A_MRG : A_H)), (const bf16*)(ws + (isout ? WS_WOUT : (k == PH_DN1 ? WS_WDN1 : WS_WDN2))), MT, DM, isout ? DM : DFF,
                        ARENA_B - (size_t)SEQ * (isout ? DM : DFF) * 2}; pg8::StaticOrder S; S.init(MT, DM, F.G, F.bx);
            pg8::EpiResid E{XB, rowss, isout ? 1.0f : 0.5f, (LAS float*)(F.lds + 132096)};

#ifndef NO_DN
 pg8::gemm_phase<pg8::EpiResid, pg8::StaticOrder, true, true>(F.lds, g, S, E, F.tid);
#endif

        }
        else if (k == PH_WIN) {
            pg8::Gemm g{XB, (const bf16*)(ws + WS_WIN), MT, NWIN, DM, 0}; pg8::StaticOrder S; S.init(MT, NWIN, F.G, F.bx);
            pg8::EpiWin E{rowss, (const float*)(ws + WS_ROPEC), (const float*)(ws + WS_ROPES),
                pg8::WinBufs{(bf16*)(ws + WS_ARENA + A_QA), (bf16*)(ws + WS_ARENA + A_QB), (bf16*)(ws + WS_ARENA + A_KB), (bf16*)(ws + WS_ARENA + A_VBT), (bf16*)(ws + WS_ARENA + A_KC), (bf16*)(ws + WS_ARENA + A_VC), (bf16*)(ws + WS_ARENA + A_KS), (bf16*)(ws + WS_ARENA + A_VST),
                             (bf16*)(ws + WS_ARENA + A_KW), (bf16*)(ws + WS_ARENA + A_VWT), (bf16*)(ws + WS_ARENA + A_GA), (bf16*)(ws + WS_ARENA + A_GB), (float*)(ws + WS_ARENA + A_GS)}};

#ifndef NO_WIN
 pg8::gemm_phase<pg8::EpiWin, pg8::StaticOrder, true, true>(F.lds, g, S, E, F.tid);
#endif

        }
        else if (k == PH_CMP) {
#ifndef NO_CMP
 { bf16* attout = (bf16*)args.out; asm volatile("" : "+s"(attout)); phase_x(F, args, l, attout); }
#endif
 }
        else if (k == PH_ATT) {
#ifndef NO_ATT
 { bf16* attout = (bf16*)args.out; asm volatile("" : "+s"(attout)); phase_y(F, attout); }
#endif
 }
        else if (k == PH_MRG) {
            { pg8::Gemm g{(const bf16*)args.out, (const bf16*)(ws + WS_WPA), MT, DM, DM, (size_t)OUT_BATCH_E * 2 - (size_t)SEQ * DM * 2}; pg8::StaticOrder S; S.init(MT, DM, F.G, F.bx);
              pg8::EpiMergeF E{(const bf16*)(ws + WS_ARENA + A_GA), (const bf16*)(ws + WS_ARENA + A_GB), (bf16*)(ws + WS_ARENA + A_MRG)};
#ifndef NO_MRG
              pg8::gemm_phase<pg8::EpiMergeF, pg8::StaticOrder, true, true>(F.lds, g, S, E, F.tid);
#endif
            }
        }
        if (ph + 1 < args.ph_hi) {
            const bool full_seam = (k == PH_CONV) || (k == PH_DN2 && l == 0);
            const int tq = fresh_tid(wave_s);
            if (full_seam || !colocal) { xcd_barrier(bar, tq == 0); if (!checked) { colocal = colocal_check(bar, MISC + 10, fresh_tid(wave_s)); checked = true; } }
            else if (k == PH_UP1 || k == PH_UP2 || k == PH_MRG) team_barrier(bar, tq == 0, (blockIdx.x & 7u) * 8u + ((blockIdx.x >> 3) & 7u));
            else group_barrier(bar, tq == 0, blockIdx.x & 7u, gridDim.x >> 3);
        }
    }
}

extern "C" void kernel_launch(void* const* d_in, const int* in_sizes, int n_in, void* d_out, int out_size, void* d_ws, size_t ws_size, hipStream_t stream) {
    static int grid = 0;
    if (grid == 0) {
        if (n_in != 21 || in_sizes[0] != MT * DM || out_size != MT * DM || ws_size < WS_END) { fprintf(stderr, "kernel_launch: unexpected shapes (n_in %d, in0 %d, out %d, ws %zu)\n", n_in, n_in > 0 ? in_sizes[0] : -1, out_size, ws_size); grid = -1; return; }
        int dev = 0, cus = 0;
        if (hipGetDevice(&dev) != hipSuccess || hipDeviceGetAttribute(&cus, hipDeviceAttributeMultiprocessorCount, dev) != hipSuccess) { grid = -1; return; }
        if (hipFuncSetAttribute((const void*)fwd_kernel, hipFuncAttributeMaxDynamicSharedMemorySize, LDS_BYTES) != hipSuccess) { fprintf(stderr, "kernel_launch: hipFuncSetAttribute failed\n"); grid = -1; return; }
        (void)hipGetLastError();
        grid = cus;
    }
    if (grid < 0) return;
    (void)hipMemsetAsync((char*)d_ws + WS_CTL, 0, CTL_ZERO_BYTES, stream);
    Args a{};
    for (int i = 0; i < 21; ++i) a.in[i] = (const float*)d_in[i];
    a.out = (float*)d_out; a.ws = (unsigned char*)d_ws;
#ifndef MULTI_LAUNCH
    a.ph_lo = 0; a.ph_hi = PH_TOTAL;
    hipLaunchKernelGGL(fwd_kernel, dim3(grid), dim3(NWAVES * 64), LDS_BYTES, stream, a);
    return;
#endif
    for (int ph = 0; ph < PH_TOTAL; ++ph) {
        a.ph_lo = ph; a.ph_hi = ph + 1;
        hipLaunchKernelGGL(fwd_kernel, dim3(grid), dim3(NWAVES * 64), LDS_BYTES, stream, a);
    }
}
```

```cpp
#include <hip/hip_runtime.h>
#include <cstdio>
#include <cstdint>
namespace pg8 {
#define PG8_LAS __attribute__((address_space(3)))
typedef unsigned short bf16_t;
typedef short bf16x8 __attribute__((ext_vector_type(8)));
typedef float f32x4 __attribute__((ext_vector_type(4)));
typedef unsigned u32x4 __attribute__((ext_vector_type(4)));
constexpr int BM = 256, BK = 64, HALF = 128, HTB = HALF * BK * 2  , STAGE_BYTES = 8 * HTB, NXCD = 8, WGM = 8;

__host__ __device__ __forceinline__ int lds_byte(int r, int c) { const int st = (r >> 4) * 2 + (c >> 5), rr = r & 15, cc = c & 31, ob = rr * 64 + cc * 2; return st * 1024 + (ob ^ (((ob >> 9) & 1) << 5)); }
__host__ __device__ __forceinline__ void stage_rc(int b, int& R, int& C) { const int st = b / 1024, sb = b % 1024, swz = sb ^ (((sb >> 9) & 1) << 5); R = (st >> 1) * 16 + swz / 64; C = (st & 1) * 32 + (swz % 64) / 2; }
__host__ __device__ __forceinline__ int perm32(int rho) { const int n = rho >> 4, i = rho & 15; return 8 * (i >> 2) + 4 * n + (i & 3); }

struct Unit { int pm, pn; };
struct Gemm { const bf16_t* A; const bf16_t* Bt; int M, N, K; size_t abgap; };

struct StaticOrder {
    int nM, nN, nwg, G, c;
    __host__ __device__ void init(int M, int N, int G_, int c_) { nM = M / BM; nN = N / BM; nwg = nM * nN; G = G_; c = c_; }
    __host__ __device__ bool next(int i, Unit& u) const {
        const long L = (long)i * G + c; if (L >= nwg) return false;
        int wgid = (int)L; { const int q = nwg / NXCD, r = nwg % NXCD, xcd = wgid % NXCD, off = wgid / NXCD; wgid = (xcd < r ? xcd * (q + 1) : r * (q + 1) + (xcd - r) * q) + off; }
        const int nig = WGM * nN, gid = wgid / nig, fm = gid * WGM, gsz = (nM - fm) < WGM ? (nM - fm) : WGM;
        u.pm = fm + ((wgid % nig) % gsz); u.pn = (wgid % nig) / gsz; return true;
    }
    __device__ __forceinline__ void a_ready(const Unit&) const {}
    __device__ __forceinline__ void done(const Unit&) const {}
};

typedef unsigned u32x2 __attribute__((ext_vector_type(2)));
typedef float pk_f32x2 __attribute__((ext_vector_type(2)));
typedef __bf16 pk_bf16x2 __attribute__((ext_vector_type(2)));
__device__ __forceinline__ unsigned cvt_pk_bf16(float lo, float hi) { const pk_f32x2 v = {lo, hi}; const pk_bf16x2 b = __builtin_convertvector(v, pk_bf16x2); return __builtin_bit_cast(unsigned, b); }
__device__ __forceinline__ float rstd_of(const float* rowss, int row) { const f32x4 a = *(const __attribute__((address_space(1))) f32x4*)(rowss + (size_t)row * 4); return __builtin_amdgcn_rsqf(((a[0] + a[1]) + (a[2] + a[3])) * (1.0f / 1024.0f) + 1e-6f); }
__device__ __forceinline__ void rstd8(const float* rowss, int row0, float (&rs)[2][4]) {
    f32x4 a[2][4];
#pragma unroll
    for (int ai = 0; ai < 2; ++ai)
#pragma unroll
        for (int m = 0; m < 4; ++m) a[ai][m] = *(const __attribute__((address_space(1))) f32x4*)(rowss + (size_t)(row0 + ai * HALF + m * 16) * 4);
    __builtin_amdgcn_sched_barrier(0);
#pragma unroll
    for (int ai = 0; ai < 2; ++ai)
#pragma unroll
        for (int m = 0; m < 4; ++m) rs[ai][m] = __builtin_amdgcn_rsqf(((a[ai][m][0] + a[ai][m][1]) + (a[ai][m][2] + a[ai][m][3])) * (1.0f / 1024.0f) + 1e-6f);
}
__device__ __forceinline__ float sigm(float v) { return __builtin_amdgcn_rcpf(1.0f + __builtin_amdgcn_exp2f(-1.4426950408889634f * v)); }
__device__ __forceinline__ float bfl(unsigned w) { return __uint_as_float(w << 16); }
__device__ __forceinline__ float bfh(unsigned w) { return __uint_as_float(w & 0xffff0000u); }

struct EpiSwiglu {
    static constexpr bool PERM = false, AFTER_DRAIN = false, HAS_MID = false;
    bf16_t* H; const float* rowss;
    __device__ __forceinline__ void operator()(const f32x4 (&acc)[2][2][4][2], const Unit& u, int wr, int wc, int fr, int fq) const {
        const int row0 = u.pm * BM + wr * 64 + fr, col0 = u.pn * 128 + wc * 32 + 8 * fq;
        float rsa[2][4]; rstd8(rowss, row0, rsa);
#pragma unroll
        for (int ai = 0; ai < 2; ++ai)
#pragma unroll
            for (int m = 0; m < 4; ++m) { const int row = row0 + ai * HALF + m * 16; const float rs = rsa[ai][m];
                float hv[8];
#pragma unroll
                for (int n = 0; n < 2; ++n)
#pragma unroll
                    for (int i = 0; i < 4; ++i) { const float g = acc[ai][0][m][n][i] * rs, uu = acc[ai][1][m][n][i] * rs; hv[4 * n + i] = g * uu * sigm(g); }
                u32x4 w; w.x = cvt_pk_bf16(hv[0], hv[1]); w.y = cvt_pk_bf16(hv[2], hv[3]); w.z = cvt_pk_bf16(hv[4], hv[5]); w.w = cvt_pk_bf16(hv[6], hv[7]);
                *(u32x4*)(H + (size_t)(row >> 11) * (size_t)10526720 + (size_t)(row & 2047) * 2816 + col0) = w; asm volatile("" ::: "memory"); }
    }
};
struct EpiResid {
    static constexpr bool PERM = false, AFTER_DRAIN = false, HAS_MID = false;
    bf16_t* XB; float* rowss; float alpha; PG8_LAS float* ssl;
    __device__ __forceinline__ void operator()(const f32x4 (&acc)[2][2][4][2], const Unit& u, int wr, int wc, int fr, int fq) const {
        const int row0 = u.pm * BM + wr * 64 + fr, col0 = u.pn * BM + wc * 32 + 4 * fq;
        u32x2 xo[2][4][2][2];
#pragma unroll
        for (int ai = 0; ai < 2; ++ai)
#pragma unroll
            for (int m = 0; m < 4; ++m)
#pragma unroll
                for (int bj = 0; bj < 2; ++bj)
#pragma unroll
                    for (int n = 0; n < 2; ++n) xo[ai][m][bj][n] = *(const __attribute__((address_space(1))) u32x2*)(XB + (size_t)(row0 + ai * HALF + m * 16) * 1024 + col0 + bj * HALF + n * 16);
        __builtin_amdgcn_sched_barrier(0);
#pragma unroll
        for (int ai = 0; ai < 2; ++ai)
#pragma unroll
            for (int m = 0; m < 4; ++m) { const int row = row0 + ai * HALF + m * 16; const size_t off = (size_t)row * 1024 + col0; float ss = 0.f;
#pragma unroll
                for (int bj = 0; bj < 2; ++bj)
#pragma unroll
                    for (int n = 0; n < 2; ++n) { const size_t o = off + bj * HALF + n * 16; const f32x4 a = acc[ai][bj][m][n]; const u32x2 xv = xo[ai][m][bj][n];
                        const float x0 = bfl(xv.x) + a[0] * alpha, x1 = bfh(xv.x) + a[1] * alpha, x2 = bfl(xv.y) + a[2] * alpha, x3 = bfh(xv.y) + a[3] * alpha;
                        u32x2 w; w.x = cvt_pk_bf16(x0, x1); w.y = cvt_pk_bf16(x2, x3); *(__attribute__((address_space(1))) u32x2*)(XB + o) = w;
                        ss += (x0 * x0 + x1 * x1) + (x2 * x2 + x3 * x3); }
                ss += __shfl_xor(ss, 16); ss += __shfl_xor(ss, 32);
                if (fq == 0) ssl[(ai * HALF + wr * 64 + m * 16 + fr) * 4 + wc] = ss; }
        asm volatile("s_waitcnt lgkmcnt(0)" ::: "memory"); __builtin_amdgcn_s_barrier(); asm volatile("" ::: "memory");
        { const int tid = (wr * 4 + wc) * 64 + fq * 16 + fr;
          if (tid < 256) { const f32x4 p = *(const PG8_LAS f32x4*)(ssl + tid * 4); rowss[(size_t)(u.pm * BM + tid) * 4 + u.pn] = (p[0] + p[1]) + (p[2] + p[3]); } }
        asm volatile("s_waitcnt lgkmcnt(0)" ::: "memory"); __builtin_amdgcn_s_barrier(); asm volatile("" ::: "memory");
    }
};
struct EpiMergeF {
    static constexpr bool PERM = false, AFTER_DRAIN = false, HAS_MID = true; static constexpr int MID_T = 8;
    const bf16_t* GA; const bf16_t* GB; bf16_t* Mg;
    __device__ __forceinline__ void mid(f32x4 (&acc)[2][2][4][2], const Unit& u, int wr, int wc, int fr, int fq) const {
        int row0 = u.pm * BM + wr * 64 + fr, col0 = u.pn * BM + wc * 32 + 8 * fq;
        asm volatile("" : "+v"(row0), "+v"(col0));
#pragma unroll
        for (int ai = 0; ai < 2; ++ai) {
            u32x4 ga[4][2], gb[4][2];
#pragma unroll
            for (int m = 0; m < 4; ++m)
#pragma unroll
                for (int bj = 0; bj < 2; ++bj) { const int rw = row0 + ai * HALF + m * 16; const size_t o = (size_t)(rw >> 11) * (size_t)10526720 + (size_t)(rw & 2047) * 1024 + col0 + bj * HALF;
                    ga[m][bj] = *(const __attribute__((address_space(1))) u32x4*)(GA + o); gb[m][bj] = *(const __attribute__((address_space(1))) u32x4*)(GB + o); }
            __builtin_amdgcn_sched_barrier(0);
#pragma unroll
            for (int m = 0; m < 4; ++m)
#pragma unroll
                for (int bj = 0; bj < 2; ++bj) { const u32x4 a = ga[m][bj], b = gb[m][bj]; float r[8];
                    r[0] = bfl(a.x) * __builtin_amdgcn_rcpf(fmaxf(bfl(b.x), 1e-30f)); r[1] = bfh(a.x) * __builtin_amdgcn_rcpf(fmaxf(bfh(b.x), 1e-30f));
                    r[2] = bfl(a.y) * __builtin_amdgcn_rcpf(fmaxf(bfl(b.y), 1e-30f)); r[3] = bfh(a.y) * __builtin_amdgcn_rcpf(fmaxf(bfh(b.y), 1e-30f));
                    r[4] = bfl(a.z) * __builtin_amdgcn_rcpf(fmaxf(bfl(b.z), 1e-30f)); r[5] = bfh(a.z) * __builtin_amdgcn_rcpf(fmaxf(bfh(b.z), 1e-30f));
                    r[6] = bfl(a.w) * __builtin_amdgcn_rcpf(fmaxf(bfl(b.w), 1e-30f)); r[7] = bfh(a.w) * __builtin_amdgcn_rcpf(fmaxf(bfh(b.w), 1e-30f));
                    acc[ai][bj][m][0][0] *= r[0]; acc[ai][bj][m][0][1] *= r[1]; acc[ai][bj][m][0][2] *= r[2]; acc[ai][bj][m][0][3] *= r[3];
                    acc[ai][bj][m][1][0] *= r[4]; acc[ai][bj][m][1][1] *= r[5]; acc[ai][bj][m][1][2] *= r[6]; acc[ai][bj][m][1][3] *= r[7]; }
            asm volatile("" ::: "memory"); }
    }
    __device__ __forceinline__ void operator()(const f32x4 (&acc)[2][2][4][2], const Unit& u, int wr, int wc, int fr, int fq) const {
        const int row0 = u.pm * BM + wr * 64 + fr, col0 = u.pn * BM + wc * 32 + 8 * fq;
        u32x4 gb[2][4][2];
#pragma unroll
        for (int ai = 0; ai < 2; ++ai)
#pragma unroll
            for (int m = 0; m < 4; ++m)
#pragma unroll
                for (int bj = 0; bj < 2; ++bj) { const int rw = row0 + ai * HALF + m * 16; gb[ai][m][bj] = *(const __attribute__((address_space(1))) u32x4*)(GB + (size_t)(rw >> 11) * (size_t)10526720 + (size_t)(rw & 2047) * 1024 + col0 + bj * HALF); }
        __builtin_amdgcn_sched_barrier(0);
#pragma unroll
        for (int ai = 0; ai < 2; ++ai)
#pragma unroll
            for (int m = 0; m < 4; ++m) { const int row = row0 + ai * HALF + m * 16;
#pragma unroll
                for (int bj = 0; bj < 2; ++bj) { const size_t o = (size_t)(row >> 11) * (size_t)10526720 + (size_t)(row & 2047) * 1024 + col0 + bj * HALF; const u32x4 gw = gb[ai][m][bj];
                    float r[8]; const f32x4 a0 = acc[ai][bj][m][0], a1 = acc[ai][bj][m][1];
                    r[0] = fmaxf(bfl(gw.x), 1e-30f) * a0[0]; r[1] = fmaxf(bfh(gw.x), 1e-30f) * a0[1]; r[2] = fmaxf(bfl(gw.y), 1e-30f) * a0[2]; r[3] = fmaxf(bfh(gw.y), 1e-30f) * a0[3];
                    r[4] = fmaxf(bfl(gw.z), 1e-30f) * a1[0]; r[5] = fmaxf(bfh(gw.z), 1e-30f) * a1[1]; r[6] = fmaxf(bfl(gw.w), 1e-30f) * a1[2]; r[7] = fmaxf(bfh(gw.w), 1e-30f) * a1[3];
                    u32x4 w; w.x = cvt_pk_bf16(r[0], r[1]); w.y = cvt_pk_bf16(r[2], r[3]); w.z = cvt_pk_bf16(r[4], r[5]); w.w = cvt_pk_bf16(r[6], r[7]);
                    *(__attribute__((address_space(1))) u32x4*)(Mg + o) = w; } }
    }
};
constexpr float C2Q = 0.125f * 1.4426950408889634f;
enum { WT_ROPE = 0, WT_PLAIN = 1, WT_VT = 2, WT_SIG = 3, WT_GS = 4, WT_NONE = 5 };
struct WinBufs { bf16_t *QA, *QB, *KBb, *VBt, *KC, *VC, *KS, *VSt, *KW, *VWt, *GA, *GB; float* GS; };
struct EpiWin {
    static constexpr bool PERM = false, AFTER_DRAIN = false, HAS_MID = false;
    const float* rowss; const float* ropec; const float* ropes; WinBufs B;
    __device__ __forceinline__ void operator()(const f32x4 (&acc)[2][2][4][2], const Unit& u, int wr, int wc, int fr, int fq) const {
        const int row0 = u.pm * BM + wr * 64 + fr;
        float rs[2][4]; rstd8(rowss, row0, rs);
        const int hh = wc >> 1, w = wc & 1;
#pragma unroll
        for (int bj = 0; bj < 2; ++bj) {
            const int half = 2 * u.pn + bj;
            int type, nh = 8, hb = 0, cb = 0; bf16_t* dst = nullptr; float sc = 1.f;
            if (half < 4) { type = WT_ROPE; dst = B.QA; hb = 2 * half; sc = C2Q; }
            else if (half == 4) { type = WT_PLAIN; dst = B.KC; nh = 2; }
            else if (half == 5) { type = WT_PLAIN; dst = B.VC; nh = 2; }
            else if (half == 6) { type = WT_ROPE; dst = B.KS; nh = 2; }
            else if (half == 7) { type = WT_VT; dst = B.VSt; nh = 2; }
            else if (half == 8) { type = WT_ROPE; dst = B.KW; nh = 2; }
            else if (half == 9) { type = WT_VT; dst = B.VWt; nh = 2; }
            else if (half < 14) { type = WT_ROPE; dst = B.QB; hb = 2 * (half - 10); sc = C2Q; }
            else if (half < 18) { type = WT_ROPE; dst = B.KBb; hb = 2 * (half - 14); }
            else if (half < 22) { type = WT_VT; dst = B.VBt; hb = 2 * (half - 18); }
            else if (half < 30) { type = WT_SIG; dst = B.GA; cb = 128 * (half - 22); }
            else if (half < 38) { type = WT_SIG; dst = B.GB; cb = 128 * (half - 30); }
            else if (half == 38) { type = WT_GS; }
            else { type = WT_NONE; }
            const int head = hb + hh;
            if (type == WT_ROPE) {
#pragma unroll
                for (int ai = 0; ai < 2; ++ai) {
                    f32x4 cs4[4], sn4[4];
#pragma unroll
                    for (int m = 0; m < 4; ++m) { const int sp = (row0 + ai * HALF + m * 16) & 2047;
                        cs4[m] = *(const __attribute__((address_space(1))) f32x4*)(ropec + sp * 32 + 16 * w + 4 * fq); sn4[m] = *(const __attribute__((address_space(1))) f32x4*)(ropes + sp * 32 + 16 * w + 4 * fq); }
                    __builtin_amdgcn_sched_barrier(0);
#pragma unroll
                    for (int m = 0; m < 4; ++m) { const int row = row0 + ai * HALF + m * 16, b = row >> 11, s = row & 2047; const float r = rs[ai][m] * sc;
                        const f32x4 c4 = cs4[m], s4 = sn4[m];
                        const f32x4 x1 = acc[ai][bj][m][0] * r, x2 = acc[ai][bj][m][1] * r;
                        const f32x4 o1 = x1 * c4 - x2 * s4, o2 = x2 * c4 + x1 * s4;
                        bf16_t* p = dst + (size_t)b * (size_t)10526720 + ((size_t)head * 2048 + s) * 64 + 16 * w + 4 * fq;
                        u32x2 w1, w2; w1.x = cvt_pk_bf16(o1[0], o1[1]); w1.y = cvt_pk_bf16(o1[2], o1[3]); w2.x = cvt_pk_bf16(o2[0], o2[1]); w2.y = cvt_pk_bf16(o2[2], o2[3]);
                        *(u32x2*)p = w1; *(u32x2*)(p + 32) = w2; }
                    asm volatile("" ::: "memory"); }
            } else if (type == WT_PLAIN) {
#pragma unroll
                for (int ai = 0; ai < 2; ++ai)
#pragma unroll
                    for (int m = 0; m < 4; ++m) { const int row = row0 + ai * HALF + m * 16, b = row >> 11, s = row & 2047; const float r = rs[ai][m];
                        const f32x4 v0 = acc[ai][bj][m][0] * r, v1 = acc[ai][bj][m][1] * r;
                        bf16_t* p = dst + (size_t)b * (size_t)10526720 + ((size_t)head * 2048 + s) * 64 + 32 * w + 4 * fq;
                        u32x2 w1, w2; w1.x = cvt_pk_bf16(v0[0], v0[1]); w1.y = cvt_pk_bf16(v0[2], v0[3]); w2.x = cvt_pk_bf16(v1[0], v1[1]); w2.y = cvt_pk_bf16(v1[2], v1[3]);
                        *(u32x2*)p = w1; *(u32x2*)(p + 16) = w2; asm volatile("" ::: "memory"); }
            } else if (type == WT_VT) {
#pragma unroll
                for (int ai = 0; ai < 2; ++ai)
#pragma unroll
                    for (int m = 0; m < 4; ++m) { const int row = row0 + ai * HALF + m * 16, b = row >> 11, s = row & 2047; const float r = rs[ai][m];
                        bf16_t* p = dst + (size_t)b * (size_t)10526720 + ((size_t)head * 64 + 32 * w + 4 * fq) * 2048 + s;
#pragma unroll
                        for (int n = 0; n < 2; ++n) { const f32x4 v = acc[ai][bj][m][n] * r; const unsigned a = cvt_pk_bf16(v[0], v[1]), c = cvt_pk_bf16(v[2], v[3]);
                            bf16_t* q = p + (size_t)(16 * n) * 2048;
                            q[0] = (bf16_t)(a & 0xffffu); q[2048] = (bf16_t)(a >> 16); q[4096] = (bf16_t)(c & 0xffffu); q[6144] = (bf16_t)(c >> 16); } asm volatile("" ::: "memory"); }
            } else if (type == WT_SIG) {
#pragma unroll
                for (int ai = 0; ai < 2; ++ai)
#pragma unroll
                    for (int m = 0; m < 4; ++m) { const int row = row0 + ai * HALF + m * 16, b = row >> 11, s = row & 2047; const float r = rs[ai][m];
                        const f32x4 v0 = acc[ai][bj][m][0] * r, v1 = acc[ai][bj][m][1] * r;
                        u32x4 o; o.x = cvt_pk_bf16(sigm(v0[0]), sigm(v0[1])); o.y = cvt_pk_bf16(sigm(v0[2]), sigm(v0[3])); o.z = cvt_pk_bf16(sigm(v1[0]), sigm(v1[1])); o.w = cvt_pk_bf16(sigm(v1[2]), sigm(v1[3]));
                        *(u32x4*)(dst + (size_t)b * (size_t)10526720 + (size_t)s * 1024 + cb + 32 * wc + 8 * fq) = o; asm volatile("" ::: "memory"); }
            } else if (type == WT_GS) {
                if (wc == 0) {
#pragma unroll
                    for (int ai = 0; ai < 2; ++ai)
#pragma unroll
                        for (int m = 0; m < 4; ++m) { const int row = row0 + ai * HALF + m * 16; const float r = rs[ai][m];
#pragma unroll
                            for (int n = 0; n < 2; ++n) { const f32x4 v = acc[ai][bj][m][n] * r; f32x4 o; o[0] = sigm(v[0]); o[1] = sigm(v[1]); o[2] = sigm(v[2]); o[3] = sigm(v[3]);
                                *(f32x4*)(B.GS + (size_t)(row >> 11) * (size_t)5263360 + (size_t)(row & 2047) * 32 + 16 * n + 4 * fq) = o; } }
                }
            }
        }
    }
};
template <class Epi, class Sched, bool ALIGN_EPI = false, bool SP2 = false>
__device__ __forceinline__ void gemm_phase(PG8_LAS unsigned char* lds, const Gemm g, const Sched& S, const Epi& E, const int tid) {
    const int wid = __builtin_amdgcn_readfirstlane(tid >> 6), lane = tid & 63, wr = wid >> 2, wc = wid & 3, fr = lane & 15, fq = lane >> 4;
    const int K = g.K, nt = K / BK;
    unsigned voffA[2], voffB[2];
#pragma unroll
    for (int i = 0; i < 2; ++i) { int R, C; stage_rc(tid * 16 + i * 8192, R, C); const int Rb = Epi::PERM ? ((R & ~31) + perm32(R & 31)) : R;
        voffA[i] = (unsigned)(R * K + C) * 2u; voffB[i] = (unsigned)(Rb * K + C) * 2u; }
    const size_t kstep = (size_t)(BK * 2);
    const size_t hstep = (size_t)HALF * K * 2;
    const size_t tstep = 2 * hstep;
    const unsigned ldsw = (unsigned)wid * 1024u;
    const int aoff = lds_byte(wr * 64 + fr, fq * 8), boff = lds_byte(wc * 32 + fr, fq * 8);
#define PG8_SA(b, h) (((b) * 2 + (h)) * HTB)
#define PG8_SB(b, h) ((4 + (b) * 2 + (h)) * HTB)
#define PG8_STAGE(bufoff, gbase, voff) do { _Pragma("unroll") for (int _i = 0; _i < 2; ++_i) \
        __builtin_amdgcn_global_load_lds((const unsigned*)((const char*)(gbase) + (voff)[_i]), (PG8_LAS unsigned*)(lds + (bufoff) + ldsw + _i * 8192), 16, 0, 0); } while (0)
#define PG8_LDA(dst, b, h) do { _Pragma("unroll") for (int m = 0; m < 4; ++m) _Pragma("unroll") for (int k = 0; k < 2; ++k) dst[m][k] = *(const PG8_LAS bf16x8*)(lds + PG8_SA(b, h) + aoff + m * 2048 + k * 1024); } while (0)
#define PG8_LDB(dst, b, h) do { _Pragma("unroll") for (int n = 0; n < 2; ++n) _Pragma("unroll") for (int k = 0; k < 2; ++k) dst[n][k] = *(const PG8_LAS bf16x8*)(lds + PG8_SB(b, h) + boff + n * 2048 + k * 1024); } while (0)
#define PG8_MMA(ai, bj, At, Bt) do { __builtin_amdgcn_s_setprio(1); _Pragma("unroll") for (int m = 0; m < 4; ++m) _Pragma("unroll") for (int n = 0; n < 2; ++n) _Pragma("unroll") for (int k = 0; k < 2; ++k) \
        acc[ai][bj][m][n] = __builtin_amdgcn_mfma_f32_16x16x32_bf16(Bt[n][k], At[m][k], acc[ai][bj][m][n], 0, 0, 0); __builtin_amdgcn_s_setprio(0); } while (0)
#define PG8_WAIT_V(n) asm volatile("s_waitcnt vmcnt(" #n ")" ::: "memory")
#define PG8_WAIT_L(n) asm volatile("s_waitcnt lgkmcnt(" #n ")" ::: "memory")
#define PG8_BAR __builtin_amdgcn_s_barrier()
#define PG8_SCHED __builtin_amdgcn_sched_barrier(0)
    Unit cur, nxt; int ui = 0;
    if (!S.next(0, cur)) return;
    f32x4 acc[2][2][4][2];
#pragma unroll
    for (int a = 0; a < 2; ++a)
#pragma unroll
        for (int b = 0; b < 2; ++b)
#pragma unroll
            for (int m = 0; m < 4; ++m)
#pragma unroll
                for (int n = 0; n < 2; ++n) acc[a][b][m][n] = (f32x4){0.f, 0.f, 0.f, 0.f};
    bf16x8 At[4][2], B0[2][2], B1[2][2];
    const char* cA = (const char*)g.A + (size_t)cur.pm * tstep + (size_t)(cur.pm >> 3) * g.abgap; const char* cB = (const char*)g.Bt + (size_t)cur.pn * tstep;
    S.a_ready(cur);
    if constexpr (SP2) {
        PG8_STAGE(PG8_SB(0, 0), cB, voffB); PG8_STAGE(PG8_SB(0, 1), cB + hstep, voffB); PG8_STAGE(PG8_SA(0, 0), cA, voffA); PG8_STAGE(PG8_SA(0, 1), cA + hstep, voffA);
        if (wr == 1) PG8_BAR;
        PG8_WAIT_V(2); PG8_BAR;
        PG8_STAGE(PG8_SB(1, 0), cB + kstep, voffB); PG8_STAGE(PG8_SA(1, 0), cA + kstep, voffA); PG8_STAGE(PG8_SB(1, 1), cB + hstep + kstep, voffB);
        PG8_WAIT_V(6); PG8_BAR;
    } else {
        PG8_STAGE(PG8_SB(0, 0), cB, voffB); PG8_STAGE(PG8_SA(0, 0), cA, voffA); PG8_STAGE(PG8_SB(0, 1), cB + hstep, voffB); PG8_STAGE(PG8_SA(0, 1), cA + hstep, voffA);
        if (wr == 1) PG8_BAR;
        PG8_WAIT_V(4); PG8_BAR;
        PG8_STAGE(PG8_SB(1, 0), cB + kstep, voffB); PG8_STAGE(PG8_SA(1, 0), cA + kstep, voffA); PG8_STAGE(PG8_SB(1, 1), cB + hstep + kstep, voffB);
        PG8_WAIT_V(6); PG8_BAR;
    }
    for (;;) {
        const bool has_next = S.next(ui + 1, nxt);
        const char* nA = has_next ? (const char*)g.A + (size_t)nxt.pm * tstep + (size_t)(nxt.pm >> 3) * g.abgap : cA; const char* nB = has_next ? (const char*)g.Bt + (size_t)nxt.pn * tstep : cB;
        for (int t = 0; t < nt; t += 2) {
            const bool last = (t == nt - 2);
            const char* a1 = cA + (size_t)(t + 1) * kstep;
            const char* a2 = last ? nA : cA + (size_t)(t + 2) * kstep; const char* b2 = last ? nB : cB + (size_t)(t + 2) * kstep;
            const char* a3 = a2 + kstep; const char* b3 = b2 + kstep;
            if (last && has_next) S.a_ready(nxt);
            if constexpr (Epi::HAS_MID) { if (t == Epi::MID_T) { __builtin_amdgcn_sched_barrier(0); E.mid(acc, cur, wr, wc, fr, fq); __builtin_amdgcn_sched_barrier(0); } }
            if constexpr (SP2) {
            PG8_LDB(B0, 0, 0); PG8_LDB(B1, 0, 1); PG8_SCHED; PG8_LDA(At, 0, 0); PG8_STAGE(PG8_SA(1, 1), a1 + hstep, voffA);
            PG8_WAIT_V(8); PG8_WAIT_L(0); PG8_BAR; PG8_MMA(0, 0, At, B0); PG8_MMA(0, 1, At, B1); PG8_BAR; PG8_SCHED;
            PG8_LDA(At, 0, 1); PG8_STAGE(PG8_SB(0, 0), b2, voffB); PG8_STAGE(PG8_SB(0, 1), b2 + hstep, voffB); PG8_STAGE(PG8_SA(0, 0), a2, voffA);
            PG8_WAIT_V(8); PG8_WAIT_L(0); PG8_BAR; PG8_MMA(1, 0, At, B0); PG8_MMA(1, 1, At, B1); PG8_BAR; PG8_SCHED;
            PG8_LDB(B0, 1, 0); PG8_LDB(B1, 1, 1); PG8_SCHED; PG8_LDA(At, 1, 0); PG8_STAGE(PG8_SA(0, 1), a2 + hstep, voffA);
            PG8_WAIT_V(8); PG8_WAIT_L(0); PG8_BAR; PG8_MMA(0, 0, At, B0); PG8_MMA(0, 1, At, B1); PG8_BAR; PG8_SCHED;
            PG8_LDA(At, 1, 1); PG8_STAGE(PG8_SB(1, 0), b3, voffB); PG8_STAGE(PG8_SB(1, 1), b3 + hstep, voffB); PG8_STAGE(PG8_SA(1, 0), a3, voffA);
            PG8_WAIT_V(8); PG8_WAIT_L(0); PG8_BAR; PG8_MMA(1, 0, At, B0); PG8_MMA(1, 1, At, B1); PG8_BAR; PG8_SCHED;
            } else {
            PG8_LDB(B0, 0, 0); PG8_SCHED; PG8_LDA(At, 0, 0); PG8_STAGE(PG8_SA(1, 1), a1 + hstep, voffA);
            PG8_WAIT_L(8); PG8_BAR; PG8_WAIT_L(0); PG8_MMA(0, 0, At, B0); PG8_BAR; PG8_SCHED;
            PG8_LDB(B1, 0, 1); PG8_STAGE(PG8_SB(0, 0), b2, voffB);
            PG8_BAR; PG8_WAIT_L(0); PG8_MMA(0, 1, At, B1); PG8_BAR;
            PG8_LDA(At, 0, 1); PG8_STAGE(PG8_SA(0, 0), a2, voffA);
            PG8_BAR; PG8_WAIT_L(0); PG8_MMA(1, 0, At, B0); PG8_BAR; PG8_SCHED;
            PG8_STAGE(PG8_SB(0, 1), b2 + hstep, voffB);
            PG8_WAIT_V(6); PG8_BAR; PG8_MMA(1, 1, At, B1); PG8_BAR;
            PG8_LDB(B0, 1, 0); PG8_SCHED; PG8_LDA(At, 1, 0); PG8_STAGE(PG8_SA(0, 1), a2 + hstep, voffA);
            PG8_WAIT_L(8); PG8_BAR; PG8_WAIT_L(0); PG8_MMA(0, 0, At, B0); PG8_BAR; PG8_SCHED;
            PG8_LDB(B1, 1, 1); PG8_STAGE(PG8_SB(1, 0), b3, voffB);
            PG8_BAR; PG8_WAIT_L(0); PG8_MMA(0, 1, At, B1); PG8_BAR;
            PG8_LDA(At, 1, 1); PG8_STAGE(PG8_SA(1, 0), a3, voffA);
            PG8_BAR; PG8_WAIT_L(0); PG8_MMA(1, 0, At, B0); PG8_BAR; PG8_SCHED;
            PG8_STAGE(PG8_SB(1, 1), b3 + hstep, voffB);
            PG8_WAIT_V(6); PG8_BAR; PG8_MMA(1, 1, At, B1); PG8_BAR;
            }
        }
        if constexpr (ALIGN_EPI) { if (wr == 0) PG8_BAR; }
        if constexpr (!Epi::AFTER_DRAIN) { E(acc, cur, wr, wc, fr, fq); S.done(cur); }
        if (!has_next) break;
#pragma unroll
        for (int a = 0; a < 2; ++a)
#pragma unroll
            for (int b = 0; b < 2; ++b)
#pragma unroll
                for (int m = 0; m < 4; ++m)
#pragma unroll
                    for (int n = 0; n < 2; ++n) acc[a][b][m][n] = (f32x4){0.f, 0.f, 0.f, 0.f};
        cur = nxt; cA = nA; cB = nB; ++ui;
        if constexpr (ALIGN_EPI) { if (wr == 1) PG8_BAR; }
    }
    PG8_WAIT_V(0);
    if constexpr (!ALIGN_EPI) { if (wr == 0) PG8_BAR; }
    PG8_BAR;
    if constexpr (Epi::AFTER_DRAIN) { E.fused(acc, cur, wr, wc, fr, fq, lds, wid, lane); S.done(cur); }
#undef PG8_SA
#undef PG8_SB
#undef PG8_STAGE
#undef PG8_LDA
#undef PG8_LDB
#undef PG8_MMA
#undef PG8_WAIT_V
#undef PG8_WAIT_L
#undef PG8_BAR
#undef PG8_SCHED
}
}
constexpr int NB = 8, SEQ = 2048, DM = 1024, MT = NB * SEQ, DFF = 2816, INC = 4888, NWIN = 5120, NUP = 2 * DFF;
constexpr int NWAVES = 8;
typedef unsigned short bf16;
typedef float f32x4 __attribute__((ext_vector_type(4)));
typedef unsigned v4u __attribute__((ext_vector_type(4)));
typedef unsigned v2u __attribute__((ext_vector_type(2)));
#define LAS __attribute__((address_space(3)))
#define GAS __attribute__((address_space(1)))
typedef GAS unsigned gu32;
#define RLX_AGENT __ATOMIC_RELAXED, __HIP_MEMORY_SCOPE_AGENT
#define LDS_WAIT() asm volatile("s_waitcnt lgkmcnt(0)" ::: "memory")
#define VM_WAIT() asm volatile("s_waitcnt vmcnt(0)" ::: "memory")
constexpr size_t MiB = 1u << 20;
constexpr size_t WS_CTL = 0, CTL_ZERO_BYTES = 64 * 1024;
constexpr size_t WS_ROPEC = 1 * MiB, WS_ROPES = 1 * MiB + 256 * 1024;
constexpr size_t WS_ROWSS = 1 * MiB + 512 * 1024;
constexpr size_t WS_KCB = 2 * MiB + 512 * 1024, WS_VCBT = WS_KCB + 256 * 1024;
constexpr size_t WS_CBIAS = 3 * MiB + 512 * 1024;
constexpr size_t WS_W2TK = 3 * MiB + 576 * 1024, WS_W2TV = 3 * MiB + 592 * 1024;
constexpr size_t WS_W1TK = 51 * MiB, WS_W1TV = 51 * MiB + 512 * 1024;
constexpr size_t WS_WUP1 = 4 * MiB, WS_WDN1 = 15 * MiB, WS_WIN = 20 * MiB + 512 * 1024, WS_WPA = 30 * MiB + 512 * 1024  ,
                 WS_WOUT = 32 * MiB + 512 * 1024, WS_WUP2 = 34 * MiB + 512 * 1024, WS_WDN2 = 45 * MiB + 512 * 1024;
constexpr size_t WS_XB = 52 * MiB;
constexpr size_t WS_ARENA = 84 * MiB, ARENA_B = 20 * MiB + 80 * 1024  , ARENA_E = ARENA_B / 2;
constexpr size_t A_QA = 0, A_QB = 2 * MiB, A_KB = 4 * MiB, A_VBT = 6 * MiB, A_KC = 8 * MiB, A_VC = 8 * MiB + 512 * 1024, A_KS = 9 * MiB, A_VST = 9 * MiB + 512 * 1024,
                 A_KW = 10 * MiB, A_VWT = 10 * MiB + 512 * 1024, A_GA = 11 * MiB, A_GB = 15 * MiB, A_GS = 19 * MiB;
constexpr size_t A_H = 0;
constexpr size_t A_MRG = 2 * MiB;
constexpr size_t OUT_BATCH_E = 4 * MiB;
constexpr size_t WS_END = WS_ARENA + 8 * ARENA_B;
constexpr int RING_BYTES = 131072, LDSCTL_OFF = RING_BYTES, MISC_OFF = LDSCTL_OFF + 320, LDS_BYTES = 147456;

enum { PH_CONV = 0, PH_UP1, PH_DN1, PH_WIN, PH_CMP, PH_ATT, PH_MRG, PH_OUT, PH_UP2, PH_DN2, PH_PER_LAYER };
constexpr int PH_NORM = 2 * PH_PER_LAYER, PH_TOTAL = PH_NORM + 1;

struct Args { const float* in[21]; float* out; unsigned char* ws; int ph_lo, ph_hi; };
static_assert(sizeof(Args) == 21 * 8 + 8 + 8 + 8, "no padding in Args");
enum { I_X = 0, I_F1N, I_F1G, I_F1U, I_F1D, I_MIXN, I_WIN, I_CKP, I_CKW1, I_CKW2, I_CVP, I_CVW1, I_CVW2, I_WBA, I_WBB, I_WOUT, I_F2N, I_F2G, I_F2U, I_F2D, I_FINN };

struct Frame {
    LAS unsigned char* lds; gu32* ctl; unsigned char* ws;
    int tid, lane, wave, G, bx, wave_s;
};
__device__ __forceinline__ int fresh_tid(int wave_s) { unsigned z = 0u; asm volatile("" : "+s"(z)); int t = wave_s * 64 + (int)__builtin_amdgcn_mbcnt_hi(~0u, __builtin_amdgcn_mbcnt_lo(~0u, z)); asm volatile("" : "+v"(t)); return t; }
__device__ __forceinline__ void frame_refresh(Frame& F) { asm volatile("" : "+v"(F.tid)); F.lane = F.tid & 63; F.wave = __builtin_amdgcn_readfirstlane(F.tid >> 6); }
__device__ __forceinline__ float wave_sum(float v) {
#pragma unroll
    for (int o = 1; o < 64; o <<= 1) v += __shfl_xor(v, o);
    return v;
}
__device__ __forceinline__ unsigned f2bf(float f) { unsigned u = __builtin_bit_cast(unsigned, f); return (u + 0x7fffu + ((u >> 16) & 1u)) >> 16; }
__device__ __forceinline__ unsigned pk2(float lo, float hi) { return f2bf(lo) | (f2bf(hi) << 16); }
__device__ __forceinline__ float bf2f(bf16 h) { return __uint_as_float((unsigned)h << 16); }
__host__ __device__ __forceinline__ int perm32i(int rho) { const int n = rho >> 4, i = rho & 15; return 8 * (i >> 2) + 4 * n + (i & 3); }

enum { CV_UP = 0, CV_NAT = 1, CV_WIN = 2, CV_P32 = 3 };
__device__ __forceinline__ int win_src_col(int rho) {
    const int half = rho >> 7, p = rho & 127;
    const int hh = p >> 6, q = p & 63, dim = 16 * (q >> 5) + (q & 15) + 32 * ((q >> 4) & 1);
    const int rp = 64 * hh + dim, pp = (p & ~31) + perm32i(p & 31);
    if (half < 4) return 128 * half + rp;
    if (half == 4) return 536 + p;
    if (half == 5) return 664 + p;
    if (half == 6) return 792 + rp;
    if (half == 7) return 920 + p;
    if (half == 8) return 1048 + rp;
    if (half == 9) return 1176 + p;
    if (half < 14) return 1304 + 128 * (half - 10) + rp;
    if (half < 18) return 1816 + 128 * (half - 14) + rp;
    if (half < 22) return 2328 + 128 * (half - 18) + p;
    if (half < 30) return 2840 + 128 * (half - 22) + pp;
    if (half < 38) return 3864 + 128 * (half - 30) + pp;
    if (half == 38) return p < 24 ? 512 + p : -1;
    return -1;
}
struct ConvJob { const float* W0; const float* W1; const float* gain; bf16* dst; int K, Nsrc, Ndst, kind, items, dpitch, koff; };
__device__ __forceinline__ int win_block_col(int r0, int& nvalid) {
    const int half = r0 >> 7, p0 = r0 & 127; nvalid = 64;
    if (half < 4) return 128 * half + p0;
    if (half == 4) return 536 + p0;
    if (half == 5) return 664 + p0;
    if (half == 6) return 792 + p0;
    if (half == 7) return 920 + p0;
    if (half == 8) return 1048 + p0;
    if (half == 9) return 1176 + p0;
    if (half < 14) return 1304 + 128 * (half - 10) + p0;
    if (half < 18) return 1816 + 128 * (half - 14) + p0;
    if (half < 22) return 2328 + 128 * (half - 18) + p0;
    if (half < 30) return 2840 + 128 * (half - 22) + p0;
    if (half < 38) return 3864 + 128 * (half - 30) + p0;
    if (half == 38 && p0 == 0) { nvalid = 24; return 512; }
    nvalid = 0; return 0;
}
struct ConvRegs { f32x4 v[16]; f32x4 g0, g1; };
__device__ __forceinline__ int conv_swz(int k) { return ((k & 7) ^ (k >> 3)) & 7; }
__device__ __forceinline__ void conv_item(const ConvJob& J, int item, int& kb, int& rb) {
    const int nrb = J.Ndst / 64;
    if ((nrb & 3) == 0 && ((J.K / 64) & 1) == 0) { const int blk = item >> 3, q = nrb >> 2; rb = 4 * (blk % q) + (item & 3); kb = 2 * (blk / q) + ((item >> 2) & 1); }
    else { kb = item / nrb; rb = item % nrb; }
}
__device__ __forceinline__ void conv_load(const ConvJob& J, int item, int lane, ConvRegs& R) {
    int kb, rb; conv_item(J, item, kb, rb); const int k0 = 64 * kb, r0 = 64 * rb;
    const float* W = J.W0; int c0, nvalid = 64;
    if (J.kind == CV_UP) { const int pn = r0 >> 8, bj = (r0 >> 7) & 1; c0 = 128 * pn + (r0 & 127); if (bj) W = J.W1; }
    else if (J.kind == CV_WIN) c0 = win_block_col(r0, nvalid);
    else c0 = r0;
    const int kr = lane >> 4, c4 = lane & 15;
#pragma unroll
    for (int i = 0; i < 16; ++i) R.v[i] = (f32x4){0.f, 0.f, 0.f, 0.f};
    R.g0 = (f32x4){1.f, 1.f, 1.f, 1.f}; R.g1 = R.g0;
    if (J.gain) { const GAS f32x4* gp = (const GAS f32x4*)(J.gain + k0 + 8 * (lane & 7)); R.g0 = gp[0]; R.g1 = gp[1]; }
    if (4 * c4 < nvalid) {
#pragma unroll
        for (int i = 0; i < 16; ++i) R.v[i] = __builtin_nontemporal_load((const GAS f32x4*)(W + (size_t)(k0 + 4 * i + kr) * J.Nsrc + c0 + 4 * c4));
    }
}
__device__ __forceinline__ void conv_emit(const ConvJob& J, int item, LAS float* scr, int lane, const ConvRegs& R) {
    int kb, rb; conv_item(J, item, kb, rb); const int k0 = 64 * kb, r0 = 64 * rb;
    int c0 = r0, nvalid = 64;
    if (J.kind == CV_UP) c0 = 128 * (r0 >> 8) + (r0 & 127);
    else if (J.kind == CV_WIN) c0 = win_block_col(r0, nvalid);
    const int kr = lane >> 4, c4 = lane & 15;
#pragma unroll
    for (int i = 0; i < 16; ++i) { const int k = 4 * i + kr;
        *(LAS f32x4*)(scr + k * 64 + 4 * (c4 ^ conv_swz(k))) = R.v[i]; }
    LDS_WAIT(); asm volatile("" ::: "memory");
}
__device__ __forceinline__ void conv_emit_b(const ConvJob& J, int item, LAS float* scr, int lane, const ConvRegs& R) {
    int kb, rb; conv_item(J, item, kb, rb); const int k0 = 64 * kb, r0 = 64 * rb;
    int c0 = r0, nvalid = 64;
    if (J.kind == CV_UP) c0 = 128 * (r0 >> 8) + (r0 & 127);
    else if (J.kind == CV_WIN) c0 = win_block_col(r0, nvalid);
#pragma unroll
    for (int e = 0; e < 8; ++e) { const int id = lane + 64 * e, n = id >> 3, c = id & 7, rho = r0 + n; int sc;
        if (J.kind == CV_UP) { const int p = rho & 127; sc = ((p & ~31) + perm32i(p & 31)) - (r0 & 127); }
        else if (J.kind == CV_NAT) sc = n;
        else if (J.kind == CV_P32) sc = ((rho & ~31) + perm32i(rho & 31)) - r0;
        else { const int col = win_src_col(rho); sc = col >= 0 ? col - c0 : -1; }
        v4u o = {0u, 0u, 0u, 0u};
        if (sc >= 0) { float f[8];
#pragma unroll
            for (int i = 0; i < 8; ++i) { const int k = 8 * c + i; f[i] = scr[k * 64 + 4 * ((sc >> 2) ^ conv_swz(k)) + (sc & 3)] * (i < 4 ? R.g0[i & 3] : R.g1[i & 3]); }
            o.x = pk2(f[0], f[1]); o.y = pk2(f[2], f[3]); o.z = pk2(f[4], f[5]); o.w = pk2(f[6], f[7]); }
        *(GAS v4u*)(J.dst + (size_t)rho * J.dpitch + J.koff + k0 + 8 * c) = o; }
    LDS_WAIT(); asm volatile("" ::: "memory");
}
__device__ __forceinline__ unsigned topk16_mask(const float (&v)[32]) { unsigned msk = 0;
#pragma unroll
    for (int j = 0; j < 32; ++j) { int rank = 0;
#pragma unroll
        for (int i = 0; i < 32; ++i) rank += (v[i] > v[j] || (v[i] == v[j] && i < j)) ? 1 : 0;
        if (rank < 16) msk |= (1u << j); }
    return msk; }
#define XB_TMO      128
#define XB_XCNT(j)  (256  + 64 * (j))
#define XB_XSUB(j)  (1280 + 64 * (j))
#define XB_XGEN(j)  (2304 + 64 * (j))
#define XB_TOP      3328
#define XB_TOPGEN   3392
#define XCD_BAR_WORDS 3456
#define XB_LSUB(j)  (3584 + 64 * (j))
#define XB_LGEN(j)  (4608 + 64 * (j))
#define XB_XTAB     5632
#define XB_TSUB(t)  (6400 + 32 * (t))
#define XB_TGEN(t)  (6416 + 32 * (t))
#define XB_SPIN_CAP (1u << 18)

__device__ __forceinline__ unsigned xb_ld(unsigned* p)              { return __hip_atomic_load(p, __ATOMIC_RELAXED, __HIP_MEMORY_SCOPE_AGENT); }
__device__ __forceinline__ unsigned xb_add(unsigned* p, unsigned v) { return __hip_atomic_fetch_add(p, v, __ATOMIC_RELAXED, __HIP_MEMORY_SCOPE_AGENT); }
__device__ __forceinline__ unsigned xb_xcc_id() { return (unsigned)__builtin_amdgcn_s_getreg((3 << 11) | 20) & 0xFu; }
#define XB_SPIN(cond, bar) do { unsigned _sp = 0; while (cond) { __builtin_amdgcn_s_sleep(1); \
    if ((++_sp & 255u) == 0u) { if (xb_ld(&(bar)[XB_TMO])) break; if (_sp > XB_SPIN_CAP) { atomicAdd(&(bar)[XB_TMO], 1u); break; } } } } while (0)

struct XcdBarrier {
    unsigned* bar; unsigned x;
    volatile LAS unsigned* st;
};

__device__ __forceinline__ XcdBarrier xcd_barrier_post(unsigned* bar, volatile LAS unsigned* st) {
    XcdBarrier b; b.bar = bar; b.x = xb_xcc_id(); b.st = st;
    if (threadIdx.x == 0) { (void)xb_add(&bar[XB_XCNT(b.x)], 1u); __hip_atomic_store(&bar[XB_XTAB + blockIdx.x], b.x + 1u, __ATOMIC_RELAXED, __HIP_MEMORY_SCOPE_AGENT); }
    return b;
}
__device__ __forceinline__ void xcd_barrier_complete(unsigned* bar, unsigned x, unsigned& nloc, unsigned& nx) {
    const unsigned G = gridDim.x * gridDim.y * gridDim.z;
    unsigned sum, cnt, mine, sp = 0u;
    for (;;) {
        sum = 0u; cnt = 0u; mine = 0u;
#pragma unroll
        for (unsigned j = 0; j < 16; ++j) { const unsigned c = xb_ld(&bar[XB_XCNT(j)]); sum += c; cnt += (c > 0u) ? 1u : 0u; mine = (j == x) ? c : mine; }
        if (sum == G) break;
        __builtin_amdgcn_s_sleep(1);
        if ((++sp & 255u) == 0u) { if (xb_ld(&bar[XB_TMO])) break; if (sp > XB_SPIN_CAP) { atomicAdd(&bar[XB_TMO], 1u); break; } }
    }
    nloc = mine > 0u ? mine : 1u; nx = cnt > 0u ? cnt : 1u;
}

__device__ __forceinline__ void xcd_barrier(const XcdBarrier& b, const bool leader, const bool release_l2 = true) {
    asm volatile("s_waitcnt vmcnt(0)" ::: "memory");
    __syncthreads();
    if (leader) {
        unsigned* bar = b.bar;
        __builtin_amdgcn_s_waitcnt(0);
        unsigned nloc = b.st[0], nx = b.st[1];
        if (nloc == 0u) { xcd_barrier_complete(bar, b.x, nloc, nx); b.st[0] = nloc; b.st[1] = nx; }
        const unsigned old = xb_add(&bar[XB_XSUB(b.x)], 1u);
        const unsigned gen = old / nloc;
        if (old + 1u == (gen + 1u) * nloc) {
            if (release_l2) __builtin_amdgcn_fence(__ATOMIC_RELEASE, "agent");
            asm volatile("s_waitcnt vmcnt(0)" ::: "memory");
            const unsigned og = xb_add(&bar[XB_TOP], 1u);
            const unsigned tg = og / nx;
            if (og + 1u == (tg + 1u) * nx) xb_add(&bar[XB_TOPGEN], 1u);
            else XB_SPIN(xb_ld(&bar[XB_TOPGEN]) == tg, bar);
            __builtin_amdgcn_fence(__ATOMIC_ACQUIRE, "agent");
            xb_add(&bar[XB_XGEN(b.x)], 1u);
            asm volatile("s_waitcnt vmcnt(0)" ::: "memory");
        } else {
            XB_SPIN(xb_ld(&bar[XB_XGEN(b.x)]) == gen, bar);
            __builtin_amdgcn_fence(__ATOMIC_ACQUIRE, "agent");
            asm volatile("s_waitcnt vmcnt(0)" ::: "memory");
        }
    }
    __syncthreads();
}

__device__ __forceinline__ void group_barrier(const XcdBarrier& b, const bool leader, const unsigned grp, const unsigned nloc) {
    asm volatile("s_waitcnt vmcnt(0)" ::: "memory");
    __syncthreads();
    if (leader) {
        unsigned* bar = b.bar;
        __builtin_amdgcn_s_waitcnt(0);
        asm volatile("buffer_inv sc1" ::: "memory");
        const unsigned old = xb_add(&bar[XB_LSUB(grp)], 1u);
        const unsigned gen = old / nloc;
        if (old + 1u == (gen + 1u) * nloc) xb_add(&bar[XB_LGEN(grp)], 1u);
        else XB_SPIN(xb_ld(&bar[XB_LGEN(grp)]) == gen, bar);
        asm volatile("s_waitcnt vmcnt(0)" ::: "memory");
    }
    __syncthreads();
}
__device__ __forceinline__ void team_barrier(const XcdBarrier& b, const bool leader, const unsigned team) {
    asm volatile("s_waitcnt vmcnt(0)" ::: "memory");
    __syncthreads();
    if (leader) {
        unsigned* bar = b.bar;
        __builtin_amdgcn_s_waitcnt(0);
        asm volatile("buffer_inv sc1" ::: "memory");
        const unsigned old = xb_add(&bar[XB_TSUB(team)], 1u);
        const unsigned gen = old >> 2;
        if ((old & 3u) == 3u) xb_add(&bar[XB_TGEN(team)], 1u);
        else XB_SPIN(xb_ld(&bar[XB_TGEN(team)]) == gen, bar);
        asm volatile("s_waitcnt vmcnt(0)" ::: "memory");
    }
    __syncthreads();
}
__device__ __forceinline__ bool colocal_check(const XcdBarrier& b, volatile LAS unsigned* flag, int tid) {
    if (tid < 64) {
        bool ok = (gridDim.x == 256u);
        if (ok) {
#pragma unroll
            for (int r = 0; r < 4; ++r) { const unsigned t = (unsigned)tid + 64u * r; const unsigned v = xb_ld(&b.bar[XB_XTAB + t]), rep = xb_ld(&b.bar[XB_XTAB + (t & 7u)]); ok = ok && (v != 0u) && (v == rep); }
            if (tid < 8) { const unsigned mine = xb_ld(&b.bar[XB_XTAB + tid]);
#pragma unroll
                for (int u = 0; u < 8; ++u) { const unsigned o = xb_ld(&b.bar[XB_XTAB + u]); if (u != tid && o == mine) ok = false; } }
        }
        const bool all = (__ballot(ok) == ~0ull);
        if (tid == 0) flag[0] = all ? 1u : 2u;
    }
    __syncthreads();
    return flag[0] == 1u;
}
__device__ __forceinline__ void phase_conv(Frame& F, const Args& A, int l) {
    frame_refresh(F);
    LAS float* scr = (LAS float*)(F.lds + F.wave * 16384);
    const int gw = F.bx * NWAVES + F.wave, NGW = F.G * NWAVES;
    unsigned char* ws = F.ws;
    const size_t LU = (size_t)DM * DFF, LW = (size_t)DM * INC, LB = (size_t)512 * DM, LO = (size_t)DM * DM;
    auto job = [&](int j) -> ConvJob {
        switch (j) {
        case 0: return ConvJob{A.in[I_F1G] + l * LU, A.in[I_F1U] + l * LU, A.in[I_F1N] + l * DM, (bf16*)(ws + WS_WUP1), DM, DFF, NUP, CV_UP, (DM / 64) * (NUP / 64), DM, 0};
        case 1: return ConvJob{A.in[I_F1D] + l * LU, nullptr, nullptr, (bf16*)(ws + WS_WDN1), DFF, DM, DM, CV_NAT, (DFF / 64) * (DM / 64), DFF, 0};
        case 2: return ConvJob{A.in[I_WIN] + l * LW, nullptr, A.in[I_MIXN] + l * DM, (bf16*)(ws + WS_WIN), DM, INC, NWIN, CV_WIN, (DM / 64) * (NWIN / 64), DM, 0};
        case 3: return ConvJob{A.in[I_WBA] + l * LB, nullptr, nullptr, (bf16*)(ws + WS_WPA), 512, DM, DM, CV_P32, (512 / 64) * (DM / 64), 1024, 0};
        case 4: return ConvJob{A.in[I_WBB] + l * LB, nullptr, nullptr, (bf16*)(ws + WS_WPA), 512, DM, DM, CV_P32, (512 / 64) * (DM / 64), 1024, 512};
        case 5: return ConvJob{A.in[I_WOUT] + l * LO, nullptr, nullptr, (bf16*)(ws + WS_WOUT), DM, DM, DM, CV_NAT, (DM / 64) * (DM / 64), DM, 0};
        case 6: return ConvJob{A.in[I_F2G] + l * LU, A.in[I_F2U] + l * LU, A.in[I_F2N] + l * DM, (bf16*)(ws + WS_WUP2), DM, DFF, NUP, CV_UP, (DM / 64) * (NUP / 64), DM, 0};
        case 7: return ConvJob{A.in[I_F2D] + l * LU, nullptr, nullptr, (bf16*)(ws + WS_WDN2), DFF, DM, DM, CV_NAT, (DFF / 64) * (DM / 64), DFF, 0};
        case 8: return ConvJob{A.in[I_CKW1] + (size_t)l * 2048 * 128, nullptr, nullptr, (bf16*)(ws + WS_W1TK), 2048, 128, 128, CV_NAT, (2048 / 64) * (128 / 64), 2048, 0};
        case 9: return ConvJob{A.in[I_CVW1] + (size_t)l * 2048 * 128, nullptr, nullptr, (bf16*)(ws + WS_W1TV), 2048, 128, 128, CV_NAT, (2048 / 64) * (128 / 64), 2048, 0};
        case 10: return ConvJob{A.in[I_CKW2] + (size_t)l * 128 * 64, nullptr, nullptr, (bf16*)(ws + WS_W2TK), 128, 64, 64, CV_NAT, 2, 128, 0};
        default: return ConvJob{A.in[I_CVW2] + (size_t)l * 128 * 64, nullptr, nullptr, (bf16*)(ws + WS_W2TV), 128, 64, 64, CV_NAT, 2, 128, 0};
        }
    };
    constexpr int NI[12] = {(DM / 64) * (NUP / 64), (DFF / 64) * (DM / 64), (DM / 64) * (NWIN / 64), (512 / 64) * (DM / 64), (512 / 64) * (DM / 64), (DM / 64) * (DM / 64), (DM / 64) * (NUP / 64), (DFF / 64) * (DM / 64), 64, 64, 2, 2};
    int total = 0;
#pragma unroll
    for (int j = 0; j < 12; ++j) total += NI[j];
    auto locate = [&](int it, int& jj, int& r) { r = it; jj = 11;
#pragma unroll
        for (int j = 0; j < 12; ++j) { if (jj == 11 && j < 11 && r < NI[j]) jj = j; else if (jj == 11 && j < 11) r -= NI[j]; } };
    int it = gw; bool have = it < total; ConvRegs cur; int jc = 0, rc = 0;
    if (have) { locate(it, jc, rc); const ConvJob Jc = job(jc); conv_load(Jc, rc, F.lane, cur); }
    while (have) {
        const int nit = it + NGW; const bool hn = nit < total; ConvRegs nxt; int jn = 0, rn = 0;
        { const ConvJob Jc = job(jc); conv_emit(Jc, rc, scr, F.lane, cur); }
        __builtin_amdgcn_sched_barrier(0);
        if (hn) { locate(nit, jn, rn); const ConvJob Jn = job(jn); conv_load(Jn, rn, F.lane, nxt); }
        __builtin_amdgcn_sched_barrier(0);
        { const ConvJob Jc = job(jc); conv_emit_b(Jc, rc, scr, F.lane, cur); }
        it = nit; have = hn; jc = jn; rc = rn;
        if (hn) cur = nxt;
    }
    if (F.wave == 0) for (int o = F.bx; o < 256; o += F.G) {
        const int kv = o >> 7, n = o & 127; const float* w1 = A.in[kv ? I_CVW1 : I_CKW1] + (size_t)l * 2048 * 128; const float* pos = A.in[kv ? I_CVP : I_CKP] + (size_t)l * 2048; float sacc = 0.f;
        {
            float pv[32], wv[32];
#pragma unroll
            for (int i = 0; i < 32; ++i) { const int k = F.lane + 64 * i; pv[i] = ((const GAS float*)pos)[k]; wv[i] = ((const GAS float*)w1)[(size_t)k * 128 + n]; }
            __builtin_amdgcn_sched_barrier(0);
#pragma unroll
            for (int i = 0; i < 32; ++i) sacc += pv[i] * wv[i];
        }
        sacc = wave_sum(sacc); if (F.lane == 0) ((float*)(ws + WS_CBIAS))[o] = sacc;
    }
    if (l == 0) {
        const float* x = A.in[I_X]; bf16* XB = (bf16*)(ws + WS_XB); float* rowss = (float*)(ws + WS_ROWSS);
        for (int m0 = 4 * gw; m0 < MT; m0 += 8 * NGW) {
            f32x4 v[2][4][4];
#pragma unroll
            for (int h = 0; h < 2; ++h) { const int mh = m0 + h * 4 * NGW;
                if (mh < MT) {
#pragma unroll
                    for (int rr = 0; rr < 4; ++rr) { const GAS f32x4* xr = (const GAS f32x4*)(x + (size_t)(mh + rr) * DM) + F.lane;
#pragma unroll
                        for (int j = 0; j < 4; ++j) v[h][rr][j] = __builtin_nontemporal_load(xr + 64 * j); } } }
            __builtin_amdgcn_sched_barrier(0);
#pragma unroll
            for (int h = 0; h < 2; ++h) { const int mh = m0 + h * 4 * NGW;
                if (mh < MT) {
#pragma unroll
                    for (int rr = 0; rr < 4; ++rr) { const int m = mh + rr; float s = 0.f;
#pragma unroll
                        for (int j = 0; j < 4; ++j) s += (v[h][rr][j][0] * v[h][rr][j][0] + v[h][rr][j][1] * v[h][rr][j][1]) + (v[h][rr][j][2] * v[h][rr][j][2] + v[h][rr][j][3] * v[h][rr][j][3]);
                        s = wave_sum(s);
                        GAS v2u* o8 = (GAS v2u*)(XB + (size_t)m * DM) + F.lane;
#pragma unroll
                        for (int j = 0; j < 4; ++j) { v2u w; w.x = pk2(v[h][rr][j][0], v[h][rr][j][1]); w.y = pk2(v[h][rr][j][2], v[h][rr][j][3]); o8[64 * j] = w; }
                        if (F.lane < 4) rowss[(size_t)m * 4 + F.lane] = F.lane == 0 ? s : 0.f; } } }
        }
        float* rc = (float*)(ws + WS_ROPEC); float* rsn = (float*)(ws + WS_ROPES);
        for (int e = F.bx * 512 + F.tid; e < SEQ * 32; e += F.G * 512) { const int t = e >> 5, d = e & 31;
            const float inv = __builtin_amdgcn_exp2f(-(float)d * 0.41524101186092029f);
            const float ang = (float)t * inv;
            const float rev = ang * 0.15915494309189535f; const float fr = rev - __builtin_rintf(rev);
            rc[e] = __builtin_amdgcn_cosf(fr); rsn[e] = __builtin_amdgcn_sinf(fr); }
    }
}
__device__ __forceinline__ float gelu_tanh(float v) { const float u = 0.7978845608028654f * (v + 0.044715f * v * v * v); const float e = __builtin_amdgcn_exp2f(-2.8853900817779268f * u); return v * __builtin_amdgcn_rcpf(1.0f + e); }
__device__ __forceinline__ void phase_norm(Frame& F, const Args& A) {
    frame_refresh(F);
    const int vcu = (F.G % 8 == 0) ? (F.bx % 8) * (F.G / 8) + F.bx / 8 : F.bx; const float* g = A.in[I_FINN]; const bf16* XB = (const bf16*)(F.ws + WS_XB); const float* rowss = (const float*)(F.ws + WS_ROWSS);
    f32x4 gg[4];
#pragma unroll
    for (int j = 0; j < 4; ++j) gg[j] = *((const GAS f32x4*)g + F.lane + 64 * j);
    for (int v = vcu; v < 256; v += F.G) {
        v2u w[8][4]; f32x4 ss[8];
#pragma unroll
        for (int r = 0; r < 8; ++r) { const int m = 2048 * (v >> 5) + 8 * (v & 31) + F.wave + 256 * r; const GAS v2u* xb = (const GAS v2u*)(XB + (size_t)m * DM) + F.lane;
#pragma unroll
            for (int j = 0; j < 4; ++j) w[r][j] = xb[64 * j];
            ss[r] = *(const GAS f32x4*)(rowss + (size_t)m * 4); }
        __builtin_amdgcn_sched_barrier(0);
#pragma unroll
        for (int r = 0; r < 8; ++r) { const int m = 2048 * (v >> 5) + 8 * (v & 31) + F.wave + 256 * r; GAS f32x4* xr = (GAS f32x4*)(A.out + (size_t)m * DM) + F.lane;
            const float rs = __builtin_amdgcn_rsqf(((ss[r][0] + ss[r][1]) + (ss[r][2] + ss[r][3])) * (1.0f / 1024.0f) + 1e-6f);
#pragma unroll
            for (int j = 0; j < 4; ++j) { f32x4 x; x[0] = __uint_as_float(w[r][j].x << 16); x[1] = __uint_as_float(w[r][j].x & 0xffff0000u); x[2] = __uint_as_float(w[r][j].y << 16); x[3] = __uint_as_float(w[r][j].y & 0xffff0000u);
                xr[64 * j] = x * rs * gg[j]; } }
    }
}
namespace fa {
typedef short bf16x8 __attribute__((ext_vector_type(8)));
typedef short s16x4 __attribute__((ext_vector_type(4)));
typedef float f32x16 __attribute__((ext_vector_type(16)));
typedef float f32x2_t __attribute__((ext_vector_type(2))); typedef __bf16 bf16x2_t __attribute__((ext_vector_type(2)));
#define FA_MFMA(a, b, c) __builtin_amdgcn_mfma_f32_32x32x16_bf16((a), (b), (c), 0, 0, 0)
constexpr float FA_THR = 6.0f, FA_NINF = -INFINITY;
__device__ __forceinline__ int crow(int r, int h) { return (r & 3) + 8 * (r >> 2) + 4 * h; }
__device__ __forceinline__ float opaque_inf() { float v = __builtin_inff(); asm volatile("" : "+s"(v)); return v; }
#define mx2(a, b) __builtin_amdgcn_fmed3f((a), (b), pinf_)
__device__ __forceinline__ unsigned cvtpk(float lo, float hi) { f32x2_t v = {lo, hi}; bf16x2_t b = __builtin_convertvector(v, bf16x2_t); return __builtin_bit_cast(unsigned, b); }
__device__ __forceinline__ float swap_max(float x) { auto rr = __builtin_amdgcn_permlane32_swap(__float_as_uint(x), __float_as_uint(x), false, false); return fmaxf(__uint_as_float(rr[0]), __uint_as_float(rr[1])); }
__device__ __forceinline__ float swap_sum(float x) { auto rr = __builtin_amdgcn_permlane32_swap(__float_as_uint(x), __float_as_uint(x), false, false); return __uint_as_float(rr[0]) + __uint_as_float(rr[1]); }
__device__ __forceinline__ float swap_other(float x, int hi) { auto rr = __builtin_amdgcn_permlane32_swap(__float_as_uint(x), __float_as_uint(x), false, false); return hi ? __uint_as_float(rr[0]) : __uint_as_float(rr[1]); }
__device__ __forceinline__ bf16x8 pack8(const f32x16& p, int s) { v4u w; w.x = cvtpk(p[8 * s], p[8 * s + 1]); w.y = cvtpk(p[8 * s + 2], p[8 * s + 3]); w.z = cvtpk(p[8 * s + 4], p[8 * s + 5]); w.w = cvtpk(p[8 * s + 6], p[8 * s + 7]); return __builtin_bit_cast(bf16x8, w); }
__device__ __forceinline__ bf16x8 vfrag(const bf16* p) { const s16x4 a = *(const GAS s16x4*)p, b = *(const GAS s16x4*)(p + 8); return (bf16x8){a[0], a[1], a[2], a[3], b[0], b[1], b[2], b[3]}; }
struct Qf { bf16x8 f[4]; };
__device__ __forceinline__ void load_rows(Qf& q, const bf16* rowp  ) {
#pragma unroll
    for (int s = 0; s < 4; ++s) q.f[s] = *(const GAS bf16x8*)(rowp + 16 * s);
}
__device__ __forceinline__ f32x16 qk_tile(const bf16* kbase, const Qf& q, const f32x16& c0, int r32, int hi) {
    Qf k; load_rows(k, kbase + r32 * 64 + hi * 8);
    f32x16 S = FA_MFMA(k.f[0], q.f[0], c0); S = FA_MFMA(k.f[1], q.f[1], S); S = FA_MFMA(k.f[2], q.f[2], S); S = FA_MFMA(k.f[3], q.f[3], S); return S;
}
__device__ __forceinline__ void pv_tile(f32x16& o0, f32x16& o1, const bf16* vbase, int vs, const f32x16& P, int r32, int hi) {
    const bf16* v0 = vbase + (size_t)r32 * vs + 4 * hi; const bf16* v1 = v0 + (size_t)32 * vs;
    const bf16x8 a00 = vfrag(v0), a01 = vfrag(v0 + 16), a10 = vfrag(v1), a11 = vfrag(v1 + 16);
    const bf16x8 p0 = pack8(P, 0), p1 = pack8(P, 1);
    o0 = FA_MFMA(a00, p0, o0); o0 = FA_MFMA(a01, p1, o0); o1 = FA_MFMA(a10, p0, o1); o1 = FA_MFMA(a11, p1, o1);
}
struct Acc { f32x16 o0, o1, negm; float m, l; bool seen; };
__device__ __forceinline__ void acc_reset(Acc& a) {
#pragma unroll
    for (int r = 0; r < 16; ++r) { a.o0[r] = 0.f; a.o1[r] = 0.f; a.negm[r] = 0.f; }
    a.m = 0.f; a.l = 0.f; a.seen = false;
}
__device__ __forceinline__ void step32(Acc& a, const Qf& q, const bf16* kbase, const bf16* vbase, int vs, int r32, int hi, bool needmask, int lo, int up, bool rowon) {
    f32x16 S = qk_tile(kbase, q, a.negm, r32, hi);
    if (needmask) {
#pragma unroll
        for (int r = 0; r < 16; ++r) { const int c = crow(r, hi); S[r] = (rowon && c >= lo && c <= up) ? S[r] : FA_NINF; }
    }
    float rm = fmaxf(fmaxf(fmaxf(S[0], S[1]), fmaxf(S[2], S[3])), fmaxf(fmaxf(S[4], S[5]), fmaxf(S[6], S[7])));
    rm = fmaxf(rm, fmaxf(fmaxf(fmaxf(S[8], S[9]), fmaxf(S[10], S[11])), fmaxf(fmaxf(S[12], S[13]), fmaxf(S[14], S[15]))));
    rm = swap_max(rm);
    const bool big = rm > (a.seen ? FA_THR : -3.0e38f);
    if (__any(big)) { const float dl = big ? rm : 0.f; a.m += dl; const float f = __builtin_amdgcn_exp2f(-dl); a.l *= f;
#pragma unroll
        for (int r = 0; r < 16; ++r) { a.o0[r] *= f; a.o1[r] *= f; S[r] -= dl; a.negm[r] = -a.m; } }
    a.seen = a.seen || (rm > -3.0e38f);
    float ps = 0.f;
#pragma unroll
    for (int r = 0; r < 16; ++r) { S[r] = __builtin_amdgcn_exp2f(S[r]); ps += S[r]; }
    a.l += ps;
    pv_tile(a.o0, a.o1, vbase, vs, S, r32, hi);
}
__device__ __forceinline__ void acc_finish(const Acc& a, f32x16& t0, f32x16& t1, float gate) {
    const float l = swap_sum(a.l); const float sc = l > 0.f ? gate * __builtin_amdgcn_rcpf(l) : 0.f;
#pragma unroll
    for (int r = 0; r < 16; ++r) { t0[r] += a.o0[r] * sc; t1[r] += a.o1[r] * sc; }
}
constexpr int L_TILE = 49152, TILE_BYTES = 16384;
struct TileRegs { v4u k, v; };
__device__ __forceinline__ void tile_issue(TileRegs& t, const bf16* kp  , const bf16* vp  , int tid) {
    t.k = *(const GAS v4u*)(kp + tid * 8); t.v = *(const GAS v4u*)(vp + (size_t)(tid >> 3) * SEQ + (tid & 7) * 8);
}
__device__ __forceinline__ void tile_commit(LAS unsigned char* buf, const TileRegs& t, int tid) {
    const int row = tid >> 3, pc = tid & 7;
    *(LAS v4u*)(buf + row * 128 + ((pc ^ ((row >> 1) & 7)) << 4)) = t.k;
    const int x = (row >> 1) & 7, g = pc >> 1, od = pc & 1; v2u lo, hi2; lo.x = t.v.x; lo.y = t.v.y; hi2.x = t.v.z; hi2.y = t.v.w;
    LAS unsigned char* vr = buf + 8192 + row * 128;
    *(LAS v2u*)(vr + (((2 * g) ^ x) << 4) + 8 * od) = lo; *(LAS v2u*)(vr + (((2 * g + 1) ^ x) << 4) + 8 * od) = hi2;
}
__device__ __forceinline__ bf16x8 lds_vfrag(const LAS unsigned char* vrow  , int c16, int x) { return *(const LAS bf16x8*)(vrow + ((c16 ^ x) << 4)); }
__device__ __forceinline__ void step32l(Acc& a, const Qf& q, const LAS unsigned char* buf, int kt, int r32, int hi, bool needmask, int lo, int up, bool rowon) {
    const float pinf_ = opaque_inf();
    const int key = 32 * kt + r32; const LAS unsigned char* kr = buf + key * 128; const int kx = (key >> 1) & 7;
    const bf16x8 k0 = *(const LAS bf16x8*)(kr + (((0 + hi) ^ kx) << 4)), k1 = *(const LAS bf16x8*)(kr + (((2 + hi) ^ kx) << 4)), k2 = *(const LAS bf16x8*)(kr + (((4 + hi) ^ kx) << 4)), k3 = *(const LAS bf16x8*)(kr + (((6 + hi) ^ kx) << 4));
    f32x16 S = FA_MFMA(k0, q.f[0], a.negm); S = FA_MFMA(k1, q.f[1], S); S = FA_MFMA(k2, q.f[2], S); S = FA_MFMA(k3, q.f[3], S);
    const LAS unsigned char* v0 = buf + 8192 + r32 * 128; const LAS unsigned char* v1 = v0 + 32 * 128; const int x0 = (r32 >> 1) & 7;
    const bf16x8 a00 = lds_vfrag(v0, 4 * kt + hi, x0), a01 = lds_vfrag(v0, 4 * kt + 2 + hi, x0), a10 = lds_vfrag(v1, 4 * kt + hi, x0), a11 = lds_vfrag(v1, 4 * kt + 2 + hi, x0);
    if (needmask) {
#pragma unroll
        for (int r = 0; r < 16; ++r) { const int c = crow(r, hi); S[r] = (rowon && c >= lo && c <= up) ? S[r] : FA_NINF; }
    }
    float rm = mx2(mx2(mx2(S[0], S[1]), mx2(S[2], S[3])), mx2(mx2(S[4], S[5]), mx2(S[6], S[7])));
    rm = mx2(rm, mx2(mx2(mx2(S[8], S[9]), mx2(S[10], S[11])), mx2(mx2(S[12], S[13]), mx2(S[14], S[15]))));
    rm = swap_max(rm);
    const bool big = rm > (a.seen ? FA_THR : -3.0e38f);
    if (__any(big)) { const float dl = big ? rm : 0.f; a.m += dl; const float f = __builtin_amdgcn_exp2f(-dl); a.l *= f;
#pragma unroll
        for (int r = 0; r < 16; ++r) { a.o0[r] *= f; a.o1[r] *= f; S[r] -= dl; a.negm[r] = -a.m; } }
    a.seen = a.seen || (rm > -3.0e38f);
    float ps = 0.f;
#pragma unroll
    for (int r = 0; r < 16; ++r) { S[r] = __builtin_amdgcn_exp2f(S[r]); ps += S[r]; }
    a.l += ps;
    const bf16x8 p0 = pack8(S, 0), p1 = pack8(S, 1);
    a.o0 = FA_MFMA(a00, p0, a.o0); a.o0 = FA_MFMA(a01, p1, a.o0); a.o1 = FA_MFMA(a10, p0, a.o1); a.o1 = FA_MFMA(a11, p1, a.o1);
}
__device__ __forceinline__ void step64l(Acc& a, const Qf& q, const LAS unsigned char* buf, int r32, int hi, bool rowmask, bool rowon) {
    const float pinf_ = opaque_inf();
    const LAS unsigned char* kr0 = buf + r32 * 128; const LAS unsigned char* kr1 = kr0 + 32 * 128; const int kx = (r32 >> 1) & 7;
    f32x16 S0, S1;
    { const bf16x8 k0 = *(const LAS bf16x8*)(kr0 + (((0 + hi) ^ kx) << 4)), k1 = *(const LAS bf16x8*)(kr0 + (((2 + hi) ^ kx) << 4)), k2 = *(const LAS bf16x8*)(kr0 + (((4 + hi) ^ kx) << 4)), k3 = *(const LAS bf16x8*)(kr0 + (((6 + hi) ^ kx) << 4));
      const bf16x8 j0 = *(const LAS bf16x8*)(kr1 + (((0 + hi) ^ kx) << 4)), j1 = *(const LAS bf16x8*)(kr1 + (((2 + hi) ^ kx) << 4)), j2 = *(const LAS bf16x8*)(kr1 + (((4 + hi) ^ kx) << 4)), j3 = *(const LAS bf16x8*)(kr1 + (((6 + hi) ^ kx) << 4));
      S0 = FA_MFMA(k0, q.f[0], a.negm); S1 = FA_MFMA(j0, q.f[0], a.negm); S0 = FA_MFMA(k1, q.f[1], S0); S1 = FA_MFMA(j1, q.f[1], S1);
      S0 = FA_MFMA(k2, q.f[2], S0); S1 = FA_MFMA(j2, q.f[2], S1); S0 = FA_MFMA(k3, q.f[3], S0); S1 = FA_MFMA(j3, q.f[3], S1); }
    const LAS unsigned char* v0 = buf + 8192 + r32 * 128; const LAS unsigned char* v1 = v0 + 32 * 128; const int x0 = (r32 >> 1) & 7;
    const bf16x8 a00 = lds_vfrag(v0, hi, x0), a01 = lds_vfrag(v0, 2 + hi, x0), a02 = lds_vfrag(v0, 4 + hi, x0), a03 = lds_vfrag(v0, 6 + hi, x0);
    float ra = mx2(mx2(mx2(S0[0], S0[1]), mx2(S0[2], S0[3])), mx2(mx2(S0[4], S0[5]), mx2(S0[6], S0[7])));
    ra = mx2(ra, mx2(mx2(mx2(S0[8], S0[9]), mx2(S0[10], S0[11])), mx2(mx2(S0[12], S0[13]), mx2(S0[14], S0[15]))));
    float rb = mx2(mx2(mx2(S1[0], S1[1]), mx2(S1[2], S1[3])), mx2(mx2(S1[4], S1[5]), mx2(S1[6], S1[7])));
    rb = mx2(rb, mx2(mx2(mx2(S1[8], S1[9]), mx2(S1[10], S1[11])), mx2(mx2(S1[12], S1[13]), mx2(S1[14], S1[15]))));
    float rm = mx2(ra, rb);
    if (rowmask) rm = rowon ? rm : FA_NINF;
    rm = swap_max(rm);
    const bool big = rm > (a.seen ? FA_THR : -3.0e38f);
    if (__any(big)) { const float dl = big ? rm : 0.f; a.m += dl; const float f = __builtin_amdgcn_exp2f(-dl); a.l *= f;
#pragma unroll
        for (int r = 0; r < 16; ++r) { a.o0[r] *= f; a.o1[r] *= f; S0[r] -= dl; S1[r] -= dl; a.negm[r] = -a.m; } }
    a.seen = a.seen || (rm > -3.0e38f);
    float ps = 0.f, pt = 0.f;
#pragma unroll
    for (int r = 0; r < 16; ++r) { S0[r] = __builtin_amdgcn_exp2f(S0[r]); ps += S0[r]; S1[r] = __builtin_amdgcn_exp2f(S1[r]); pt += S1[r]; }
    ps += pt;
    v4u w0 = __builtin_bit_cast(v4u, pack8(S0, 0)), w1 = __builtin_bit_cast(v4u, pack8(S0, 1)), w2 = __builtin_bit_cast(v4u, pack8(S1, 0)), w3 = __builtin_bit_cast(v4u, pack8(S1, 1));
    if (rowmask) { const unsigned km = rowon ? 0xffffffffu : 0u; ps = rowon ? ps : 0.f;
        w0.x &= km; w0.y &= km; w0.z &= km; w0.w &= km; w1.x &= km; w1.y &= km; w1.z &= km; w1.w &= km; w2.x &= km; w2.y &= km; w2.z &= km; w2.w &= km; w3.x &= km; w3.y &= km; w3.z &= km; w3.w &= km; }
    a.l += ps;
    const bf16x8 p0 = __builtin_bit_cast(bf16x8, w0), p1 = __builtin_bit_cast(bf16x8, w1), p2 = __builtin_bit_cast(bf16x8, w2), p3 = __builtin_bit_cast(bf16x8, w3);
    const bf16x8 a10 = lds_vfrag(v1, hi, x0), a11 = lds_vfrag(v1, 2 + hi, x0), a12 = lds_vfrag(v1, 4 + hi, x0), a13 = lds_vfrag(v1, 6 + hi, x0);
    a.o0 = FA_MFMA(a00, p0, a.o0); a.o0 = FA_MFMA(a01, p1, a.o0); a.o0 = FA_MFMA(a02, p2, a.o0); a.o0 = FA_MFMA(a03, p3, a.o0);
    a.o1 = FA_MFMA(a10, p0, a.o1); a.o1 = FA_MFMA(a11, p1, a.o1); a.o1 = FA_MFMA(a12, p2, a.o1); a.o1 = FA_MFMA(a13, p3, a.o1);
}
__device__ __forceinline__ void step64m(Acc& a, const Qf& q, const LAS unsigned char* buf, int r32, int hi, bool needmask, int loA, int upA, int loB, int upB) {
    const float pinf_ = opaque_inf();
    const LAS unsigned char* kr0 = buf + r32 * 128; const LAS unsigned char* kr1 = kr0 + 32 * 128; const int kx = (r32 >> 1) & 7;
    f32x16 S0, S1;
    { const bf16x8 k0 = *(const LAS bf16x8*)(kr0 + (((0 + hi) ^ kx) << 4)), k1 = *(const LAS bf16x8*)(kr0 + (((2 + hi) ^ kx) << 4)), k2 = *(const LAS bf16x8*)(kr0 + (((4 + hi) ^ kx) << 4)), k3 = *(const LAS bf16x8*)(kr0 + (((6 + hi) ^ kx) << 4));
      const bf16x8 j0 = *(const LAS bf16x8*)(kr1 + (((0 + hi) ^ kx) << 4)), j1 = *(const LAS bf16x8*)(kr1 + (((2 + hi) ^ kx) << 4)), j2 = *(const LAS bf16x8*)(kr1 + (((4 + hi) ^ kx) << 4)), j3 = *(const LAS bf16x8*)(kr1 + (((6 + hi) ^ kx) << 4));
      S0 = FA_MFMA(k0, q.f[0], a.negm); S1 = FA_MFMA(j0, q.f[0], a.negm); S0 = FA_MFMA(k1, q.f[1], S0); S1 = FA_MFMA(j1, q.f[1], S1);
      S0 = FA_MFMA(k2, q.f[2], S0); S1 = FA_MFMA(j2, q.f[2], S1); S0 = FA_MFMA(k3, q.f[3], S0); S1 = FA_MFMA(j3, q.f[3], S1); }
    const LAS unsigned char* v0 = buf + 8192 + r32 * 128; const LAS unsigned char* v1 = v0 + 32 * 128; const int x0 = (r32 >> 1) & 7;
    const bf16x8 a00 = lds_vfrag(v0, hi, x0), a01 = lds_vfrag(v0, 2 + hi, x0), a02 = lds_vfrag(v0, 4 + hi, x0), a03 = lds_vfrag(v0, 6 + hi, x0);
    if (needmask) {
#pragma unroll
        for (int r = 0; r < 16; ++r) { const int c = crow(r, hi); S0[r] = (c >= loA && c <= upA) ? S0[r] : FA_NINF; S1[r] = (c >= loB && c <= upB) ? S1[r] : FA_NINF; }
    }
    float ra = mx2(mx2(mx2(S0[0], S0[1]), mx2(S0[2], S0[3])), mx2(mx2(S0[4], S0[5]), mx2(S0[6], S0[7])));
    ra = mx2(ra, mx2(mx2(mx2(S0[8], S0[9]), mx2(S0[10], S0[11])), mx2(mx2(S0[12], S0[13]), mx2(S0[14], S0[15]))));
    float rb = mx2(mx2(mx2(S1[0], S1[1]), mx2(S1[2], S1[3])), mx2(mx2(S1[4], S1[5]), mx2(S1[6], S1[7])));
    rb = mx2(rb, mx2(mx2(mx2(S1[8], S1[9]), mx2(S1[10], S1[11])), mx2(mx2(S1[12], S1[13]), mx2(S1[14], S1[15]))));
    float rm = mx2(ra, rb);
    rm = swap_max(rm);
    const bool big = rm > (a.seen ? FA_THR : -3.0e38f);
    if (__any(big)) { const float dl = big ? rm : 0.f; a.m += dl; const float f = __builtin_amdgcn_exp2f(-dl); a.l *= f;
#pragma unroll
        for (int r = 0; r < 16; ++r) { a.o0[r] *= f; a.o1[r] *= f; S0[r] -= dl; S1[r] -= dl; a.negm[r] = -a.m; } }
    a.seen = a.seen || (rm > -3.0e38f);
    float ps = 0.f, pt = 0.f;
#pragma unroll
    for (int r = 0; r < 16; ++r) { S0[r] = __builtin_amdgcn_exp2f(S0[r]); ps += S0[r]; S1[r] = __builtin_amdgcn_exp2f(S1[r]); pt += S1[r]; }
    ps += pt;
    v4u w0 = __builtin_bit_cast(v4u, pack8(S0, 0)), w1 = __builtin_bit_cast(v4u, pack8(S0, 1)), w2 = __builtin_bit_cast(v4u, pack8(S1, 0)), w3 = __builtin_bit_cast(v4u, pack8(S1, 1));
    a.l += ps;
    const bf16x8 p0 = __builtin_bit_cast(bf16x8, w0), p1 = __builtin_bit_cast(bf16x8, w1), p2 = __builtin_bit_cast(bf16x8, w2), p3 = __builtin_bit_cast(bf16x8, w3);
    const bf16x8 a10 = lds_vfrag(v1, hi, x0), a11 = lds_vfrag(v1, 2 + hi, x0), a12 = lds_vfrag(v1, 4 + hi, x0), a13 = lds_vfrag(v1, 6 + hi, x0);
    a.o0 = FA_MFMA(a00, p0, a.o0); a.o0 = FA_MFMA(a01, p1, a.o0); a.o0 = FA_MFMA(a02, p2, a.o0); a.o0 = FA_MFMA(a03, p3, a.o0);
    a.o1 = FA_MFMA(a10, p0, a.o1); a.o1 = FA_MFMA(a11, p1, a.o1); a.o1 = FA_MFMA(a12, p2, a.o1); a.o1 = FA_MFMA(a13, p3, a.o1);
}
__device__ __forceinline__ void park_store(LAS float* pp, const f32x16& t0, const f32x16& t1) {
#pragma unroll
    for (int r = 0; r < 16; ++r) { pp[r * 64] = t0[r]; pp[(16 + r) * 64] = t1[r]; }
}
__device__ __forceinline__ void park_add(LAS float* pp, const Acc& a, float gate) {
    const float l = swap_sum(a.l); const float sc = l > 0.f ? gate * __builtin_amdgcn_rcpf(l) : 0.f;
#pragma unroll
    for (int r = 0; r < 16; ++r) { pp[r * 64] += a.o0[r] * sc; pp[(16 + r) * 64] += a.o1[r] * sc; }
}
__device__ __forceinline__ void park_final(LAS float* pp, const Acc& a, float gate, f32x16& t0, f32x16& t1) {
    const float l = swap_sum(a.l); const float sc = l > 0.f ? gate * __builtin_amdgcn_rcpf(l) : 0.f;
#pragma unroll
    for (int r = 0; r < 16; ++r) { t0[r] = pp[r * 64] + a.o0[r] * sc; t1[r] = pp[(16 + r) * 64] + a.o1[r] * sc; }
}
__device__ __forceinline__ void store_out(bf16* dst  , const f32x16& t0, const f32x16& t1, int hi) {
#pragma unroll
    for (int rg = 0; rg < 4; ++rg) { v2u w; w.x = cvtpk(t0[4 * rg], t0[4 * rg + 1]); w.y = cvtpk(t0[4 * rg + 2], t0[4 * rg + 3]); *(GAS v2u*)(dst + 8 * rg + 4 * hi) = w;
        v2u x; x.x = cvtpk(t1[4 * rg], t1[4 * rg + 1]); x.y = cvtpk(t1[4 * rg + 2], t1[4 * rg + 3]); *(GAS v2u*)(dst + 32 + 8 * rg + 4 * hi) = x; }
}
constexpr int L_IMP = 0, L_VS = 8 * 32 * 33 * 4, L_SELM = L_VS + 64 * 33 * 4;

__device__ __forceinline__ void nsa_unit(unsigned char* ws, bf16* attout, LAS unsigned char* lds, int wave_s, int bg, int tb) {
    const int tid = fresh_tid(wave_s); asm volatile("" : "+s"(ws));
    const int lane = tid & 63, r32 = lane & 31, hi = lane >> 5, w = __builtin_amdgcn_readfirstlane(tid >> 6), rr = w & 3, th = w >> 2;
    if (w >= 4) __builtin_amdgcn_s_setprio(1);
    const int b = bg >> 1, g = bg & 1, head = 4 * g + rr, t = 64 * tb + 32 * th + r32;
    unsigned char* ar = ws + WS_ARENA + (size_t)b * ARENA_B;
    Qf q; load_rows(q, (const bf16*)(ar + A_QA) + ((size_t)head * SEQ + t) * 64 + hi * 8);
    const GAS float* gs = (const GAS float*)(ar + A_GS) + (size_t)t * 32 + head * 3;
    const float g0 = gs[0], g1 = gs[1], g2 = gs[2];
    f32x16 t0, t1;
    const bf16* Ks = (const bf16*)(ar + A_KS) + (size_t)g * SEQ * 64; const bf16* Vs = (const bf16*)(ar + A_VST) + (size_t)g * 64 * SEQ;
    TileRegs tr; tile_issue(tr, Ks, Vs, tid);
    LAS float* IMP = (LAS float*)(lds + L_IMP); LAS float* VS = (LAS float*)(lds + L_VS); LAS unsigned* SELM = (LAS unsigned*)(lds + L_SELM);
    {
        const int ntile = (tb >> 3) + 1;
        const int clim = t >= 31 ? (t - 31) >> 4 : -1;
        const bf16* K = (const bf16*)(ws + WS_KCB) + (size_t)bg * 128 * 64; const bf16* V = (const bf16*)(ws + WS_VCBT) + (size_t)bg * 64 * 128;
        f32x16 zero;
#pragma unroll
        for (int r = 0; r < 16; ++r) zero[r] = 0.f;
        f32x16 S[4]; float rm = FA_NINF;
        Qf kf[4]; bf16x8 vf[4][4];
#pragma unroll
        for (int ti = 0; ti < 4; ++ti) if (ti < ntile) load_rows(kf[ti], K + (size_t)(ti * 32 + r32) * 64 + hi * 8);
#pragma unroll
        for (int ti = 0; ti < 4; ++ti) if (ti < ntile) { const bf16* v0 = V + (size_t)r32 * 128 + ti * 32 + 4 * hi; const bf16* v1 = v0 + (size_t)32 * 128;
            vf[ti][0] = vfrag(v0); vf[ti][1] = vfrag(v0 + 16); vf[ti][2] = vfrag(v1); vf[ti][3] = vfrag(v1 + 16); }
        __builtin_amdgcn_sched_barrier(0);
#pragma unroll
        for (int ti = 0; ti < 4; ++ti) if (ti < ntile) { S[ti] = FA_MFMA(kf[ti].f[0], q.f[0], zero); S[ti] = FA_MFMA(kf[ti].f[1], q.f[1], S[ti]); S[ti] = FA_MFMA(kf[ti].f[2], q.f[2], S[ti]); S[ti] = FA_MFMA(kf[ti].f[3], q.f[3], S[ti]); }
#pragma unroll
        for (int ti = 0; ti < 4; ++ti) if (ti < ntile) {
#pragma unroll
            for (int r = 0; r < 16; ++r) { S[ti][r] = (32 * ti + crow(r, hi) <= clim) ? S[ti][r] : FA_NINF; rm = fmaxf(rm, S[ti][r]); } }
        rm = swap_max(rm); const float mref = rm > -3.0e38f ? rm : 0.f; float l = 0.f;
#pragma unroll
        for (int ti = 0; ti < 4; ++ti) if (ti < ntile) {
#pragma unroll
            for (int r = 0; r < 16; ++r) { S[ti][r] = __builtin_amdgcn_exp2f(S[ti][r] - mref); l += S[ti][r]; } }
        l = swap_sum(l); const float il = l > 0.f ? __builtin_amdgcn_rcpf(l) : 0.f;
#pragma unroll
        for (int r = 0; r < 16; ++r) { t0[r] = 0.f; t1[r] = 0.f; }
        LAS float* myimp = IMP + (w * 32 + r32) * 33; float carry = 0.f;
#pragma unroll
        for (int ti = 0; ti < 4; ++ti) if (ti < ntile) {
#pragma unroll
            for (int r = 0; r < 16; ++r) S[ti][r] *= il;
            float lo4[4];
#pragma unroll
            for (int rg = 0; rg < 4; ++rg) lo4[rg] = swap_other(S[ti][4 * rg + 3], hi);
#pragma unroll
            for (int rg = 0; rg < 4; ++rg) { const float gsum = (S[ti][4 * rg] + S[ti][4 * rg + 1]) + (S[ti][4 * rg + 2] + S[ti][4 * rg + 3]);
                const float prev = hi ? lo4[rg] : (rg > 0 ? lo4[rg > 0 ? rg - 1 : 0] : carry);
                myimp[2 * (4 * ti + rg) + hi] = gsum + prev; }
            carry = lo4[3];
            { const bf16x8 p0 = pack8(S[ti], 0), p1 = pack8(S[ti], 1);
              t0 = FA_MFMA(vf[ti][0], p0, t0); t0 = FA_MFMA(vf[ti][1], p1, t0); t1 = FA_MFMA(vf[ti][2], p0, t1); t1 = FA_MFMA(vf[ti][3], p1, t1); }
        }
#pragma unroll
        for (int r = 0; r < 16; ++r) { t0[r] *= g0; t1[r] *= g0; }
    }
    __syncthreads();
    {
        const int tk = tid >> 3, jg = tid & 7, tht = tk >> 5, qt = tk & 31;
#pragma unroll
        for (int i = 0; i < 4; ++i) { const int j = 4 * jg + i; float x = 0.f;
#pragma unroll
            for (int r = 0; r < 4; ++r) x += IMP[((tht * 4 + r) * 32 + qt) * 33 + j];
            VS[tk * 33 + j] = (j <= tb) ? x + ((j == 0 || j == tb || j == tb - 1) ? 1e4f : 0.f) : -1e30f; }
        if (tid < 64) SELM[tid] = 0u;
    }
    __syncthreads();
    {
        const int tk = tid >> 3, part = tid & 7; float v[32];
#pragma unroll
        for (int j = 0; j < 32; ++j) v[j] = VS[tk * 33 + j];
        unsigned bits = 0;
#pragma unroll
        for (int i = 0; i < 4; ++i) { const int j = 4 * part + i; const float vj = VS[tk * 33 + j]; int rank = 0;
#pragma unroll
            for (int k = 0; k < 32; ++k) rank += (v[k] > vj || (v[k] == vj && k < j)) ? 1 : 0;
            if (rank < 16 && j <= tb) bits |= 1u << j; }
        __hip_atomic_fetch_or((LAS unsigned*)&SELM[tk], bits, __ATOMIC_RELAXED, __HIP_MEMORY_SCOPE_WORKGROUP);
    }
    __syncthreads();
    const unsigned selm = SELM[32 * th + r32];

    LAS float* pp = (LAS float*)(lds + (w < 6 ? 81920 + w * 8192 : (w - 6) * 8192)) + lane;
    park_store(pp, t0, t1);
    Acc a; LAS unsigned char* tb0 = lds + L_TILE;
    const bf16* Kw = (const bf16*)(ar + A_KW) + (size_t)g * SEQ * 64; const bf16* Vw = (const bf16*)(ar + A_VWT) + (size_t)g * 64 * SEQ;
    const int jw0 = tb >= 8 ? tb - 8 : 0;
    {
        acc_reset(a);
        for (int j = 0; j < tb; ++j) {
            LAS unsigned char* buf = tb0 + (j & 1) * TILE_BYTES;
            tile_commit(buf, tr, tid);
            tile_issue(tr, Ks + (size_t)(64 * (j + 1)) * 64, Vs + 64 * (j + 1), tid);
            __syncthreads();
            const bool on = (selm >> j) & 1u; const unsigned long long bal = __ballot(on);
            if (bal != 0ull) step64l(a, q, buf, r32, hi, bal != ~0ull, on);
        }
        {
            LAS unsigned char* buf = tb0 + (tb & 1) * TILE_BYTES;
            tile_commit(buf, tr, tid);
            tile_issue(tr, Kw + (size_t)(64 * jw0) * 64, Vw + 64 * jw0, tid);
            __syncthreads();
            step64m(a, q, buf, r32, hi, true, 0, th ? 31 : r32, th ? 0 : 1, th ? r32 : 0);
        }
        park_add(pp, a, g1);
    }

    __syncthreads();
    {
        acc_reset(a);
        const int as = 2 * tb + th, ks0 = as >= 16 ? as - 16 : 0;
        auto edge_tile = [&](int j) {
            LAS unsigned char* buf = tb0 + (j & 1) * TILE_BYTES;
            tile_commit(buf, tr, tid);
            if (j < tb) tile_issue(tr, Kw + (size_t)(64 * (j + 1)) * 64, Vw + 64 * (j + 1), tid);
            __syncthreads();
            const int ka = 2 * j, kb = 2 * j + 1;
            const bool fa_ = (as >= 16 && ka == as - 16), la_ = (ka == as), fb_ = (as >= 16 && kb == as - 16), lb_ = (kb == as);
            const bool acta = (ka >= ks0 && ka <= as), actb = (kb >= ks0 && kb <= as);
            if (acta || actb) step64m(a, q, buf, r32, hi, !(acta && actb && !fa_ && !la_ && !fb_ && !lb_),
                                      !acta ? 1 : (fa_ ? r32 + 1 : 0), !acta ? 0 : (la_ ? r32 : 31), !actb ? 1 : (fb_ ? r32 + 1 : 0), !actb ? 0 : (lb_ ? r32 : 31));
        };
        edge_tile(jw0);
        for (int j = jw0 + 1; j < tb; ++j) {
            LAS unsigned char* buf = tb0 + (j & 1) * TILE_BYTES;
            tile_commit(buf, tr, tid);
            tile_issue(tr, Kw + (size_t)(64 * (j + 1)) * 64, Vw + 64 * (j + 1), tid);
            __syncthreads();
            step64l(a, q, buf, r32, hi, false, true);
        }
        if (tb > jw0) edge_tile(tb);
        park_final(pp, a, g2, t0, t1);
    }
    store_out(attout + (size_t)b * OUT_BATCH_E + (size_t)t * 1024 + head * 64, t0, t1, hi);
    __builtin_amdgcn_s_setprio(0);

    __syncthreads();
}
__device__ __forceinline__ void moba_unit(unsigned char* ws, bf16* attout, LAS unsigned char* lds, int wave_s, int bh, int c8) {
    const int tid = fresh_tid(wave_s); asm volatile("" : "+s"(ws));
    const int lane = tid & 63, r32 = lane & 31, hi = lane >> 5, w = __builtin_amdgcn_readfirstlane(tid >> 6);
    if (w >= 4) __builtin_amdgcn_s_setprio(1);
    const int b = bh >> 3, h = bh & 7, t = 256 * c8 + 32 * w + r32;
    unsigned char* ar = ws + WS_ARENA + (size_t)b * ARENA_B;
    Qf q; load_rows(q, (const bf16*)(ar + A_QB) + ((size_t)h * SEQ + t) * 64 + hi * 8);
    const bf16* K = (const bf16*)(ar + A_KB) + (size_t)h * SEQ * 64; const bf16* V = (const bf16*)(ar + A_VBT) + (size_t)h * 64 * SEQ;
    TileRegs tr; tile_issue(tr, K, V, tid);
    unsigned selm = 0;
    if (c8 > 0) {
        LAS bf16* KMl = (LAS bf16*)(lds + L_TILE + 2 * TILE_BYTES);
        if (w < c8) { const int ko = lane >> 3, ch = lane & 7; const bf16* base = K + (size_t)(256 * w) * 64; float s8[8];
#pragma unroll
            for (int i = 0; i < 8; ++i) s8[i] = 0.f;
            for (int ib = 0; ib < 32; ib += 16) { v4u wv[16];
#pragma unroll
                for (int i = 0; i < 16; ++i) wv[i] = *(const GAS v4u*)(base + (size_t)(8 * (ib + i) + ko) * 64 + ch * 8);
                __builtin_amdgcn_sched_barrier(0);
#pragma unroll
                for (int i = 0; i < 16; ++i) {
                    s8[0] += __uint_as_float(wv[i].x << 16); s8[1] += __uint_as_float(wv[i].x & 0xffff0000u); s8[2] += __uint_as_float(wv[i].y << 16); s8[3] += __uint_as_float(wv[i].y & 0xffff0000u);
                    s8[4] += __uint_as_float(wv[i].z << 16); s8[5] += __uint_as_float(wv[i].z & 0xffff0000u); s8[6] += __uint_as_float(wv[i].w << 16); s8[7] += __uint_as_float(wv[i].w & 0xffff0000u); } }
#pragma unroll
            for (int i = 0; i < 8; ++i) { s8[i] += __shfl_xor(s8[i], 8); s8[i] += __shfl_xor(s8[i], 16); s8[i] += __shfl_xor(s8[i], 32); s8[i] *= (1.0f / 256.0f); }
            if (lane < 8) { v4u o; o.x = pk2(s8[0], s8[1]); o.y = pk2(s8[2], s8[3]); o.z = pk2(s8[4], s8[5]); o.w = pk2(s8[6], s8[7]); *(LAS v4u*)(KMl + w * 64 + ch * 8) = o; } }
        else if (lane < 8) { const v4u z = {0u, 0u, 0u, 0u}; *(LAS v4u*)(KMl + w * 64 + (lane & 7) * 8) = z; }
        __syncthreads();
        f32x16 zero;
#pragma unroll
        for (int r = 0; r < 16; ++r) zero[r] = 0.f;
        Qf k;
#pragma unroll
        for (int sx = 0; sx < 4; ++sx) k.f[sx] = *(const LAS bf16x8*)(KMl + (r32 & 7) * 64 + hi * 8 + 16 * sx);
        f32x16 S = FA_MFMA(k.f[0], q.f[0], zero); S = FA_MFMA(k.f[1], q.f[1], S); S = FA_MFMA(k.f[2], q.f[2], S); S = FA_MFMA(k.f[3], q.f[3], S);
        float gsc[8];
#pragma unroll
        for (int i = 0; i < 4; ++i) { auto sw = __builtin_amdgcn_permlane32_swap(__float_as_uint(S[i]), __float_as_uint(S[i]), false, false); gsc[i] = __uint_as_float(sw[0]); gsc[4 + i] = __uint_as_float(sw[1]); }
#pragma unroll
        for (int j = 0; j < 8; ++j) { int rank = 0;
#pragma unroll
            for (int i = 0; i < 8; ++i) rank += (i < c8 && (gsc[i] > gsc[j] || (gsc[i] == gsc[j] && i < j))) ? 1 : 0;
            if (j < c8 && rank < 3) selm |= 1u << j; }
    }
    Acc a; acc_reset(a); LAS unsigned char* tb0 = lds + L_TILE;
    const int nt = 4 * c8 + 4, npast = 4 * c8;
    for (int i = 0; i < npast; ++i) {
        LAS unsigned char* buf = tb0 + (i & 1) * TILE_BYTES;
        tile_commit(buf, tr, tid);
        tile_issue(tr, K + (size_t)(64 * (i + 1)) * 64, V + 64 * (i + 1), tid);
        __syncthreads();
        const bool on = (selm >> (i >> 2)) & 1u; const unsigned long long bal = __ballot(on);
        if (bal != 0ull) step64l(a, q, buf, r32, hi, bal != ~0ull, on);
    }
    for (int i = npast; i < nt; ++i) {
        LAS unsigned char* buf = tb0 + (i & 1) * TILE_BYTES;
        tile_commit(buf, tr, tid);
        if (i + 1 < nt) tile_issue(tr, K + (size_t)(64 * (i + 1)) * 64, V + 64 * (i + 1), tid);
        __syncthreads();
        const int ka = 2 * (i & 3), kb = ka + 1;
        if (ka <= w) step64m(a, q, buf, r32, hi, kb >= w, 0, ka == w ? r32 : 31, kb > w ? 1 : 0, kb > w ? 0 : (kb == w ? r32 : 31));
    }
    f32x16 t0, t1;
#pragma unroll
    for (int r = 0; r < 16; ++r) { t0[r] = 0.f; t1[r] = 0.f; }
    acc_finish(a, t0, t1, 1.0f);
    store_out(attout + (size_t)b * OUT_BATCH_E + (size_t)t * 1024 + 512 + h * 64, t0, t1, hi);
    __builtin_amdgcn_s_setprio(0);
    __syncthreads();
}
}
__device__ __forceinline__ void cmp_unit(Frame& F, const Args& A, int l, int u) {
    unsigned char* ws = F.ws; asm volatile("" : "+s"(ws)); const int tid = fresh_tid(F.wave_s), lane = tid & 63, r32 = lane & 31, hi = lane >> 5, w = __builtin_amdgcn_readfirstlane(tid >> 6), nt = w & 3, kh = w >> 2;
    LAS float* part = (LAS float*)F.lds;
    LAS float* hid = (LAS float*)(F.lds + 16896);
    LAS float* o2 = (LAS float*)(F.lds + 16896 + 16384);
    {
        const int kv = u >> 6, bg = (u >> 2) & 15, ct = u & 3, c0 = 32 * ct;
        const bf16* src = (const bf16*)(ws + WS_ARENA + (size_t)(bg >> 1) * ARENA_B + (kv ? A_VC : A_KC)) + (size_t)(bg & 1) * SEQ * 64;
        const bf16* w1t = (const bf16*)(ws + (kv ? WS_W1TV : WS_W1TK));
        fa::f32x16 acc;
#pragma unroll
        for (int r = 0; r < 16; ++r) acc[r] = 0.f;
        const bf16* ap = src + (size_t)(16 * (c0 + r32)) * 64 + 8 * hi;
        const bf16* bp = w1t + (size_t)(32 * nt + r32) * 2048 + 8 * hi;
        for (int sb = kh * 64; sb < kh * 64 + 64; sb += 16) {
            fa::bf16x8 af[16], bfr[16];
#pragma unroll
            for (int i = 0; i < 16; ++i) { const int s = sb + i;
                af[i] = *(const GAS fa::bf16x8*)(ap + (s >> 2) * 64 + 16 * (s & 3)); bfr[i] = *(const GAS fa::bf16x8*)(bp + 16 * s); }
            __builtin_amdgcn_sched_barrier(0);
#pragma unroll
            for (int i = 0; i < 16; ++i) acc = FA_MFMA(af[i], bfr[i], acc);
            __builtin_amdgcn_sched_barrier(0);
        }

        if (kh == 1) {
#pragma unroll
            for (int r = 0; r < 16; ++r) part[(nt * 32 + fa::crow(r, hi)) * 33 + r32] = acc[r];
        }
        __syncthreads();
        LAS bf16* hidb = (LAS bf16*)hid;
        if (kh == 0) { const float bias = ((const float*)(ws + WS_CBIAS))[kv * 128 + 32 * nt + r32];
#pragma unroll
            for (int r = 0; r < 16; ++r) { const int c = fa::crow(r, hi); hidb[c * 136 + 32 * nt + r32] = (bf16)f2bf(gelu_tanh(acc[r] + part[(nt * 32 + c) * 33 + r32] + bias)); }
        }
        __syncthreads();
        if (w < 2) {
            const bf16* w2t = (const bf16*)(ws + (kv ? WS_W2TV : WS_W2TK)) + (size_t)(32 * w + r32) * 128 + 8 * hi;
            fa::bf16x8 bq[8];
#pragma unroll
            for (int sx = 0; sx < 8; ++sx) bq[sx] = *(const GAS fa::bf16x8*)(w2t + 16 * sx);
            fa::f32x16 oacc;
#pragma unroll
            for (int r = 0; r < 16; ++r) oacc[r] = 0.f;
#pragma unroll
            for (int sx = 0; sx < 8; ++sx) { const fa::bf16x8 aq = *(const LAS fa::bf16x8*)(hidb + r32 * 136 + 16 * sx + 8 * hi); oacc = FA_MFMA(aq, bq[sx], oacc); }
#pragma unroll
            for (int r = 0; r < 16; ++r) o2[fa::crow(r, hi) * 64 + 32 * w + r32] = oacc[r];
        }
        __syncthreads();
        const int d = tid & 63, cq = tid >> 6;
#pragma unroll
        for (int i = 0; i < 4; ++i) { const int cl = cq + 8 * i, c = c0 + cl;
            if (kv == 0) { float r = 0.f;
                if (c < 127) { const int t = 16 * c + 31, dd = d & 31; const float cs = ((const float*)(ws + WS_ROPEC))[t * 32 + dd], sn = ((const float*)(ws + WS_ROPES))[t * 32 + dd];
                    const float x1 = o2[cl * 64 + dd], x2 = o2[cl * 64 + dd + 32]; r = d < 32 ? x1 * cs - x2 * sn : x2 * cs + x1 * sn; }
                ((bf16*)(ws + WS_KCB))[((size_t)bg * 128 + c) * 64 + d] = (bf16)f2bf(r); }
            else { const float r = c < 127 ? o2[cl * 64 + d] : 0.f; ((bf16*)(ws + WS_VCBT))[((size_t)bg * 64 + d) * 128 + c] = (bf16)f2bf(r); } }
        __syncthreads();
    }
}
__device__ __forceinline__ void phase_x(Frame& F, const Args& A, int l, bf16* attout) {
    const int vcu = (F.G % 8 == 0) ? (F.bx % 8) * (F.G / 8) + F.bx / 8 : F.bx;
    for (int mp = vcu; mp < 256; mp += F.G) { const int bh = mp >> 2, i = mp & 3;
        if (i < 2) { const int g8 = mp >> 5, j5 = mp & 31, a4 = (j5 >> 2) * 2 + (j5 & 1);
            cmp_unit(F, A, l, (a4 >> 3) * 64 + (2 * g8 + ((a4 >> 2) & 1)) * 4 + (a4 & 3)); }
        const int code = i == 0 ? 0x7 : i == 1 ? 0x06 : i == 2 ? 0x35 : 0x124, cnt = i == 0 ? 1 : i == 3 ? 3 : 2;
        for (int k = 0; k < cnt; ++k) fa::moba_unit(F.ws, attout, F.lds, F.wave_s, bh, (code >> (4 * k)) & 15); }
}
__device__ __forceinline__ void phase_y(Frame& F, bf16* attout) {
    const int vcu = (F.G % 8 == 0) ? (F.bx % 8) * (F.G / 8) + F.bx / 8 : F.bx;
    for (int np = vcu; np < 256; np += F.G) { const int bg = np >> 4, p = np & 15;
        for (int k = 0; k < 2; ++k) fa::nsa_unit(F.ws, attout, F.lds, F.wave_s, bg, k == 0 ? 31 - p : p); }
}
__global__ void __launch_bounds__(NWAVES * 64, 2) fwd_kernel(Args args) {
    extern __shared__ __attribute__((aligned(16))) unsigned char lds[];
    LAS unsigned char* ldsb = (LAS unsigned char*)lds;
    volatile LAS unsigned* MISC = (volatile LAS unsigned*)(ldsb + MISC_OFF);
    for (int u = threadIdx.x; u < (LDS_BYTES - LDSCTL_OFF) / 4; u += NWAVES * 64) ((LAS unsigned*)(ldsb + LDSCTL_OFF))[u] = 0u;
    __syncthreads();
    const int wave_s = __builtin_amdgcn_readfirstlane((int)threadIdx.x >> 6);
    XcdBarrier bar; bar.bar = (unsigned*)(args.ws + WS_CTL) + 4096; bar.x = 0; bar.st = nullptr;
    const bool multi = (args.ph_hi - args.ph_lo) > 1;
    if (multi) bar = xcd_barrier_post((unsigned*)(args.ws + WS_CTL) + 4096, MISC + 8);
    bool colocal = false, checked = !multi;
    for (int ph = args.ph_lo; ph < args.ph_hi; ++ph) {
        unsigned char* ws = args.ws; asm volatile("" : "+s"(ws));
        unsigned zero_ = 0u; asm volatile("" : "+s"(zero_));
        int tid_ = wave_s * 64 + (int)__builtin_amdgcn_mbcnt_hi(~0u, __builtin_amdgcn_mbcnt_lo(~0u, zero_)); asm volatile("" : "+v"(tid_));
        Frame F;
        F.lds = ldsb; F.ws = ws; F.ctl = (gu32*)(ws + WS_CTL);
        F.tid = tid_; F.lane = 0; F.wave = 0; F.G = gridDim.x; F.bx = blockIdx.x; F.wave_s = wave_s;
        const int l = ph / PH_PER_LAYER, k = (ph == PH_NORM) ? -1 : ph % PH_PER_LAYER;
        bf16* XB = (bf16*)(ws + WS_XB); float* rowss = (float*)(ws + WS_ROWSS);
        if (ph == PH_NORM) {
#ifndef NO_NORM
 phase_norm(F, args);
#endif
 }
        else if (k == PH_CONV) {
#ifndef NO_CONV
 phase_conv(F, args, l);
#endif
 }
        else if (k == PH_UP1 || k == PH_UP2) {
            pg8::Gemm g{XB, (const bf16*)(ws + (k == PH_UP1 ? WS_WUP1 : WS_WUP2)), MT, NUP, DM, 0}; pg8::StaticOrder S; S.init(MT, NUP, F.G, F.bx);
            pg8::EpiSwiglu E{(bf16*)(ws + WS_ARENA + A_H), rowss};

#ifndef NO_UP
 pg8::gemm_phase<pg8::EpiSwiglu, pg8::StaticOrder, true, true>(F.lds, g, S, E, F.tid);
#endif

        }
        else if (k == PH_DN1 || k == PH_DN2 || k == PH_OUT) {
            const bool isout = (k == PH_OUT);
            pg8::Gemm g{(const bf16*)(ws + WS_ARENA + (isout ? A_MRG : A_H)), (const bf16*)(ws + (isout ? WS_WOUT : (k == PH_DN1 ? WS_WDN1 : WS_WDN2))), MT, DM, isout ? DM : DFF,
                        ARENA_B - (size_t)SEQ * (isout ? DM : DFF) * 2}; pg8::StaticOrder S; S.init(MT, DM, F.G, F.bx);
            pg8::EpiResid E{XB, rowss, isout ? 1.0f : 0.5f, (LAS float*)(F.lds + 132096)};

#ifndef NO_DN
 pg8::gemm_phase<pg8::EpiResid, pg8::StaticOrder, true, true>(F.lds, g, S, E, F.tid);
#endif

        }
        else if (k == PH_WIN) {
            pg8::Gemm g{XB, (const bf16*)(ws + WS_WIN), MT, NWIN, DM, 0}; pg8::StaticOrder S; S.init(MT, NWIN, F.G, F.bx);
            pg8::EpiWin E{rowss, (const float*)(ws + WS_ROPEC), (const float*)(ws + WS_ROPES),
                pg8::WinBufs{(bf16*)(ws + WS_ARENA + A_QA), (bf16*)(ws + WS_ARENA + A_QB), (bf16*)(ws + WS_ARENA + A_KB), (bf16*)(ws + WS_ARENA + A_VBT), (bf16*)(ws + WS_ARENA + A_KC), (bf16*)(ws + WS_ARENA + A_VC), (bf16*)(ws + WS_ARENA + A_KS), (bf16*)(ws + WS_ARENA + A_VST),
                             (bf16*)(ws + WS_ARENA + A_KW), (bf16*)(ws + WS_ARENA + A_VWT), (bf16*)(ws + WS_ARENA + A_GA), (bf16*)(ws + WS_ARENA + A_GB), (float*)(ws + WS_ARENA + A_GS)}};

#ifndef NO_WIN
 pg8::gemm_phase<pg8::EpiWin, pg8::StaticOrder, true, true>(F.lds, g, S, E, F.tid);
#endif

        }
        else if (k == PH_CMP) {
#ifndef NO_CMP
 { bf16* attout = (bf16*)args.out; asm volatile("" : "+s"(attout)); phase_x(F, args, l, attout); }
#endif
 }
        else if (k == PH_ATT) {
#ifndef NO_ATT
 { bf16* attout = (bf16*)args.out; asm volatile("" : "+s"(attout)); phase_y(F, attout); }
#endif
 }
        else if (k == PH_MRG) {
            { pg8::Gemm g{(const bf16*)args.out, (const bf16*)(ws + WS_WPA), MT, DM, DM, (size_t)OUT_BATCH_E * 2 - (size_t)SEQ * DM * 2}; pg8::StaticOrder S; S.init(MT, DM, F.G, F.bx);
              pg8::EpiMergeF E{(const bf16*)(ws + WS_ARENA + A_GA), (const bf16*)(ws + WS_ARENA + A_GB), (bf16*)(ws + WS_ARENA + A_MRG)};
#ifndef NO_MRG
              pg8::gemm_phase<pg8::EpiMergeF, pg8::StaticOrder, true, true>(F.lds, g, S, E, F.tid);
#endif
            }
        }
        if (ph + 1 < args.ph_hi) {
            const bool full_seam = (k == PH_CONV) || (k == PH_DN2 && l == 0);
            const int tq = fresh_tid(wave_s);
            if (full_seam || !colocal) { xcd_barrier(bar, tq == 0); if (!checked) { colocal = colocal_check(bar, MISC + 10, fresh_tid(wave_s)); checked = true; } }
            else if (k == PH_UP1 || k == PH_UP2 || k == PH_MRG) team_barrier(bar, tq == 0, (blockIdx.x & 7u) * 8u + ((blockIdx.x >> 3) & 7u));
            else group_barrier(bar, tq == 0, blockIdx.x & 7u, gridDim.x >> 3);
        }
    }
}

extern "C" void kernel_launch(void* const* d_in, const int* in_sizes, int n_in, void* d_out, int out_size, void* d_ws, size_t ws_size, hipStream_t stream) {
    static int grid = 0;
    if (grid == 0) {
        if (n_in != 21 || in_sizes[0] != MT * DM || out_size != MT * DM || ws_size < WS_END) { fprintf(stderr, "kernel_launch: unexpected shapes (n_in %d, in0 %d, out %d, ws %zu)\n", n_in, n_in > 0 ? in_sizes[0] : -1, out_size, ws_size); grid = -1; return; }
        int dev = 0, cus = 0;
        if (hipGetDevice(&dev) != hipSuccess || hipDeviceGetAttribute(&cus, hipDeviceAttributeMultiprocessorCount, dev) != hipSuccess) { grid = -1; return; }
        if (hipFuncSetAttribute((const void*)fwd_kernel, hipFuncAttributeMaxDynamicSharedMemorySize, LDS_BYTES) != hipSuccess) { fprintf(stderr, "kernel_launch: hipFuncSetAttribute failed\n"); grid = -1; return; }
        (void)hipGetLastError();
        grid = cus;
    }
    if (grid < 0) return;
    (void)hipMemsetAsync((char*)d_ws + WS_CTL, 0, CTL_ZERO_BYTES, stream);
    Args a{};
    for (int i = 0; i < 21; ++i) a.in[i] = (const float*)d_in[i];
    a.out = (float*)d_out; a.ws = (unsigned char*)d_ws;
#ifndef MULTI_LAUNCH
    a.ph_lo = 0; a.ph_hi = PH_TOTAL;
    hipLaunchKernelGGL(fwd_kernel, dim3(grid), dim3(NWAVES * 64), LDS_BYTES, stream, a);
    return;
#endif
    for (int ph = 0; ph < PH_TOTAL; ++ph) {
        a.ph_lo = ph; a.ph_hi = ph + 1;
        hipLaunchKernelGGL(fwd_kernel, dim3(grid), dim3(NWAVES * 64), LDS_BYTES, stream, a);
    }
}
```
